# Optimizing an MI355X kernel written in HIP

```python
import math
import jax, jax.numpy as jnp
from jax import lax
import numpy as np

D_MODEL = 2048
BATCH = 8
SEQ = 2048
DEPTH = 2

N_MIXERS = 2
RMS_EPS = 1e-6
D_SSM = D_MODEL // 2
SSM_GROUP_CH = 16
N_SSM_GROUPS = D_SSM // SSM_GROUP_CH
SSM_STATE = 64
STEP_MIN = 1e-3
STEP_MAX = 1e-1
FOX_HEAD_DIM = 128
FOX_HEADS = D_MODEL // FOX_HEAD_DIM
Q_BLOCK = 128
FORGET_BIAS_LO = 1.0
FORGET_BIAS_HI = 4.0
N_EXPERT_GROUPS = 8
EXPERTS_PER_GROUP = 8
N_EXPERTS = N_EXPERT_GROUPS * EXPERTS_PER_GROUP
TOP_K = 2
D_EXPERT = D_MODEL // 4
DISPATCH_BLOCK = 256

kernel_name = "hybrid_s5_fox_hier_moe"


def rms_norm(x, gain):
    xf = x.astype(jnp.float32)
    y = xf * lax.rsqrt(jnp.mean(xf * xf, axis=-1, keepdims=True) + RMS_EPS)
    return (y * gain.astype(jnp.float32)).astype(x.dtype)


def _diag_complex_combine(e1, e2):
    a1r, a1i, b1r, b1i = e1
    a2r, a2i, b2r, b2i = e2
    return (a2r * a1r - a2i * a1i,
            a2r * a1i + a2i * a1r,
            a2r * b1r - a2i * b1i + b2r,
            a2r * b1i + a2i * b1r + b2i)


def s5_mixer(h, w_in, lam_re, lam_im, b_re, b_im, c_re, c_im, d_skip, log_step, w_glu, b_glu, w_out):
    f32 = jnp.float32
    bsz, seq, _ = h.shape
    u = h @ w_in
    uf = u.astype(f32).reshape(bsz, seq, N_SSM_GROUPS, SSM_GROUP_CH)
    lr = lam_re.astype(f32)
    li = lam_im.astype(f32)
    step = jnp.exp(log_step.astype(f32))[:, None]
    mag = jnp.exp(lr * step)
    ab_re = mag * jnp.cos(li * step)
    ab_im = mag * jnp.sin(li * step)
    den = lr * lr + li * li
    nr = ab_re - 1.0
    ni = ab_im
    fr = (nr * lr + ni * li) / den
    fi = (ni * lr - nr * li) / den
    br = b_re.astype(f32)
    bi = b_im.astype(f32)
    bb_re = fr[..., None] * br - fi[..., None] * bi
    bb_im = fr[..., None] * bi + fi[..., None] * br
    bu_re = jnp.einsum('bsgc,gnc->sbgn', uf, bb_re)
    bu_im = jnp.einsum('bsgc,gnc->sbgn', uf, bb_im)
    a_re = jnp.broadcast_to(ab_re, (seq, 1) + ab_re.shape)
    a_im = jnp.broadcast_to(ab_im, (seq, 1) + ab_im.shape)
    _, _, x_re, x_im = lax.associative_scan(_diag_complex_combine, (a_re, a_im, bu_re, bu_im), axis=0)
    y = (jnp.einsum('sbgn,gcn->bsgc', x_re, c_re.astype(f32))
         - jnp.einsum('sbgn,gcn->bsgc', x_im, c_im.astype(f32)))
    y = y.reshape(bsz, seq, D_SSM) + d_skip.astype(f32) * u.astype(f32)
    y = y.astype(h.dtype)
    g = jax.nn.gelu(y)
    out = g * jax.nn.sigmoid(g @ w_glu + b_glu)
    return out @ w_out


def fox_mixer(h, w_in, b_forget, w_out):
    f32 = jnp.float32
    bsz, seq, _ = h.shape
    proj = h @ w_in
    q, k, v, gate, f_logit = jnp.split(proj, [D_MODEL, 2 * D_MODEL, 3 * D_MODEL, 4 * D_MODEL], axis=-1)

    def heads(t):
        return t.reshape(bsz, seq, FOX_HEADS, FOX_HEAD_DIM).transpose(0, 2, 1, 3)

    q, k, v = heads(q), heads(k), heads(v)
    log_f = jax.nn.log_sigmoid((f_logit + b_forget).astype(f32))
    cum = jnp.cumsum(log_f, axis=1).transpose(0, 2, 1)
    n_blocks = seq // Q_BLOCK
    q_blocks = q.reshape(bsz, FOX_HEADS, n_blocks, Q_BLOCK, FOX_HEAD_DIM).transpose(2, 0, 1, 3, 4)
    c_blocks = cum.reshape(bsz, FOX_HEADS, n_blocks, Q_BLOCK).transpose(2, 0, 1, 3)
    key_pos = jnp.arange(seq)
    scale = FOX_HEAD_DIM ** -0.5

    def one_block(args):
        qb, cqb, blk = args
        q_pos = blk * Q_BLOCK + jnp.arange(Q_BLOCK)
        logits = jnp.einsum('bhqd,bhkd->bhqk', qb, k).astype(f32) * scale
        logits = logits + (cqb[..., :, None] - cum[:, :, None, :])
        logits = jnp.where(key_pos[None, :] <= q_pos[:, None], logits, -jnp.inf)
        probs = jax.nn.softmax(logits, axis=-1).astype(v.dtype)
        return jnp.einsum('bhqk,bhkd->bhqd', probs, v)

    o = lax.map(one_block, (q_blocks, c_blocks, jnp.arange(n_blocks)))
    o = o.transpose(1, 0, 3, 2, 4).reshape(bsz, seq, D_MODEL)
    o = o * jax.nn.sigmoid(gate)
    return o @ w_out


def hier_moe(h, w_group, b_group, w_expert, b_expert, w_gate, w_up, w_down):
    f32 = jnp.float32
    bsz, seq, d = h.shape
    xt = h.reshape(-1, d)
    n_tok = xt.shape[0]
    group_logits = (xt @ w_group + b_group).astype(f32)
    group_probs = jax.nn.softmax(group_logits, axis=-1)
    g_sel = jnp.argmax(group_logits, axis=-1)
    p_group = jnp.take_along_axis(group_probs, g_sel[:, None], axis=1)[:, 0]
    expert_logits = (xt @ w_expert + b_expert).astype(f32).reshape(n_tok, N_EXPERT_GROUPS, EXPERTS_PER_GROUP)
    in_group = jnp.take_along_axis(expert_logits, g_sel[:, None, None], axis=1)[:, 0]
    top_logits, top_local = lax.top_k(in_group, TOP_K)
    top_w = jax.nn.softmax(top_logits, axis=-1) * p_group[:, None]
    expert_ids = g_sel[:, None] * EXPERTS_PER_GROUP + top_local

    n_pairs = n_tok * TOP_K
    flat_e = expert_ids.reshape(-1).astype(jnp.int32)
    flat_w = top_w.reshape(-1)
    flat_tok = jnp.repeat(jnp.arange(n_tok, dtype=jnp.int32), TOP_K)
    order = jnp.argsort(flat_e)
    se, stok, sw = flat_e[order], flat_tok[order], flat_w[order]
    counts = jnp.zeros((N_EXPERTS,), jnp.int32).at[flat_e].add(1)
    padded = ((counts + DISPATCH_BLOCK - 1) // DISPATCH_BLOCK) * DISPATCH_BLOCK
    start = jnp.cumsum(counts) - counts
    pend = jnp.cumsum(padded)
    pstart = pend - padded
    dest = pstart[se] + (jnp.arange(n_pairs, dtype=jnp.int32) - start[se])
    n_blocks = -(-n_pairs // DISPATCH_BLOCK) + N_EXPERTS
    rows = n_blocks * DISPATCH_BLOCK
    x_disp = jnp.zeros((rows, d), h.dtype).at[dest].set(xt[stok])
    w_disp = jnp.zeros((rows,), f32).at[dest].set(sw)
    tok_disp = jnp.full((rows,), n_tok, jnp.int32).at[dest].set(stok)
    block_start = jnp.arange(n_blocks, dtype=jnp.int32) * DISPATCH_BLOCK
    block_expert = jnp.minimum(jnp.searchsorted(pend, block_start, side='right'), N_EXPERTS - 1)

    def expert_block(args):
        xb, e = args
        hid = jax.nn.silu(xb @ w_gate[e]) * (xb @ w_up[e])
        return hid @ w_down[e]

    y_disp = lax.map(expert_block, (x_disp.reshape(n_blocks, DISPATCH_BLOCK, d), block_expert)).reshape(rows, d)
    y_disp = y_disp * w_disp[:, None].astype(y_disp.dtype)
    out = jnp.zeros((n_tok, d), h.dtype).at[tok_disp].add(y_disp, mode='drop')
    return out.reshape(bsz, seq, d)


def _normal(key, shape, scale):
    return jax.random.normal(key, shape, jnp.float32) * scale


def _gain(key):
    return 1.0 + _normal(key, (D_MODEL,), 0.02)


def _moe_params(key):
    k = jax.random.split(key, 7)
    return (
        _normal(k[0], (D_MODEL, N_EXPERT_GROUPS), D_MODEL ** -0.5),
        _normal(k[1], (N_EXPERT_GROUPS,), 0.01),
        _normal(k[2], (D_MODEL, N_EXPERTS), D_MODEL ** -0.5),
        _normal(k[3], (N_EXPERTS,), 0.01),
        _normal(k[4], (N_EXPERTS, D_MODEL, D_EXPERT), D_MODEL ** -0.5),
        _normal(k[5], (N_EXPERTS, D_MODEL, D_EXPERT), D_MODEL ** -0.5),
        _normal(k[6], (N_EXPERTS, D_EXPERT, D_MODEL), D_EXPERT ** -0.5),
    )


def setup_inputs(seed: int = 0) -> dict:
    key = jax.random.key(seed)
    ks = jax.random.split(key, 24)
    x = jax.random.normal(ks[0], (BATCH, SEQ, D_MODEL), jnp.float32)
    n_idx = jnp.arange(SSM_STATE, dtype=jnp.float32)
    lam_re = -0.5 + _normal(ks[2], (N_SSM_GROUPS, SSM_STATE), 0.01)
    lam_im = math.pi * n_idx[None, :] + _normal(ks[3], (N_SSM_GROUPS, SSM_STATE), 0.01)
    log_step = jax.random.uniform(ks[4], (N_SSM_GROUPS,), jnp.float32, math.log(STEP_MIN), math.log(STEP_MAX))
    b_scale = (2.0 * SSM_GROUP_CH) ** -0.5
    c_scale = SSM_STATE ** -0.5
    m0 = _moe_params(ks[14])
    m1 = _moe_params(ks[15])
    return {
        "x": x,
        "l0_mix_norm": _gain(ks[1]),
        "l0_s5_w_in": _normal(ks[5], (D_MODEL, D_SSM), D_MODEL ** -0.5),
        "l0_s5_lambda_re": lam_re,
        "l0_s5_lambda_im": lam_im,
        "l0_s5_b_re": _normal(ks[6], (N_SSM_GROUPS, SSM_STATE, SSM_GROUP_CH), b_scale),
        "l0_s5_b_im": _normal(ks[7], (N_SSM_GROUPS, SSM_STATE, SSM_GROUP_CH), b_scale),
        "l0_s5_c_re": _normal(ks[8], (N_SSM_GROUPS, SSM_GROUP_CH, SSM_STATE), c_scale),
        "l0_s5_c_im": _normal(ks[9], (N_SSM_GROUPS, SSM_GROUP_CH, SSM_STATE), c_scale),
        "l0_s5_d": _normal(ks[10], (D_SSM,), 1.0),
        "l0_s5_log_step": log_step,
        "l0_s5_w_glu": _normal(ks[11], (D_SSM, D_SSM), D_SSM ** -0.5),
        "l0_s5_b_glu": _normal(ks[12], (D_SSM,), 0.01),
        "l0_s5_w_out": _normal(ks[13], (D_SSM, D_MODEL), D_SSM ** -0.5),
        "l0_ffn_norm": _gain(ks[16]),
        "l0_moe_w_group": m0[0],
        "l0_moe_b_group": m0[1],
        "l0_moe_w_expert": m0[2],
        "l0_moe_b_expert": m0[3],
        "l0_moe_w_gate": m0[4],
        "l0_moe_w_up": m0[5],
        "l0_moe_w_down": m0[6],
        "l1_mix_norm": _gain(ks[17]),
        "l1_fox_w_in": _normal(ks[18], (D_MODEL, 4 * D_MODEL + FOX_HEADS), D_MODEL ** -0.5),
        "l1_fox_b_forget": jax.random.uniform(ks[19], (FOX_HEADS,), jnp.float32, FORGET_BIAS_LO, FORGET_BIAS_HI),
        "l1_fox_w_out": _normal(ks[20], (D_MODEL, D_MODEL), D_MODEL ** -0.5),
        "l1_ffn_norm": _gain(ks[21]),
        "l1_moe_w_group": m1[0],
        "l1_moe_b_group": m1[1],
        "l1_moe_w_expert": m1[2],
        "l1_moe_b_expert": m1[3],
        "l1_moe_w_gate": m1[4],
        "l1_moe_w_up": m1[5],
        "l1_moe_w_down": m1[6],
        "final_norm": _gain(ks[22]),
    }


def reference(x, l0_mix_norm, l0_s5_w_in, l0_s5_lambda_re, l0_s5_lambda_im, l0_s5_b_re, l0_s5_b_im,
              l0_s5_c_re, l0_s5_c_im, l0_s5_d, l0_s5_log_step, l0_s5_w_glu, l0_s5_b_glu, l0_s5_w_out,
              l0_ffn_norm, l0_moe_w_group, l0_moe_b_group, l0_moe_w_expert, l0_moe_b_expert,
              l0_moe_w_gate, l0_moe_w_up, l0_moe_w_down,
              l1_mix_norm, l1_fox_w_in, l1_fox_b_forget, l1_fox_w_out,
              l1_ffn_norm, l1_moe_w_group, l1_moe_b_group, l1_moe_w_expert, l1_moe_b_expert,
              l1_moe_w_gate, l1_moe_w_up, l1_moe_w_down,
              final_norm):
    mix_norms = [l0_mix_norm, l1_mix_norm]
    ffn_norms = [l0_ffn_norm, l1_ffn_norm]
    mixer_params = [
        (l0_s5_w_in, l0_s5_lambda_re, l0_s5_lambda_im, l0_s5_b_re, l0_s5_b_im, l0_s5_c_re, l0_s5_c_im,
         l0_s5_d, l0_s5_log_step, l0_s5_w_glu, l0_s5_b_glu, l0_s5_w_out),
        (l1_fox_w_in, l1_fox_b_forget, l1_fox_w_out),
    ]
    moe_params = [
        (l0_moe_w_group, l0_moe_b_group, l0_moe_w_expert, l0_moe_b_expert, l0_moe_w_gate, l0_moe_w_up, l0_moe_w_down),
        (l1_moe_w_group, l1_moe_b_group, l1_moe_w_expert, l1_moe_b_expert, l1_moe_w_gate, l1_moe_w_up, l1_moe_w_down),
    ]
    h = x
    for i in range(DEPTH):
        hn = rms_norm(h, mix_norms[i])
        if i % N_MIXERS == 0:
            h = h + s5_mixer(hn, *mixer_params[i])
        else:
            h = h + fox_mixer(hn, *mixer_params[i])
        h = h + hier_moe(rms_norm(h, ffn_norms[i]), *moe_params[i])
    return rms_norm(h, final_norm)
```

```cpp
#include <hip/hip_runtime.h>
#include <cstdio>
#include <cstdint>

namespace pg8 {
#define PG8_LAS __attribute__((address_space(3)))
typedef unsigned short bf16_t;
typedef short bf16x8 __attribute__((ext_vector_type(8)));
typedef float f32x4 __attribute__((ext_vector_type(4)));
typedef float f32x2 __attribute__((ext_vector_type(2)));
typedef unsigned u32x4 __attribute__((ext_vector_type(4)));
constexpr int BM = 256, BK = 64, HALF = 128, HTB = HALF * BK * 2  , STAGE_BYTES = 8 * HTB, NXCD = 8, WGM = 8;

__host__ __device__ __forceinline__ int lds_byte(int r, int c) { const int st = (r >> 4) * 2 + (c >> 5), rr = r & 15, cc = c & 31, ob = rr * 64 + cc * 2; return st * 1024 + (ob ^ (((ob >> 9) & 1) << 5)); }
__host__ __device__ __forceinline__ void stage_rc(int b, int& R, int& C) { const int st = b / 1024, sb = b % 1024, swz = sb ^ (((sb >> 9) & 1) << 5); R = (st >> 1) * 16 + swz / 64; C = (st & 1) * 32 + (swz % 64) / 2; }
__host__ __device__ __forceinline__ int perm32(int rho) { const int n = rho >> 4, i = rho & 15; return 8 * (i >> 2) + 4 * n + (i & 3); }

struct Unit { int pm, pn, half; };
struct UPtr { const char* A; const char* B; };

struct TileOrder {
    int nM, nN, nwg, G, c;
    __device__ __forceinline__ void init(int nM_, int nN_, int G_, int c_) { nM = nM_; nN = nN_; nwg = nM * nN; G = G_; c = c_; split = 0; }
    int split;
    __device__ __forceinline__ bool next(int i, Unit& u) const {
        if (split) { const int full = (nwg / G) * G, rem = nwg - full;
            if (rem > 0 && 2 * rem <= G && i == nwg / G) { if (c >= 2 * rem) return false; Unit t; const bool ok = next_lin((long)full + (c >> 1), t); u = t; u.half = c & 1; return ok; } }
        return next_lin((long)i * G + c, u);
    }
    __device__ __forceinline__ bool next_lin(const long L, Unit& u) const {
        if (L >= nwg) return false;
        int wgid = (int)L; { const int q = nwg / NXCD, r = nwg % NXCD, xcd = wgid % NXCD, off = wgid / NXCD; wgid = (xcd < r ? xcd * (q + 1) : r * (q + 1) + (xcd - r) * q) + off; }
        const int nig = WGM * nN, gid = wgid / nig, fm = gid * WGM, gsz = (nM - fm) < WGM ? (nM - fm) : WGM;
        u.pm = fm + ((wgid % nig) % gsz); u.pn = (wgid % nig) / gsz; u.half = -1; return true;
    }
};

__device__ __forceinline__ unsigned cvt_pk_bf16(float lo, float hi) { unsigned r; asm volatile("v_cvt_pk_bf16_f32 %0, %1, %2" : "=v"(r) : "v"(lo), "v"(hi)); return r; }
__device__ __forceinline__ float bf_lo(unsigned w) { return __uint_as_float(w << 16); }
__device__ __forceinline__ float bf_hi(unsigned w) { return __uint_as_float(w & 0xffff0000u); }

template <class Epi, class Sched, bool ALIGN_EPI>
__device__ __forceinline__ void gemm_phase(PG8_LAS unsigned char* lds, const int tid, const int K, const int lda, const int ldb, const Sched& S, const Epi& E) {
    const int wid = __builtin_amdgcn_readfirstlane(tid >> 6), lane = tid & 63, wr = wid >> 2, wc = wid & 3, fr = lane & 15, fq = lane >> 4;
    const int nt = K / BK;
    unsigned voffB[2], offC[2][2], offN[2][2];
    const unsigned hstepA = (unsigned)HALF * (unsigned)lda * 2u;
    const size_t hstepB = (size_t)HALF * ldb * 2;
#pragma unroll
    for (int i = 0; i < 2; ++i) { int R, C; stage_rc(tid * 16 + i * 8192, R, C); const int Rb = Epi::PERM ? ((R & ~31) + perm32(R & 31)) : R;
        offC[0][i] = (unsigned)(R * lda + C) * 2u; offC[1][i] = offC[0][i] + hstepA; voffB[i] = (unsigned)(Rb * ldb + C) * 2u; }
    const size_t kstep = (size_t)(BK * 2);
    const unsigned ldsw = (unsigned)wid * 1024u;
    const int aoff = lds_byte(wr * 64 + fr, fq * 8), boff = lds_byte(wc * 32 + fr, fq * 8);
#define PG8_SA(b, h) (((b) * 2 + (h)) * HTB)
#define PG8_SB(b, h) ((4 + (b) * 2 + (h)) * HTB)
#define PG8_STAGEB(bufoff, gbase) do { _Pragma("unroll") for (int _i = 0; _i < 2; ++_i) \
        __builtin_amdgcn_global_load_lds((const unsigned*)((const char*)(gbase) + voffB[_i]), (PG8_LAS unsigned*)(lds + (bufoff) + ldsw + _i * 8192), 16, 0, 0); } while (0)
#define PG8_STAGEA(bufoff, gbase, O, h) do { _Pragma("unroll") for (int _i = 0; _i < 2; ++_i) \
        __builtin_amdgcn_global_load_lds((const unsigned*)((const char*)(gbase) + (Sched::GATHER ? (size_t)0 : (size_t)(h) * hstepA) + (O)[Sched::GATHER ? (h) : 0][_i]), (PG8_LAS unsigned*)(lds + (bufoff) + ldsw + _i * 8192), 16, 0, 0); } while (0)
#define PG8_LDA(dst, b, h) do { _Pragma("unroll") for (int m = 0; m < 4; ++m) _Pragma("unroll") for (int k = 0; k < 2; ++k) dst[m][k] = *(const PG8_LAS bf16x8*)(lds + PG8_SA(b, h) + aoff + m * 2048 + k * 1024); } while (0)
#define PG8_LDB(dst, b, h) do { _Pragma("unroll") for (int n = 0; n < 2; ++n) _Pragma("unroll") for (int k = 0; k < 2; ++k) dst[n][k] = *(const PG8_LAS bf16x8*)(lds + PG8_SB(b, h) + boff + n * 2048 + k * 1024); } while (0)
#define PG8_MMA(ai, bj, At, Bt) do { __builtin_amdgcn_s_setprio(1); _Pragma("unroll") for (int m = 0; m < 4; ++m) _Pragma("unroll") for (int n = 0; n < 2; ++n) _Pragma("unroll") for (int k = 0; k < 2; ++k) \
        acc[ai][bj][m][n] = __builtin_amdgcn_mfma_f32_16x16x32_bf16(Bt[n][k], At[m][k], acc[ai][bj][m][n], 0, 0, 0); __builtin_amdgcn_s_setprio(0); } while (0)
#define PG8_WAIT_V(n) asm volatile("s_waitcnt vmcnt(" #n ")" ::: "memory")
#define PG8_WAIT_L(n) asm volatile("s_waitcnt lgkmcnt(" #n ")" ::: "memory")
#define PG8_BAR __builtin_amdgcn_s_barrier()
#define PG8_SCHED __builtin_amdgcn_sched_barrier(0)
    Unit cur, nxt; int ui = 0;
    if (!S.next(0, cur)) return;
    f32x4 acc[2][2][4][2];
#pragma unroll
    for (int a = 0; a < 2; ++a)
#pragma unroll
        for (int b = 0; b < 2; ++b)
#pragma unroll
            for (int m = 0; m < 4; ++m)
#pragma unroll
                for (int n = 0; n < 2; ++n) acc[a][b][m][n] = (f32x4){0.f, 0.f, 0.f, 0.f};
    bf16x8 At[4][2], B0[2][2], B1[2][2];
    UPtr cp = S.ptrs(cur);
    const char* cA = cp.A; const char* cB = cp.B;
    if constexpr (Sched::GATHER) { S.gather(cur, offC); }
    bool act0 = true, act1 = true;
    if constexpr (Sched::ROWSKIP) { const int v = S.valid(cur); act0 = wr * 64 < v && cur.half != 1; act1 = HALF + wr * 64 < v && cur.half != 0; }
#pragma unroll
    for (int h = 0; h < 2; ++h)
#pragma unroll
        for (int i = 0; i < 2; ++i) offN[h][i] = offC[h][i];
    PG8_STAGEB(PG8_SB(0, 0), cB); PG8_STAGEB(PG8_SB(0, 1), cB + hstepB); PG8_STAGEA(PG8_SA(0, 0), cA, offC, 0); PG8_STAGEA(PG8_SA(0, 1), cA, offC, 1);
    if (wr == 1) PG8_BAR;
    PG8_WAIT_V(2); PG8_BAR;
    PG8_STAGEB(PG8_SB(1, 0), cB + kstep); PG8_STAGEA(PG8_SA(1, 0), cA + kstep, offC, 0); PG8_STAGEB(PG8_SB(1, 1), cB + hstepB + kstep);
    PG8_WAIT_V(6); PG8_BAR;
    for (;;) {
        const bool has_next = S.next(ui + 1, nxt);
        const char* nA = cA; const char* nB = cB;
        if (has_next) { const UPtr np = S.ptrs(nxt); nA = np.A; nB = np.B; if constexpr (Sched::GATHER) { S.gather(nxt, offN); } }
        for (int t = 0; t < nt; t += 2) {
            const bool last = (t == nt - 2);
            const char* a1 = cA + (size_t)(t + 1) * kstep;
            const char* a2 = last ? nA : cA + (size_t)(t + 2) * kstep; const char* b2 = last ? nB : cB + (size_t)(t + 2) * kstep;
            const char* a3 = a2 + kstep; const char* b3 = b2 + kstep;
            unsigned o2[2][2];
#pragma unroll
            for (int h = 0; h < 2; ++h)
#pragma unroll
                for (int i = 0; i < 2; ++i) o2[h][i] = (Sched::GATHER && last) ? offN[h][i] : offC[h][i];
            PG8_LDB(B0, 0, 0); PG8_LDB(B1, 0, 1); PG8_SCHED; if (act0) PG8_LDA(At, 0, 0); PG8_STAGEA(PG8_SA(1, 1), a1, offC, 1);
            PG8_WAIT_V(8); PG8_WAIT_L(0); PG8_BAR; if (act0) { PG8_MMA(0, 0, At, B0); PG8_MMA(0, 1, At, B1); } PG8_BAR; PG8_SCHED;
            if (act1) PG8_LDA(At, 0, 1); PG8_STAGEB(PG8_SB(0, 0), b2); PG8_STAGEB(PG8_SB(0, 1), b2 + hstepB); PG8_STAGEA(PG8_SA(0, 0), a2, o2, 0);
            PG8_WAIT_V(8); PG8_WAIT_L(0); PG8_BAR; if (act1) { PG8_MMA(1, 0, At, B0); PG8_MMA(1, 1, At, B1); } PG8_BAR; PG8_SCHED;
            PG8_LDB(B0, 1, 0); PG8_LDB(B1, 1, 1); PG8_SCHED; if (act0) PG8_LDA(At, 1, 0); PG8_STAGEA(PG8_SA(0, 1), a2, o2, 1);
            PG8_WAIT_V(8); PG8_WAIT_L(0); PG8_BAR; if (act0) { PG8_MMA(0, 0, At, B0); PG8_MMA(0, 1, At, B1); } PG8_BAR; PG8_SCHED;
            if (act1) PG8_LDA(At, 1, 1); PG8_STAGEB(PG8_SB(1, 0), b3); PG8_STAGEB(PG8_SB(1, 1), b3 + hstepB); PG8_STAGEA(PG8_SA(1, 0), a3, o2, 0);
            PG8_WAIT_V(8); PG8_WAIT_L(0); PG8_BAR; if (act1) { PG8_MMA(1, 0, At, B0); PG8_MMA(1, 1, At, B1); } PG8_BAR; PG8_SCHED;
        }
        if constexpr (ALIGN_EPI) { if (wr == 0) PG8_BAR; }
        if constexpr (!Epi::AFTER_DRAIN) { E(acc, cur, wr, wc, fr, fq); }
        if (!has_next) break;
#pragma unroll
        for (int a = 0; a < 2; ++a)
#pragma unroll
            for (int b = 0; b < 2; ++b)
#pragma unroll
                for (int m = 0; m < 4; ++m)
#pragma unroll
                    for (int n = 0; n < 2; ++n) acc[a][b][m][n] = (f32x4){0.f, 0.f, 0.f, 0.f};
        cur = nxt; cA = nA; cB = nB; ++ui;
        if constexpr (Sched::ROWSKIP) { const int v = S.valid(cur); act0 = wr * 64 < v && cur.half != 1; act1 = HALF + wr * 64 < v && cur.half != 0; }
        if constexpr (Sched::GATHER) {
#pragma unroll
            for (int h = 0; h < 2; ++h)
#pragma unroll
                for (int i = 0; i < 2; ++i) offC[h][i] = offN[h][i];
        }
        if constexpr (ALIGN_EPI) { if (wr == 1) PG8_BAR; }
    }
    PG8_WAIT_V(0);
    if constexpr (!ALIGN_EPI) { if (wr == 0) PG8_BAR; }
    PG8_BAR;
    if constexpr (Epi::AFTER_DRAIN) { E.fused(acc, cur, wr, wc, fr, fq, lds, wid, lane); }
#undef PG8_SA
#undef PG8_SB
#undef PG8_STAGEA
#undef PG8_STAGEB
#undef PG8_LDA
#undef PG8_LDB
#undef PG8_MMA
#undef PG8_WAIT_V
#undef PG8_WAIT_L
#undef PG8_BAR
#undef PG8_SCHED
}
}

constexpr int NWAVES = 8;
constexpr int NB = 8, SEQ = 2048, D = 2048, M = NB * SEQ;
constexpr int DS = 1024, NG = 64, GC = 16, NST = 64;
constexpr int LCH = 32, NCH = SEQ / LCH;
constexpr int KP = LCH * GC + 2 * NST;
constexpr int NH = 16, HD = 128;
constexpr int NE = 64, DE = 512, NEG = 8, EPG = 8;
constexpr int FOXN = 4 * D + NH;
constexpr float RMS_EPS = 1e-6f;
constexpr int RT_ROWS = 96;
constexpr int MAXMT = 192;

constexpr size_t MiB = 1u << 20;
constexpr size_t WS_CTL = 0, CTL_ZERO_BYTES = 1 * MiB;
constexpr size_t WS_WS5IN  = 1 * MiB;
constexpr size_t WS_WGLU   = WS_WS5IN + 4 * MiB;
constexpr size_t WS_WS5OUT = WS_WGLU + 2 * MiB;
constexpr size_t WS_WFOXIN = WS_WS5OUT + 4 * MiB;
constexpr size_t WS_WFOXOUT = WS_WFOXIN + 32 * MiB;
constexpr size_t WS_WR     = WS_WFOXOUT + 8 * MiB;
constexpr size_t WS_WF     = WS_WR + 1 * MiB;
constexpr size_t WS_AL     = WS_WF + 512 * 1024;
constexpr size_t WS_LF     = WS_AL + 512 * 1024;
constexpr size_t WS_CUMB   = WS_LF + 1 * MiB;
constexpr size_t WS_PW     = WS_CUMB + 1 * MiB;
constexpr size_t WS_TOKL   = WS_PW + 1 * MiB;
constexpr size_t WS_SS     = 60 * MiB;
constexpr size_t WS_RSTD   = 62 * MiB;
constexpr size_t WS_WGU    = 64 * MiB;
constexpr size_t WS_WDN    = WS_WGU + 512 * MiB;
constexpr size_t WS_HN     = WS_WDN + 256 * MiB;
constexpr size_t WS_H2     = WS_HN + 64 * MiB;
constexpr size_t WS_Q      = WS_H2 + 128 * MiB;
constexpr size_t WS_K      = WS_Q + 64 * MiB, WS_V = WS_K + 64 * MiB, WS_SG = WS_V + 64 * MiB;
constexpr size_t WS_R1     = WS_SG + 64 * MiB;
constexpr size_t WS_TT     = WS_R1;
constexpr size_t WS_PT     = WS_TT + 40 * MiB;
constexpr size_t WS_UA     = WS_PT + 16 * MiB;
constexpr size_t WS_GL     = WS_UA + 40 * MiB;
constexpr size_t WS_OG     = WS_GL + 32 * MiB;
constexpr size_t WS_YP     = WS_R1;
constexpr size_t WS_HID    = WS_YP + 128 * MiB;
constexpr size_t WS_TOKW   = WS_R1 + 176 * MiB;
constexpr size_t WS_TOKR   = WS_TOKW + 4 * MiB;
constexpr size_t WS_END    = WS_TOKR + 4 * MiB;
static_assert(WS_TOKL + 4 * MiB <= WS_WGU && WS_OG + 32 * MiB <= WS_END && WS_HID + 48 * MiB <= WS_END, "d_ws map");
constexpr int CW_TMO = 0, CW_CODE = 1, CW_NPRE = 8;
constexpr int CW_BAR = 4096;
constexpr int CW_CNT = 16384;

constexpr int RING_OFF = 0, RING_BYTES = 131072;
constexpr int LDSCTL_OFF = 151552, MISC_OFF = LDSCTL_OFF + 320;
constexpr int MOE_OFF = LDSCTL_OFF + 512;
constexpr int LDS_BYTES = 155648;
static_assert(MOE_OFF + (64 * 3 + 4 + 2 * MAXMT) * 4 <= LDS_BYTES, "LDS map");

#define GAS __attribute__((address_space(1)))
#define LAS __attribute__((address_space(3)))
typedef unsigned short bf16;
typedef unsigned v4u __attribute__((ext_vector_type(4)));
typedef unsigned v2u __attribute__((ext_vector_type(2)));
typedef float f32x4 __attribute__((ext_vector_type(4)));
typedef float f32x16 __attribute__((ext_vector_type(16)));
typedef short bf16x8 __attribute__((ext_vector_type(8)));
typedef GAS unsigned gu32;
#define RLX_AGENT __ATOMIC_RELAXED, __HIP_MEMORY_SCOPE_AGENT
#define LDS_WAIT() asm volatile("s_waitcnt lgkmcnt(0)" ::: "memory")
#define VM_WAIT() asm volatile("s_waitcnt vmcnt(0)" ::: "memory")
__device__ __forceinline__ unsigned f2bf(float f) { unsigned u = __builtin_bit_cast(unsigned, f); return (u + 0x7fffu + ((u >> 16) & 1u)) >> 16; }
__device__ __forceinline__ unsigned pk2(float lo, float hi) { return f2bf(lo) | (f2bf(hi) << 16); }

#define XB_TMO      128
#define XB_XCNT(j)  (256  + 64 * (j))
#define XB_XSUB(j)  (1280 + 64 * (j))
#define XB_XGEN(j)  (2304 + 64 * (j))
#define XB_TOP      3328
#define XB_TOPGEN   3392
#define XCD_BAR_WORDS 3456
#define XB_SPIN_CAP (1u << 18)

__device__ __forceinline__ unsigned xb_ld(unsigned* p)              { return __hip_atomic_load(p, __ATOMIC_RELAXED, __HIP_MEMORY_SCOPE_AGENT); }
__device__ __forceinline__ unsigned xb_add(unsigned* p, unsigned v) { return __hip_atomic_fetch_add(p, v, __ATOMIC_RELAXED, __HIP_MEMORY_SCOPE_AGENT); }
__device__ __forceinline__ unsigned xb_xcc_id() { return (unsigned)__builtin_amdgcn_s_getreg((3 << 11) | 20) & 0xFu; }
#define XB_SPIN(cond, bar) do { unsigned _sp = 0; while (cond) { __builtin_amdgcn_s_sleep(1); \
    if ((++_sp & 255u) == 0u) { if (xb_ld(&(bar)[XB_TMO])) break; if (_sp > XB_SPIN_CAP) { atomicAdd(&(bar)[XB_TMO], 1u); break; } } } } while (0)

struct XcdBarrier {
    unsigned* bar; unsigned x;
    volatile LAS unsigned* st;
};
__device__ __forceinline__ XcdBarrier xcd_barrier_post(unsigned* bar, volatile LAS unsigned* st) {
    XcdBarrier b; b.bar = bar; b.x = xb_xcc_id(); b.st = st;
    if (threadIdx.x == 0) (void)xb_add(&bar[XB_XCNT(b.x)], 1u);
    return b;
}
__device__ __forceinline__ void xcd_barrier_complete(unsigned* bar, unsigned x, unsigned& nloc, unsigned& nx) {
    const unsigned G = gridDim.x * gridDim.y * gridDim.z;
    unsigned sum, cnt, mine, sp = 0u;
    for (;;) {
        sum = 0u; cnt = 0u; mine = 0u;
#pragma unroll
        for (unsigned j = 0; j < 16; ++j) { const unsigned c = xb_ld(&bar[XB_XCNT(j)]); sum += c; cnt += (c > 0u) ? 1u : 0u; mine = (j == x) ? c : mine; }
        if (sum == G) break;
        __builtin_amdgcn_s_sleep(1);
        if ((++sp & 255u) == 0u) { if (xb_ld(&bar[XB_TMO])) break; if (sp > XB_SPIN_CAP) { atomicAdd(&bar[XB_TMO], 1u); break; } }
    }
    nloc = mine > 0u ? mine : 1u; nx = cnt > 0u ? cnt : 1u;
}
__device__ __forceinline__ void xcd_barrier(const XcdBarrier& b, const int tid) {
    asm volatile("s_waitcnt vmcnt(0)" ::: "memory");
    __syncthreads();
    if (tid == 0) {
        unsigned* bar = b.bar;
        const unsigned bx = xb_xcc_id();
        __builtin_amdgcn_s_waitcnt(0);
        unsigned nloc = b.st[0], nx = b.st[1];
        if (nloc == 0u) { xcd_barrier_complete(bar, bx, nloc, nx); b.st[0] = nloc; b.st[1] = nx; }
        const unsigned old = xb_add(&bar[XB_XSUB(bx)], 1u);
        const unsigned gen = old / nloc;
        if (old + 1u == (gen + 1u) * nloc) {
            __builtin_amdgcn_fence(__ATOMIC_RELEASE, "agent");
            asm volatile("s_waitcnt vmcnt(0)" ::: "memory");
            const unsigned og = xb_add(&bar[XB_TOP], 1u);
            const unsigned tg = og / nx;
            if (og + 1u == (tg + 1u) * nx) { xb_add(&bar[XB_TOPGEN], 1u); xb_add(&bar[XB_XGEN(bx)], 1u); __builtin_amdgcn_fence(__ATOMIC_ACQUIRE, "agent"); }
            else { __builtin_amdgcn_fence(__ATOMIC_ACQUIRE, "agent"); XB_SPIN(xb_ld(&bar[XB_TOPGEN]) == tg, bar); xb_add(&bar[XB_XGEN(bx)], 1u); }
            asm volatile("s_waitcnt vmcnt(0)" ::: "memory");
        } else {
            __builtin_amdgcn_fence(__ATOMIC_ACQUIRE, "agent");
            XB_SPIN(xb_ld(&bar[XB_XGEN(bx)]) == gen, bar);
            asm volatile("s_waitcnt vmcnt(0)" ::: "memory");
        }
    }
    __syncthreads();
}

struct Frame {
    LAS unsigned char* lds;
    volatile LAS unsigned* MISC;
    gu32* ctl;
    int tid, lane, wave;
    int vcu, G;
    unsigned char* ws;
};
__device__ __forceinline__ float wave_sum(float v) {
#pragma unroll
    for (int o = 1; o < 64; o <<= 1) v += __shfl_xor(v, o);
    return v;
}
__device__ __forceinline__ float sigmoidf_(float x) { return __builtin_amdgcn_rcpf(1.f + __builtin_amdgcn_exp2f(-1.4426950408889634f * x)); }
__device__ __forceinline__ float gelu_tanh_(float x) {
    const float u = x * (1.f + 0.044715f * x * x);
    return x * __builtin_amdgcn_rcpf(1.f + __builtin_amdgcn_exp2f(-2.302208198f * u));
}

struct Args { const float* in[35]; float* out; unsigned char* ws; int ph_lo, ph_hi; };

__device__ __forceinline__ void p0_transpose_item(const float* W, int K, int N, int k0, int n0, bf16* dst0, LAS float* scr, int lane) {
    const int cn = n0 + (lane & 31); const bool ok = cn < N;
    float ld[32];
    const GAS float* Wp = (const GAS float*)W + (size_t)(k0 + (lane >> 5)) * N + cn;
#pragma unroll
    for (int i = 0; i < 32; ++i) ld[i] = ok ? Wp[(size_t)(2 * i) * N] : 0.f;
#pragma unroll
    for (int i = 0; i < 32; ++i) scr[(2 * i + (lane >> 5)) * 33 + (lane & 31)] = ld[i];
    LDS_WAIT(); asm volatile("" ::: "memory");
    const int c = lane & 7;
#pragma unroll
    for (int j = 0; j < 4; ++j) { const int n = (lane >> 3) + 8 * j; const LAS float* s = scr + (8 * c) * 33 + n;
        v4u o; o.x = pk2(s[0 * 33], s[1 * 33]); o.y = pk2(s[2 * 33], s[3 * 33]); o.z = pk2(s[4 * 33], s[5 * 33]); o.w = pk2(s[6 * 33], s[7 * 33]);
        *(GAS v4u*)(dst0 + (size_t)n * K + k0 + 8 * c) = o; }
    LDS_WAIT(); asm volatile("" ::: "memory");
}
__device__ __forceinline__ void p0_router_item(const float* wg, const float* we, const float* gain, bf16* WR, int kb, int ng, int lane) {
    const int k = kb * 64 + lane; const float g = gain[k];
    const GAS f32x4* src = ng == 0 ? (const GAS f32x4*)(wg + (size_t)k * 8) : (const GAS f32x4*)(we + (size_t)k * 64 + (ng - 1) * 8);
    const f32x4 v0 = src[0], v1 = src[1];
    GAS bf16* dst = (GAS bf16*)WR + (size_t)(ng == 0 ? 0 : 8 + (ng - 1) * 8) * D + k;
    dst[0 * D] = (bf16)f2bf(g * v0.x); dst[1 * D] = (bf16)f2bf(g * v0.y); dst[2 * D] = (bf16)f2bf(g * v0.z); dst[3 * D] = (bf16)f2bf(g * v0.w);
    dst[4 * D] = (bf16)f2bf(g * v1.x); dst[5 * D] = (bf16)f2bf(g * v1.y); dst[6 * D] = (bf16)f2bf(g * v1.z); dst[7 * D] = (bf16)f2bf(g * v1.w);
    if (ng == 8) for (int n = 72; n < RT_ROWS; ++n) WR[(size_t)n * D + k] = (bf16)0;
}
struct S5P { const float *lre, *lim, *bre, *bim, *cre, *cim, *lstep; };
__device__ __forceinline__ void s5_cis(double th, float& c, float& s, float& sh) {
    const double k = __builtin_rint(th * 0.15915494309189535);
    const float r = (float)__builtin_fma(-k, 6.283185307179586, th);
    c = cosf(r); s = sinf(r); sh = sinf(0.5f * r);
}
__device__ __forceinline__ void s5_pow(const S5P& P, int g, int n, int m, float& pr, float& pi) {
    const float lr = P.lre[g * 64 + n], li = P.lim[g * 64 + n], step = expf(P.lstep[g]);
    float c, s, sh; s5_cis((double)m * ((double)li * (double)step), c, s, sh);
    const float mag = expf((float)m * (lr * step));
    pr = mag * c; pi = mag * s;
}
__device__ __forceinline__ void s5_zoh(const S5P& P, int g, int n, float& fr, float& fi) {
    const float lr = P.lre[g * 64 + n], li = P.lim[g * 64 + n], step = expf(P.lstep[g]);
    float c, s, sh; s5_cis((double)li * (double)step, c, s, sh);
    const float em1 = expm1f(lr * step), mag = em1 + 1.f;
    const float nr = em1 * c - 2.f * sh * sh, ni = mag * s;
    const float den = lr * lr + li * li;
    fr = (nr * lr + ni * li) / den; fi = (ni * lr - nr * li) / den;
}
__device__ __forceinline__ void s5_item_kernel(const S5P& P, bf16* TT, int g, int m, int lane) {
    float pr, pi, fr, fi; s5_pow(P, g, lane, m, pr, pi); s5_zoh(P, g, lane, fr, fi);
    const int co = lane >> 2, ci0 = (lane & 3) * 4;
    float a0 = 0.f, a1 = 0.f, a2 = 0.f, a3 = 0.f;
#pragma unroll 8
    for (int n = 0; n < 64; ++n) {
        const float prn = __shfl(pr, n), pin = __shfl(pi, n), frn = __shfl(fr, n), fin = __shfl(fi, n);
        const f32x4 br = *(const f32x4*)(P.bre + (size_t)(g * 64 + n) * 16 + ci0), bi = *(const f32x4*)(P.bim + (size_t)(g * 64 + n) * 16 + ci0);
        const float cr = P.cre[(size_t)(g * 16 + co) * 64 + n], cm = P.cim[(size_t)(g * 16 + co) * 64 + n];
        const float car = cr * prn - cm * pin, cai = cr * pin + cm * prn;
        a0 += car * (frn * br.x - fin * bi.x) - cai * (frn * bi.x + fin * br.x);
        a1 += car * (frn * br.y - fin * bi.y) - cai * (frn * bi.y + fin * br.y);
        a2 += car * (frn * br.z - fin * bi.z) - cai * (frn * bi.z + fin * br.z);
        a3 += car * (frn * br.w - fin * bi.w) - cai * (frn * bi.w + fin * br.w);
    }
    v2u w; w.x = pk2(a0, a1); w.y = pk2(a2, a3); const v2u z = {0u, 0u};
    bf16* Tg = TT + (size_t)g * 512 * KP;
    for (int j = 0; j + m < LCH; ++j) {
        *(GAS v2u*)(Tg + (size_t)((j + m) * 16 + co) * KP + j * 16 + ci0) = w;
        if (m >= 1) *(GAS v2u*)(Tg + (size_t)(j * 16 + co) * KP + (j + m) * 16 + ci0) = z;
    }
}
__device__ __forceinline__ void s5_item_state(const S5P& P, bf16* TT, int g, int i, int lane) {
    float pr, pi; s5_pow(P, g, lane, i + 1, pr, pi);
    bf16* Tg = TT + (size_t)g * 512 * KP;
#pragma unroll
    for (int co = 0; co < 16; ++co) {
        const float cr = P.cre[(size_t)(g * 16 + co) * 64 + lane], cm = P.cim[(size_t)(g * 16 + co) * 64 + lane];
        const float car = cr * pr - cm * pi, cai = cr * pi + cm * pr;
        *(GAS unsigned*)(Tg + (size_t)(i * 16 + co) * KP + 512 + 2 * lane) = pk2(car, -cai);
    }
}
__device__ __forceinline__ void s5_item_p(const S5P& P, bf16* PT, float* AL, int g, int j, int lane) {
    const int n = lane;
    float qr, qi, fr, fi; s5_pow(P, g, n, LCH - 1 - j, qr, qi); s5_zoh(P, g, n, fr, fi);
    bf16* Pg = PT + (size_t)g * 256 * 512;
#pragma unroll
    for (int h = 0; h < 2; ++h) {
        float re[8], im[8];
#pragma unroll
        for (int q = 0; q < 2; ++q) { const f32x4 br = *(const f32x4*)(P.bre + (size_t)(g * 64 + n) * 16 + h * 8 + q * 4), bi = *(const f32x4*)(P.bim + (size_t)(g * 64 + n) * 16 + h * 8 + q * 4);
#pragma unroll
            for (int e = 0; e < 4; ++e) { const float bbr = fr * br[e] - fi * bi[e], bbi = fr * bi[e] + fi * br[e]; re[q * 4 + e] = qr * bbr - qi * bbi; im[q * 4 + e] = qr * bbi + qi * bbr; } }
        v4u wr_, wi_; wr_.x = pk2(re[0], re[1]); wr_.y = pk2(re[2], re[3]); wr_.z = pk2(re[4], re[5]); wr_.w = pk2(re[6], re[7]);
        wi_.x = pk2(im[0], im[1]); wi_.y = pk2(im[2], im[3]); wi_.z = pk2(im[4], im[5]); wi_.w = pk2(im[6], im[7]);
        const v4u z = {0u, 0u, 0u, 0u};
        *(GAS v4u*)(Pg + (size_t)(2 * n) * 512 + j * 16 + h * 8) = wr_;
        *(GAS v4u*)(Pg + (size_t)(2 * n + 1) * 512 + j * 16 + h * 8) = wi_;
        *(GAS v4u*)(Pg + (size_t)(128 + 2 * n) * 512 + j * 16 + h * 8) = z;
        *(GAS v4u*)(Pg + (size_t)(129 + 2 * n) * 512 + j * 16 + h * 8) = z;
    }
    if (j == 0) { float ar, ai; s5_pow(P, g, n, LCH, ar, ai); AL[(g * 64 + n) * 2] = ar; AL[(g * 64 + n) * 2 + 1] = ai; }
}
__device__ __forceinline__ void rms_row_to_bf16(const float* xrow, const float* gain, bf16* orow, int lane) {
    const GAS f32x4* xr = (const GAS f32x4*)xrow + lane; const GAS f32x4* gr = (const GAS f32x4*)gain + lane;
    f32x4 v[8]; float s = 0.f;
#pragma unroll
    for (int j = 0; j < 8; ++j) { v[j] = xr[64 * j]; s += (v[j].x * v[j].x + v[j].y * v[j].y) + (v[j].z * v[j].z + v[j].w * v[j].w); }
    const float rstd = 1.f / sqrtf(wave_sum(s) * (1.f / D) + RMS_EPS);
    GAS v2u* o8 = (GAS v2u*)orow + lane;
#pragma unroll
    for (int j = 0; j < 8; ++j) { const f32x4 g = gr[64 * j]; v2u w; w.x = pk2(v[j].x * rstd * g.x, v[j].y * rstd * g.y); w.y = pk2(v[j].z * rstd * g.z, v[j].w * rstd * g.w); o8[64 * j] = w; }
}

__device__ __forceinline__ void p0_prologue(Frame& F, const Args& a, unsigned char* ws) {
    LAS float* scr = (LAS float*)(F.lds + RING_OFF + F.wave * 16384);
    const int gw = F.vcu * NWAVES + F.wave, NGW = F.G * NWAVES;
    const S5P P{a.in[3], a.in[4], a.in[5], a.in[6], a.in[7], a.in[8], a.in[10]};
    bf16* TT = (bf16*)(ws + WS_TT); bf16* PT = (bf16*)(ws + WS_PT); float* AL = (float*)(ws + WS_AL);
    for (int it = gw; it < 3 * NG * LCH; it += NGW) {
        const int kind = it / (NG * LCH), r = it % (NG * LCH), g = r / LCH, m = r % LCH;
        if (kind == 0) s5_item_kernel(P, TT, g, m, F.lane);
        else if (kind == 1) s5_item_state(P, TT, g, m, F.lane);
        else s5_item_p(P, PT, AL, g, m, F.lane);
    }
    for (int it = gw; it < 2 * 32 * 9; it += NGW) { const int l = it / 288, r = it % 288, kb = r / 9, ng = r % 9;
        p0_router_item(a.in[l ? 27 : 15], a.in[l ? 29 : 17], a.in[l ? 26 : 14], (bf16*)(ws + WS_WR) + (size_t)l * (256 * 1024), kb, ng, F.lane); }
    constexpr int I_S5IN = 32 * 32, I_GLU = 16 * 32, I_S5OUT = 16 * 64, I_FOXIN = 32 * 257, I_FOXOUT = 32 * 64;
    constexpr int NITEMS = I_S5IN + I_GLU + I_S5OUT;
    for (int it = gw; it < NITEMS; it += NGW) {
        int r = it;
        if (r < I_S5IN) { const int kb = r / 32, nb = r % 32; p0_transpose_item(a.in[2], D, DS, kb * 64, nb * 32, (bf16*)(ws + WS_WS5IN) + (size_t)(nb * 32) * D, scr, F.lane); continue; } r -= I_S5IN;
        if (r < I_GLU) { const int kb = r / 32, nb = r % 32; p0_transpose_item(a.in[11], DS, DS, kb * 64, nb * 32, (bf16*)(ws + WS_WGLU) + (size_t)(nb * 32) * DS, scr, F.lane); continue; } r -= I_GLU;
        { const int kb = r / 64, nb = r % 64; p0_transpose_item(a.in[13], DS, D, kb * 64, nb * 32, (bf16*)(ws + WS_WS5OUT) + (size_t)(nb * 32) * DS, scr, F.lane); }
    }
    for (int m = gw; m < M; m += NGW) rms_row_to_bf16(a.in[0] + (size_t)m * D, a.in[1], (bf16*)(ws + WS_HN) + (size_t)m * D, F.lane);
}

struct ConvItem { const GAS float* Wp; bf16* dst0; const float* gain; int N, K, k0; bool ok, hasg; };
__device__ __forceinline__ ConvItem moe_conv_item(const Args& a, unsigned char* ws, const int l, int r, const int lane) {
    constexpr int I_EXP = 512;
    ConvItem it; it.gain = a.in[l ? 26 : 14];
    const int kind = r / (64 * I_EXP); it.hasg = kind < 2; r -= kind * (64 * I_EXP);
    const int e = r / I_EXP; r -= e * I_EXP;
    if (kind < 2) {
        const int kb = r / 16, nb = r % 16, n0 = nb * 32;
        it.N = DE; it.K = D; it.k0 = kb * 64;
        it.Wp = (const GAS float*)(a.in[(l ? 31 : 19) + kind] + (size_t)e * D * DE) + (size_t)(it.k0 + (lane >> 3)) * DE + n0 + 4 * (lane & 7);
        it.dst0 = (bf16*)(ws + WS_WGU) + ((size_t)l * NE * 1024 + (size_t)e * 1024 + (n0 >> 7) * 256 + kind * 128 + (n0 & 127)) * D;
    } else {
        const int kb = r / 64, nb = r % 64, n0 = nb * 32;
        it.N = D; it.K = DE; it.k0 = kb * 64;
        it.Wp = (const GAS float*)(a.in[l ? 33 : 21] + (size_t)e * DE * D) + (size_t)(it.k0 + (lane >> 3)) * D + n0 + 4 * (lane & 7);
        it.dst0 = (bf16*)(ws + WS_WDN) + ((size_t)l * NE * D + (size_t)e * D + n0) * DE;
    }
    it.ok = true; return it;
}
__device__ __forceinline__ ConvItem fox_conv_item(const Args& a, unsigned char* ws, int r, const int lane) {
    constexpr int I_FOXIN = 32 * 257;
    ConvItem it; it.K = D; it.gain = a.in[14]; it.hasg = false;
    if (r < I_FOXIN) { const int kb = r / 257, nb = r % 257, n0 = nb * 32, cn = n0 + 4 * (lane & 7);
        it.N = FOXN; it.k0 = kb * 64; it.ok = cn < FOXN;
        it.Wp = (const GAS float*)a.in[23] + (size_t)(it.k0 + (lane >> 3)) * FOXN + (it.ok ? cn : 0);
        it.dst0 = nb < 256 ? (bf16*)(ws + WS_WFOXIN) + (size_t)n0 * D : (bf16*)(ws + WS_WF);
    } else { r -= I_FOXIN; const int kb = r / 64, nb = r % 64, n0 = nb * 32;
        it.N = D; it.k0 = kb * 64; it.ok = true;
        it.Wp = (const GAS float*)a.in[25] + (size_t)(it.k0 + (lane >> 3)) * D + n0 + 4 * (lane & 7);
        it.dst0 = (bf16*)(ws + WS_WFOXOUT) + (size_t)n0 * D; }
    return it;
}
template <int KIND>
__device__ __forceinline__ void conv_range(Frame& F, const Args& a, unsigned char* ws, const int r0, const int r_end, const int worker, const int stride) {
    LAS unsigned char* scrb = F.lds + RING_OFF + F.wave * 16384;
    const int lane = F.lane;
    int r = r0 + worker;
    if (r >= r_end) return;
    const int wk = lane >> 3, l7 = lane & 7, wn = 4 * l7, c = l7;
    __builtin_amdgcn_s_waitcnt(0x0F70);
    if constexpr (KIND < 2) {
        const GAS f32x4* gsrc = (const GAS f32x4*)a.in[KIND ? 26 : 14];
#pragma unroll
        for (int i = 0; i < 8; ++i) *(LAS f32x4*)(scrb + 8192 + (i * 64 + lane) * 16) = gsrc[i * 64 + lane];
        LDS_WAIT(); asm volatile("" ::: "memory");
    }
    ConvItem dummy; dummy.Wp = (const GAS float*)a.in[14] + wn; dummy.dst0 = nullptr; dummy.gain = a.in[14]; dummy.N = 0; dummy.K = 0; dummy.k0 = 0; dummy.ok = true; dummy.hasg = false;
#define CONV_ITEM(r) ((r) < r_end ? (KIND < 2 ? moe_conv_item(a, ws, KIND, (r), lane) : fox_conv_item(a, ws, (r), lane)) : dummy)
#define CONV_LOAD(dst, it) { _Pragma("unroll") for (int i = 0; i < 8; ++i) dst[i] = __builtin_nontemporal_load((const GAS f32x4*)(it.Wp + (size_t)(8 * i) * it.N)); }
    const unsigned wq = (unsigned)(l7 ^ wk), wb = (unsigned)wk * 128u;
    unsigned X[8];
#pragma unroll
    for (int m = 0; m < 8; ++m) X[m] = (unsigned)c * 1024u + (unsigned)(wk & 3) * 4u + ((((unsigned)(wk >> 2) ^ (unsigned)c ^ (unsigned)m)) << 4);
#define CONV_PROC(ld, cur) { \
        _Pragma("unroll") for (int i = 0; i < 8; ++i) { const f32x4 v = cur.ok ? ld[i] : f32x4{0.f, 0.f, 0.f, 0.f}; *(LAS f32x4*)(scrb + wb + i * 1024 + ((wq ^ (unsigned)i) << 4)) = v; } \
        LDS_WAIT(); asm volatile("" ::: "memory"); \
        f32x4 g0 = {1.f, 1.f, 1.f, 1.f}, g1 = g0; \
        if constexpr (KIND < 2) { const f32x4 q0 = *(const LAS f32x4*)(scrb + 8192 + (cur.k0 + 8 * c) * 4), q1 = *(const LAS f32x4*)(scrb + 8192 + (cur.k0 + 8 * c) * 4 + 16); g0 = cur.hasg ? q0 : g0; g1 = cur.hasg ? q1 : g1; } \
        _Pragma("unroll") for (int jj = 0; jj < 4; ++jj) { const int n = (lane >> 3) + 8 * jj; float sp[8]; \
            _Pragma("unroll") for (int t = 0; t < 8; ++t) sp[t] = *(const LAS float*)(scrb + X[t ^ (2 * jj)] + t * 128); \
            v4u o; o.x = pk2(sp[0] * g0.x, sp[1] * g0.y); o.y = pk2(sp[2] * g0.z, sp[3] * g0.w); o.z = pk2(sp[4] * g1.x, sp[5] * g1.y); o.w = pk2(sp[6] * g1.z, sp[7] * g1.w); \
            __builtin_nontemporal_store(o, (GAS v4u*)(cur.dst0 + (size_t)n * cur.K + cur.k0 + 8 * c)); } \
        LDS_WAIT(); asm volatile("" ::: "memory"); }
    ConvItem iA = CONV_ITEM(r), iB = CONV_ITEM(r + stride), iC = CONV_ITEM(r + 2 * stride), iD = CONV_ITEM(r + 3 * stride), iE;
    f32x4 A[8], B[8], C[8], Dd[8], Ee[8];
    CONV_LOAD(A, iA)
    __builtin_amdgcn_sched_barrier(0);
    CONV_LOAD(B, iB)
    __builtin_amdgcn_sched_barrier(0);
    CONV_LOAD(C, iC)
    __builtin_amdgcn_sched_barrier(0);
    CONV_LOAD(Dd, iD)
    __builtin_amdgcn_sched_barrier(0);
    for (; r < r_end; r += 5 * stride) {
        iE = CONV_ITEM(r + 4 * stride); CONV_LOAD(Ee, iE)
        CONV_PROC(A, iA)
        iA = CONV_ITEM(r + 5 * stride); CONV_LOAD(A, iA)
        if (r + stride < r_end) CONV_PROC(B, iB)
        iB = CONV_ITEM(r + 6 * stride); CONV_LOAD(B, iB)
        if (r + 2 * stride < r_end) CONV_PROC(C, iC)
        iC = CONV_ITEM(r + 7 * stride); CONV_LOAD(C, iC)
        if (r + 3 * stride < r_end) CONV_PROC(Dd, iD)
        iD = CONV_ITEM(r + 8 * stride); CONV_LOAD(Dd, iD)
        if (r + 4 * stride < r_end) CONV_PROC(Ee, iE)
    }
#undef CONV_PROC
#undef CONV_LOAD
#undef CONV_ITEM
}
constexpr int CONV_TOTAL_MOE = 3 * 64 * 512, CONV_TOTAL_FOX = 32 * 257 + 32 * 64;
template <int KIND>
__device__ __forceinline__ void conv_run(Frame& F, const Args& a, unsigned char* ws, const int slot, const int nslots) {
    const int gw = F.vcu * NWAVES + F.wave, NGW = F.G * NWAVES;
    constexpr int TOTAL = KIND < 2 ? CONV_TOTAL_MOE : CONV_TOTAL_FOX;
    const int nj = (TOTAL + NGW - 1) / NGW, j0 = (nj * slot) / nslots, j1 = (nj * (slot + 1)) / nslots;
    const int re = j1 * NGW < TOTAL ? j1 * NGW : TOTAL;
    conv_range<KIND>(F, a, ws, j0 * NGW, re, gw, NGW);
}
__device__ __forceinline__ void moe_conv(Frame& F, const Args& a, unsigned char* ws, const int l, const int slot, const int nslots) {
    if (l == 0) conv_run<0>(F, a, ws, slot, nslots); else conv_run<1>(F, a, ws, slot, nslots);
}

using pg8::Unit; using pg8::UPtr; using pg8::TileOrder; using pg8::cvt_pk_bf16; using pg8::bf_lo; using pg8::bf_hi;
typedef pg8::f32x4 (AccT)[2][2][4][2];

struct SchedDense {
    static constexpr bool GATHER = false, ROWSKIP = false;
    TileOrder T; const char* A; const char* B; size_t astep, bstep;
    int i_begin, i_end;
    __device__ __forceinline__ void init(const void* A_, int lda, const void* B_, int ldb, int nM, int nN, int G, int c) { T.init(nM, nN, G, c); A = (const char*)A_; B = (const char*)B_; astep = (size_t)256 * lda * 2; bstep = (size_t)256 * ldb * 2; i_begin = 0; i_end = 1 << 30; }
    __device__ __forceinline__ bool next(int i, Unit& u) const { return (i + i_begin < i_end) && T.next(i + i_begin, u); }
    __device__ __forceinline__ UPtr ptrs(const Unit& u) const { UPtr p; p.A = A + (size_t)u.pm * astep; p.B = B + (size_t)u.pn * bstep; return p; }
};
template <int NPN> struct SchedS5 {
    static constexpr bool GATHER = false, ROWSKIP = false;
    int G, c; const char* A; const char* B; size_t bgrp, btile;
    __device__ __forceinline__ void init(const void* A_, const void* B_, int brows_per_group, int ldb, int G_, int c_) { G = G_; c = c_; A = (const char*)A_; B = (const char*)B_; bgrp = (size_t)brows_per_group * ldb * 2; btile = (size_t)256 * ldb * 2; }
    __device__ __forceinline__ bool next(int i, Unit& u) const { const int L = i * G + c; if (L >= NG * 2 * NPN) return false; u.pm = L / NPN; u.pn = L % NPN; u.half = -1; return true; }
    __device__ __forceinline__ UPtr ptrs(const Unit& u) const { UPtr p; p.A = A + (size_t)u.pm * 256 * KP * 2; p.B = B + (size_t)(u.pm >> 1) * bgrp + (size_t)u.pn * btile; return p; }
};
struct MoeTab { const LAS int* cnt; const LAS int* mt_e; const LAS int* mt_row0; int T; };
struct SchedMoeGU {
    static constexpr bool GATHER = true, ROWSKIP = true;
    __device__ __forceinline__ int valid(const Unit& u) const { return tab.cnt[tab.mt_e[u.pm]] - tab.mt_row0[u.pm]; }
    TileOrder T; MoeTab tab; const char* HN; const char* W; const int* tokl; int tid;
    __device__ __forceinline__ bool next(int i, Unit& u) const { return T.next(i, u); }
    __device__ __forceinline__ UPtr ptrs(const Unit& u) const { UPtr p; p.A = HN; p.B = W + ((size_t)tab.mt_e[u.pm] * 1024 + (size_t)u.pn * 256) * D * 2; return p; }
    __device__ __forceinline__ void gather(const Unit& u, unsigned (&off)[2][2]) const {
        const int e = tab.mt_e[u.pm], row0 = tab.mt_row0[u.pm], cnt = tab.cnt[e];
        const GAS int* tl = (const GAS int*)tokl + (size_t)e * M;
        int pr[2][2];
#pragma unroll
        for (int i = 0; i < 2; ++i) { int R, C; pg8::stage_rc(tid * 16 + i * 8192, R, C);
#pragma unroll
            for (int h = 0; h < 2; ++h) { const int idx = row0 + h * 128 + R; pr[h][i] = tl[idx < cnt ? idx : cnt - 1]; } }
#pragma unroll
        for (int i = 0; i < 2; ++i) { int R, C; pg8::stage_rc(tid * 16 + i * 8192, R, C);
#pragma unroll
            for (int h = 0; h < 2; ++h) { const int idx = row0 + h * 128 + R; const int pair = idx < cnt ? pr[h][i] : 0;
                off[h][i] = (unsigned)(pair >> 1) * (unsigned)(D * 2) + (unsigned)C * 2u; } }
    }
};
struct SchedMoeDN {
    static constexpr bool GATHER = false, ROWSKIP = true;
    __device__ __forceinline__ int valid(const Unit& u) const { return tab.cnt[tab.mt_e[u.pm]] - tab.mt_row0[u.pm]; }
    TileOrder T; MoeTab tab; const char* HID; const char* W;
    __device__ __forceinline__ bool next(int i, Unit& u) const { return T.next(i, u); }
    __device__ __forceinline__ UPtr ptrs(const Unit& u) const { UPtr p; p.A = HID + (size_t)u.pm * 256 * DE * 2; p.B = W + ((size_t)tab.mt_e[u.pm] * D + (size_t)u.pn * 256) * DE * 2; return p; }
};

struct EpiU {
    static constexpr bool PERM = true, AFTER_DRAIN = false;
    bf16* UA;
    __device__ __forceinline__ void operator()(const AccT& acc, const Unit& u, int wr, int wc, int fr, int fq) const {
#pragma unroll
        for (int ai = 0; ai < 2; ++ai)
#pragma unroll
            for (int m = 0; m < 4; ++m) { const int t = u.pm * 256 + ai * 128 + wr * 64 + m * 16 + fr;
                const int b = t >> 11, s = t & 2047, ch = s >> 5, j = s & 31;
#pragma unroll
                for (int bj = 0; bj < 2; ++bj) { const int c0 = u.pn * 256 + bj * 128 + wc * 32 + 8 * fq, g = c0 >> 4, hf = (c0 >> 3) & 1;
                    const pg8::f32x4 v0 = acc[ai][bj][m][0], v1 = acc[ai][bj][m][1];
                    v4u w; w.x = cvt_pk_bf16(v0[0], v0[1]); w.y = cvt_pk_bf16(v0[2], v0[3]); w.z = cvt_pk_bf16(v1[0], v1[1]); w.w = cvt_pk_bf16(v1[2], v1[3]);
                    *(GAS v4u*)(UA + ((size_t)(g * 512 + b * 64 + ch) * KP + j * 16 + hf * 8)) = w; } }
    }
};
struct EpiScan {
    static constexpr bool PERM = false, AFTER_DRAIN = true;
    bf16* UA; const float* AL;
    __device__ __forceinline__ void fused(const AccT& acc, const Unit& u, int wr, int wc, int fr, int fq, LAS unsigned char* lds, int wid, int lane) const {
        LAS float* X = (LAS float*)lds;
#pragma unroll
        for (int ai = 0; ai < 2; ++ai)
#pragma unroll
            for (int m = 0; m < 4; ++m) { const int r = ai * 128 + wr * 64 + m * 16 + fr;
#pragma unroll
                for (int n = 0; n < 2; ++n) *(LAS pg8::f32x4*)(X + r * 128 + wc * 32 + n * 16 + 4 * fq) = acc[ai][0][m][n]; }
        LDS_WAIT(); __syncthreads();
        const int tid = wid * 64 + lane;
        if (tid < 256) { const int bl = tid >> 6, n = tid & 63, g = u.pm >> 1;
            const float ar = AL[(g * 64 + n) * 2], ai_ = AL[(g * 64 + n) * 2 + 1];
            float sr = 0.f, si = 0.f;
            bf16* dst = UA + (size_t)(u.pm * 256 + bl * 64) * KP + 512 + 2 * n;
            const LAS float* xs = X + (bl * 64) * 128 + 2 * n;
            for (int c = 0; c < 64; ++c) {
                *(GAS unsigned*)(dst + (size_t)c * KP) = pk2(sr, si);
                const float xr = xs[c * 128], xi = xs[c * 128 + 1];
                const float nr = ar * sr - ai_ * si + xr, ni = ar * si + ai_ * sr + xi; sr = nr; si = ni; }
        }
        __syncthreads();
    }
};
struct EpiY {
    static constexpr bool PERM = true, AFTER_DRAIN = false;
    const bf16* UA; const float* dsk; bf16* GL;
    __device__ __forceinline__ void operator()(const AccT& acc, const Unit& u, int wr, int wc, int fr, int fq) const {
        const int g = u.pm >> 1, n00 = u.pn * 256 + wc * 32 + 8 * fq;
        const GAS bf16* ug = (const GAS bf16*)UA + ((size_t)(g * 512 + (u.pm & 1) * 256 + wr * 64 + fr) * KP + n00);
        v4u uv[4][2]; f32x4 dd[2][2];
#define EY_LOAD(b) { const GAS bf16* p_ = ug + (size_t)(((b) >> 2) * 128 + ((b) & 3) * 16) * KP; uv[(b) & 3][0] = *(const GAS v4u*)p_; uv[(b) & 3][1] = *(const GAS v4u*)(p_ + 128); }
        EY_LOAD(0) EY_LOAD(1) EY_LOAD(2) EY_LOAD(3)
#pragma unroll
        for (int bj = 0; bj < 2; ++bj) { const int hf = ((n00 + bj * 128) >> 3) & 1; dd[bj][0] = *(const GAS f32x4*)(dsk + g * 16 + hf * 8); dd[bj][1] = *(const GAS f32x4*)(dsk + g * 16 + hf * 8 + 4); }
        __builtin_amdgcn_s_waitcnt(0x0F70);
#pragma unroll
        for (int b = 0; b < 8; ++b) { const int ai = b >> 2, m = b & 3;
            const int rl = ai * 128 + wr * 64 + m * 16 + fr, row = (u.pm & 1) * 256 + rl, bb = row >> 6, ch = row & 63;
#pragma unroll
            for (int bj = 0; bj < 2; ++bj) { const int n0 = n00 + bj * 128, i = n0 >> 4, hf = (n0 >> 3) & 1;
                const v4u uu = uv[m][bj]; const f32x4 d0 = dd[bj][0], d1 = dd[bj][1];
                const pg8::f32x4 v0 = acc[ai][bj][m][0], v1 = acc[ai][bj][m][1];
                float y[8];
                y[0] = v0[0] + d0.x * bf_lo(uu.x); y[1] = v0[1] + d0.y * bf_hi(uu.x); y[2] = v0[2] + d0.z * bf_lo(uu.y); y[3] = v0[3] + d0.w * bf_hi(uu.y);
                y[4] = v1[0] + d1.x * bf_lo(uu.z); y[5] = v1[1] + d1.y * bf_hi(uu.z); y[6] = v1[2] + d1.z * bf_lo(uu.w); y[7] = v1[3] + d1.w * bf_hi(uu.w);
#pragma unroll
                for (int e = 0; e < 8; ++e) y[e] = gelu_tanh_(y[e]);
                v4u w; w.x = cvt_pk_bf16(y[0], y[1]); w.y = cvt_pk_bf16(y[2], y[3]); w.z = cvt_pk_bf16(y[4], y[5]); w.w = cvt_pk_bf16(y[6], y[7]);
                const size_t tok = (size_t)bb * SEQ + ch * LCH + i;
                *(GAS v4u*)(GL + tok * DS + g * 16 + hf * 8) = w; }
            if (b + 4 < 8) EY_LOAD(b + 4) }
#undef EY_LOAD
    }
};
struct EpiGlu {
    static constexpr bool PERM = true, AFTER_DRAIN = false;
    const bf16* GL; const float* bias; bf16* OG;
    __device__ __forceinline__ void operator()(const AccT& acc, const Unit& u, int wr, int wc, int fr, int fq) const {
        const int c00 = u.pn * 256 + wc * 32 + 8 * fq;
        const GAS bf16* gp = (const GAS bf16*)GL + ((size_t)u.pm * 256 + wr * 64 + fr) * DS + c00;
        v4u gv[4][2]; f32x4 bb[2][2];
#define EG_LOAD(b) { const GAS bf16* p_ = gp + (size_t)(((b) >> 2) * 128 + ((b) & 3) * 16) * DS; gv[(b) & 3][0] = *(const GAS v4u*)p_; gv[(b) & 3][1] = *(const GAS v4u*)(p_ + 128); }
        EG_LOAD(0) EG_LOAD(1) EG_LOAD(2) EG_LOAD(3)
#pragma unroll
        for (int bj = 0; bj < 2; ++bj) { bb[bj][0] = *(const GAS f32x4*)(bias + c00 + bj * 128); bb[bj][1] = *(const GAS f32x4*)(bias + c00 + bj * 128 + 4); }
        __builtin_amdgcn_s_waitcnt(0x0F70);
#pragma unroll
        for (int b = 0; b < 8; ++b) { const int ai = b >> 2, m = b & 3; const size_t row = (size_t)u.pm * 256 + ai * 128 + wr * 64 + m * 16 + fr;
#pragma unroll
            for (int bj = 0; bj < 2; ++bj) { const int c0 = c00 + bj * 128; const v4u gg = gv[m][bj]; const f32x4 b0 = bb[bj][0], b1 = bb[bj][1];
                const pg8::f32x4 v0 = acc[ai][bj][m][0], v1 = acc[ai][bj][m][1];
                float o[8];
                o[0] = bf_lo(gg.x) * sigmoidf_(v0[0] + b0.x); o[1] = bf_hi(gg.x) * sigmoidf_(v0[1] + b0.y); o[2] = bf_lo(gg.y) * sigmoidf_(v0[2] + b0.z); o[3] = bf_hi(gg.y) * sigmoidf_(v0[3] + b0.w);
                o[4] = bf_lo(gg.z) * sigmoidf_(v1[0] + b1.x); o[5] = bf_hi(gg.z) * sigmoidf_(v1[1] + b1.y); o[6] = bf_lo(gg.w) * sigmoidf_(v1[2] + b1.z); o[7] = bf_hi(gg.w) * sigmoidf_(v1[3] + b1.w);
                v4u w; w.x = cvt_pk_bf16(o[0], o[1]); w.y = cvt_pk_bf16(o[2], o[3]); w.z = cvt_pk_bf16(o[4], o[5]); w.w = cvt_pk_bf16(o[6], o[7]);
                *(GAS v4u*)(OG + row * DS + c0) = w; }
            if (b + 4 < 8) EG_LOAD(b + 4) }
#undef EG_LOAD
    }
};
struct EpiRes {
    static constexpr bool PERM = false, AFTER_DRAIN = false;
    const float* base; float* out;
    __device__ __forceinline__ void operator()(const AccT& acc, const Unit& u, int wr, int wc, int fr, int fq) const {
#pragma unroll
        for (int ai = 0; ai < 2; ++ai)
#pragma unroll
            for (int m = 0; m < 4; ++m) { const size_t off = ((size_t)u.pm * 256 + ai * 128 + wr * 64 + m * 16 + fr) * D + u.pn * 256 + wc * 32 + 4 * fq;
#pragma unroll
                for (int bj = 0; bj < 2; ++bj)
#pragma unroll
                    for (int n = 0; n < 2; ++n) { const f32x4 bs = *(const GAS f32x4*)(base + off + bj * 128 + n * 16); const pg8::f32x4 a = acc[ai][bj][m][n];
                        f32x4 o; o.x = bs.x + a[0]; o.y = bs.y + a[1]; o.z = bs.z + a[2]; o.w = bs.w + a[3];
                        *(GAS f32x4*)(out + off + bj * 128 + n * 16) = o; }
                asm volatile("" ::: "memory"); }
    }
};
struct EpiResYP {
    static constexpr bool PERM = false, AFTER_DRAIN = false;
    float* out; const bf16* YP;
    __device__ __forceinline__ void operator()(const AccT& acc, const Unit& u, int wr, int wc, int fr, int fq) const {
#pragma unroll
        for (int ai = 0; ai < 2; ++ai)
#pragma unroll
            for (int m = 0; m < 4; ++m) { const size_t row = (size_t)u.pm * 256 + ai * 128 + wr * 64 + m * 16 + fr; const int col = u.pn * 256 + wc * 32 + 4 * fq;
#pragma unroll
                for (int bj = 0; bj < 2; ++bj)
#pragma unroll
                    for (int n = 0; n < 2; ++n) { const int c = col + bj * 128 + n * 16;
                        const f32x4 bs = *(const GAS f32x4*)(out + row * D + c); const v2u y0 = *(const GAS v2u*)(YP + (2 * row) * D + c), y1 = *(const GAS v2u*)(YP + (2 * row + 1) * D + c);
                        const pg8::f32x4 a = acc[ai][bj][m][n];
                        f32x4 o; o.x = bs.x + bf_lo(y0.x) + bf_lo(y1.x) + a[0]; o.y = bs.y + bf_hi(y0.x) + bf_hi(y1.x) + a[1]; o.z = bs.z + bf_lo(y0.y) + bf_lo(y1.y) + a[2]; o.w = bs.w + bf_hi(y0.y) + bf_hi(y1.y) + a[3];
                        *(GAS f32x4*)(out + row * D + c) = o; }
                asm volatile("" ::: "memory"); }
    }
};
__device__ __forceinline__ float sumsq8(const v4u w) { float s = 0.f; s += bf_lo(w.x) * bf_lo(w.x) + bf_hi(w.x) * bf_hi(w.x); s += bf_lo(w.y) * bf_lo(w.y) + bf_hi(w.y) * bf_hi(w.y);
    s += bf_lo(w.z) * bf_lo(w.z) + bf_hi(w.z) * bf_hi(w.z); s += bf_lo(w.w) * bf_lo(w.w) + bf_hi(w.w) * bf_hi(w.w); return s; }
struct EpiResB {
    static constexpr bool PERM = true, AFTER_DRAIN = false;
    const float* x; bf16* HB; float* SS;
    __device__ __forceinline__ void operator()(const AccT& acc, const Unit& u, int wr, int wc, int fr, int fq) const {
        const int c00 = u.pn * 256 + wc * 32 + 8 * fq;
        const GAS float* xg = (const GAS float*)x + ((size_t)u.pm * 256 + wr * 64 + fr) * D + c00;
        f32x4 xv[4][2][2];
#define RB_LOAD(b) { const GAS float* p_ = xg + (size_t)(((b) >> 2) * 128 + ((b) & 3) * 16) * D; _Pragma("unroll") for (int bj = 0; bj < 2; ++bj) { xv[(b) & 3][bj][0] = *(const GAS f32x4*)(p_ + bj * 128); xv[(b) & 3][bj][1] = *(const GAS f32x4*)(p_ + bj * 128 + 4); } }
        RB_LOAD(0) RB_LOAD(1) RB_LOAD(2) RB_LOAD(3)
        __builtin_amdgcn_s_waitcnt(0x0F70);
#pragma unroll
        for (int b = 0; b < 8; ++b) { const int ai = b >> 2, m = b & 3; const size_t row = (size_t)u.pm * 256 + ai * 128 + wr * 64 + m * 16 + fr; float ssq = 0.f;
#pragma unroll
            for (int bj = 0; bj < 2; ++bj) { const int c = c00 + bj * 128; const f32x4 x0 = xv[m][bj][0], x1 = xv[m][bj][1];
                const pg8::f32x4 v0 = acc[ai][bj][m][0], v1 = acc[ai][bj][m][1];
                v4u w; w.x = cvt_pk_bf16(x0.x + v0[0], x0.y + v0[1]); w.y = cvt_pk_bf16(x0.z + v0[2], x0.w + v0[3]); w.z = cvt_pk_bf16(x1.x + v1[0], x1.y + v1[1]); w.w = cvt_pk_bf16(x1.z + v1[2], x1.w + v1[3]);
                *(GAS v4u*)(HB + row * D + c) = w; ssq += sumsq8(w); }
            ssq += __shfl_xor(ssq, 16); ssq += __shfl_xor(ssq, 32);
            if (fq == 0) SS[row * 32 + u.pn * 4 + wc] = ssq;
            if (b + 4 < 8) RB_LOAD(b + 4) }
#undef RB_LOAD
    }
};
struct EpiResYPB {
    static constexpr bool PERM = true, AFTER_DRAIN = false;
    bf16* HB; const bf16* YP; float* SS;
    __device__ __forceinline__ void operator()(const AccT& acc, const Unit& u, int wr, int wc, int fr, int fq) const {
        const int c00 = u.pn * 256 + wc * 32 + 8 * fq;
        const size_t r00 = (size_t)u.pm * 256 + wr * 64 + fr;
        const GAS bf16* hg = (const GAS bf16*)HB + r00 * D + c00; const GAS bf16* yg = (const GAS bf16*)YP + (2 * r00) * D + c00;
        v4u hv[4][2], y0v[4][2], y1v[4][2];
#define RY_LOAD(b) { const size_t ro_ = (size_t)(((b) >> 2) * 128 + ((b) & 3) * 16); _Pragma("unroll") for (int bj = 0; bj < 2; ++bj) { \
            hv[(b) & 3][bj] = *(const GAS v4u*)(hg + ro_ * D + bj * 128); y0v[(b) & 3][bj] = *(const GAS v4u*)(yg + (2 * ro_) * D + bj * 128); y1v[(b) & 3][bj] = *(const GAS v4u*)(yg + (2 * ro_ + 1) * D + bj * 128); } }
        RY_LOAD(0) RY_LOAD(1) RY_LOAD(2) RY_LOAD(3)
        __builtin_amdgcn_s_waitcnt(0x0F70);
#pragma unroll
        for (int b = 0; b < 8; ++b) { const int ai = b >> 2, m = b & 3; const size_t row = (size_t)u.pm * 256 + ai * 128 + wr * 64 + m * 16 + fr; float ssq = 0.f;
#pragma unroll
            for (int bj = 0; bj < 2; ++bj) { const int c = c00 + bj * 128; const v4u hb = hv[m][bj], y0 = y0v[m][bj], y1 = y1v[m][bj];
                const pg8::f32x4 v0 = acc[ai][bj][m][0], v1 = acc[ai][bj][m][1];
                v4u w;
                w.x = cvt_pk_bf16(bf_lo(hb.x) + bf_lo(y0.x) + bf_lo(y1.x) + v0[0], bf_hi(hb.x) + bf_hi(y0.x) + bf_hi(y1.x) + v0[1]);
                w.y = cvt_pk_bf16(bf_lo(hb.y) + bf_lo(y0.y) + bf_lo(y1.y) + v0[2], bf_hi(hb.y) + bf_hi(y0.y) + bf_hi(y1.y) + v0[3]);
                w.z = cvt_pk_bf16(bf_lo(hb.z) + bf_lo(y0.z) + bf_lo(y1.z) + v1[0], bf_hi(hb.z) + bf_hi(y0.z) + bf_hi(y1.z) + v1[1]);
                w.w = cvt_pk_bf16(bf_lo(hb.w) + bf_lo(y0.w) + bf_lo(y1.w) + v1[2], bf_hi(hb.w) + bf_hi(y0.w) + bf_hi(y1.w) + v1[3]);
                *(GAS v4u*)(HB + row * D + c) = w; ssq += sumsq8(w); }
            ssq += __shfl_xor(ssq, 16); ssq += __shfl_xor(ssq, 32);
            if (fq == 0) SS[row * 32 + u.pn * 4 + wc] = ssq;
            if (b + 4 < 8) RY_LOAD(b + 4) }
#undef RY_LOAD
    }
};
struct EpiGU {
    static constexpr bool PERM = true, AFTER_DRAIN = false;
    bf16* HID; MoeTab tab; const float* tokr;
    __device__ __forceinline__ void operator()(const AccT& acc, const Unit& u, int wr, int wc, int fr, int fq) const {
        const int e_ = tab.mt_e[u.pm], row0_ = tab.mt_row0[u.pm], cnt_ = tab.cnt[e_];
        const GAS float* tr = (const GAS float*)tokr + (size_t)e_ * M;
        float rsv[8];
#pragma unroll
        for (int b = 0; b < 8; ++b) { const int idx_ = row0_ + (b >> 2) * 128 + wr * 64 + (b & 3) * 16 + fr; rsv[b] = tr[idx_ < cnt_ ? idx_ : cnt_ - 1]; }
        __builtin_amdgcn_s_waitcnt(0x0F70);
#pragma unroll
        for (int ai = 0; ai < 2; ++ai) { if (u.half >= 0 && u.half != ai) continue;
#pragma unroll
            for (int m = 0; m < 4; ++m) { const size_t row = (size_t)u.pm * 256 + ai * 128 + wr * 64 + m * 16 + fr;
                const int idx_ = row0_ + ai * 128 + wr * 64 + m * 16 + fr; const float rs = idx_ < cnt_ ? rsv[ai * 4 + m] : 0.f;
                float h[8];
#pragma unroll
                for (int n = 0; n < 2; ++n)
#pragma unroll
                    for (int e = 0; e < 4; ++e) { const float gt = acc[ai][0][m][n][e] * rs, up = acc[ai][1][m][n][e] * rs; h[n * 4 + e] = gt * sigmoidf_(gt) * up; }
                v4u w; w.x = cvt_pk_bf16(h[0], h[1]); w.y = cvt_pk_bf16(h[2], h[3]); w.z = cvt_pk_bf16(h[4], h[5]); w.w = cvt_pk_bf16(h[6], h[7]);
                *(GAS v4u*)(HID + row * DE + u.pn * 128 + wc * 32 + 8 * fq) = w; } }
    }
};
struct EpiDN {
    static constexpr bool PERM = true, AFTER_DRAIN = false;
    MoeTab tab; const int* tokl; const float* tokw; bf16* YP;
    __device__ __forceinline__ void operator()(const AccT& acc, const Unit& u, int wr, int wc, int fr, int fq) const {
        const int e = tab.mt_e[u.pm], row0 = tab.mt_row0[u.pm], cnt = tab.cnt[e];
        const GAS int* tl = (const GAS int*)tokl + (size_t)e * M; const GAS float* tw = (const GAS float*)tokw + (size_t)e * M;
        int pr[8]; float wg[8];
#pragma unroll
        for (int b = 0; b < 8; ++b) { const int idx = row0 + (b >> 2) * 128 + wr * 64 + (b & 3) * 16 + fr, ic = idx < cnt ? idx : cnt - 1; pr[b] = tl[ic]; wg[b] = tw[ic]; }
        __builtin_amdgcn_s_waitcnt(0x0F70);
#pragma unroll
        for (int ai = 0; ai < 2; ++ai) { if (u.half >= 0 && u.half != ai) continue;
#pragma unroll
            for (int m = 0; m < 4; ++m) { const int idx = row0 + ai * 128 + wr * 64 + m * 16 + fr;
                if (idx < cnt) { const int pair = pr[ai * 4 + m]; const float wgt = wg[ai * 4 + m];
#pragma unroll
                    for (int bj = 0; bj < 2; ++bj) { const pg8::f32x4 v0 = acc[ai][bj][m][0], v1 = acc[ai][bj][m][1];
                        v4u w; w.x = cvt_pk_bf16(v0[0] * wgt, v0[1] * wgt); w.y = cvt_pk_bf16(v0[2] * wgt, v0[3] * wgt); w.z = cvt_pk_bf16(v1[0] * wgt, v1[1] * wgt); w.w = cvt_pk_bf16(v1[2] * wgt, v1[3] * wgt);
                        *(GAS v4u*)(YP + (size_t)pair * D + u.pn * 256 + bj * 128 + wc * 32 + 8 * fq) = w; } } } }
    }
};
struct EpiQKVG {
    static constexpr bool PERM = true, AFTER_DRAIN = false;
    bf16* Q; size_t tstride;
    __device__ __forceinline__ void operator()(const AccT& acc, const Unit& u, int wr, int wc, int fr, int fq) const {
        const int t = u.pn >> 3; bf16* base = Q + (size_t)t * tstride; const int col0 = (u.pn & 7) * 256 + wc * 32 + 8 * fq;
#pragma unroll
        for (int ai = 0; ai < 2; ++ai)
#pragma unroll
            for (int m = 0; m < 4; ++m) { bf16* rowp = base + ((size_t)u.pm * 256 + ai * 128 + wr * 64 + m * 16 + fr) * D + col0;
#pragma unroll
                for (int bj = 0; bj < 2; ++bj) { pg8::f32x4 v0 = acc[ai][bj][m][0], v1 = acc[ai][bj][m][1];
                    if (t == 3) {
#pragma unroll
                        for (int e = 0; e < 4; ++e) { v0[e] = sigmoidf_(v0[e]); v1[e] = sigmoidf_(v1[e]); } }
                    v4u w; w.x = cvt_pk_bf16(v0[0], v0[1]); w.y = cvt_pk_bf16(v0[2], v0[3]); w.z = cvt_pk_bf16(v1[0], v1[1]); w.w = cvt_pk_bf16(v1[2], v1[3]);
                    *(GAS v4u*)(rowp + bj * 128) = w; } }
    }
};

namespace fox {
constexpr int AD = 128, PITCH = 2048;
constexpr float SCALE = 0.08838834764831845f;
constexpr float THR = 24.f;
constexpr int NW = 8, QBLK = 32, KVBLK = 64, QB = NW * QBLK;
constexpr int SHM_V = KVBLK * AD * 2, SHM_K = KVBLK * AD * 2;
constexpr int WS_OFF = 2 * SHM_V + 2 * SHM_K;
constexpr int BIAS_OFF = WS_OFF + NW * 64 * 4;
constexpr int ATT_LDS_BYTES = BIAS_OFF + 2 * SEQ * 4;
constexpr int GATE_OFF = 86016;
static_assert(GATE_OFF >= ATT_LDS_BYTES && GATE_OFF % 16 == 0, "gate tiles above the K/V/bias region");
typedef short s16x4 __attribute__((ext_vector_type(4)));

#define KSWZ(row, colB) ((row) * 256 + ((colB) ^ (((row) & 7) << 4)))
#define SBAR() __builtin_amdgcn_sched_barrier(0)
__device__ __forceinline__ int v_st(int k, int c) { const int kk = (k & ~0xC) | ((k & 4) << 1) | ((k & 8) >> 1); return ((kk >> 3) * 4 + (c >> 5)) * 512 + ((kk & 7) * 32 + (c & 31)) * 2; }
__device__ __forceinline__ int v_rd_base(int lane) { return ((lane & 3) << 3) | (((lane >> 2) & 3) << 6) | (((lane >> 4) & 1) << 5) | (((lane >> 5) & 1) << 8); }
constexpr int v_rd_off(int d0, int ks, int half) { return d0 * 512 + ks * 4096 + half * 2048; }
__device__ __forceinline__ int crow(int r, int hi) { return (r & 3) + 8 * (r >> 2) + 4 * hi; }
__device__ __forceinline__ unsigned cvtpk(float lo, float hi) { unsigned r; asm volatile("v_cvt_pk_bf16_f32 %0, %1, %2" : "=v"(r) : "v"(lo), "v"(hi)); return r; }
__device__ __forceinline__ bf16x8 ld8(const GAS char* ubase, unsigned voff) { return *(const GAS bf16x8*)(ubase + voff); }
constexpr size_t VK_DELTA = (size_t)64 << 20;
__device__ __forceinline__ void mask_tile(f32x16& p0, f32x16& p1, int dq) {
    const float NEG = -__builtin_inff();
#pragma unroll
    for (int r = 0; r < 16; ++r) {
        const int c = (r & 3) + 8 * (r >> 2);
        if (dq - c < 0) p0[r] = NEG;
        if (dq - c - 32 < 0) p1[r] = NEG;
    }
}
__device__ __forceinline__ void partialSM(f32x16& p0, f32x16& p1, float& m_reg, float& mn, float& alpha) {
    float pmax = p0[0]; for (int r = 1; r < 16; ++r) pmax = fmaxf(pmax, p0[r]); for (int r = 0; r < 16; ++r) pmax = fmaxf(pmax, p1[r]);
    { auto rr = __builtin_amdgcn_permlane32_swap(__float_as_uint(pmax), __float_as_uint(pmax), false, false);
      pmax = fmaxf(__uint_as_float(rr[0]), __uint_as_float(rr[1])); }
    constexpr float C2 = 1.4426950408889634f * SCALE;
    if (__builtin_expect(__all((pmax - m_reg) * SCALE <= THR), 1)) { mn = m_reg; alpha = 1.f; }
    else { mn = fmaxf(m_reg, pmax); alpha = __builtin_amdgcn_exp2f((m_reg - mn) * C2); m_reg = mn; }
    const float mnL = -mn * C2;
    for (int r = 0; r < 16; ++r) p0[r] = fmaf(p0[r], C2, mnL); for (int r = 0; r < 16; ++r) p1[r] = fmaf(p1[r], C2, mnL);
    for (int r = 0; r < 16; ++r) p0[r] = __builtin_amdgcn_exp2f(p0[r]);
}
__device__ __forceinline__ void finishSM(f32x16& p0, f32x16& p1, float alpha, float& l_reg, bf16x8& pa0, bf16x8& pa1, bf16x8& pa2, bf16x8& pa3) {
    for (int r = 0; r < 16; ++r) p1[r] = __builtin_amdgcn_exp2f(p1[r]);
    float ps = 0; for (int r = 0; r < 16; ++r) ps += p0[r]; for (int r = 0; r < 16; ++r) ps += p1[r];
    { auto rr = __builtin_amdgcn_permlane32_swap(__float_as_uint(ps), __float_as_uint(ps), false, false);
      ps = __uint_as_float(rr[0]) + __uint_as_float(rr[1]); }
    l_reg = l_reg * alpha + ps;
#define PK4(P, B_, OUT) do { unsigned a0 = cvtpk(P[B_+0], P[B_+1]), a1 = cvtpk(P[B_+2], P[B_+3]);                          \
        unsigned b0 = cvtpk(P[B_+4], P[B_+5]), b1 = cvtpk(P[B_+6], P[B_+7]);                                             \
        auto r0 = __builtin_amdgcn_permlane32_swap(a0, b0, false, false); auto r1 = __builtin_amdgcn_permlane32_swap(a1, b1, false, false); \
        v4u w = {r0[0], r1[0], r0[1], r1[1]}; OUT = *reinterpret_cast<bf16x8*>(&w); } while (0)
    PK4(p0, 0, pa0); PK4(p0, 8, pa1); PK4(p1, 0, pa2); PK4(p1, 8, pa3);
#undef PK4
}
template <int KB>
__device__ __forceinline__ void qkt(f32x16& p0, f32x16& p1, const char* K_lds, int r32, int hi, const bf16x8* qr, const float* bias_t  ) {
#pragma unroll
    for (int g = 0; g < 4; ++g) { const f32x4 b0 = *(const f32x4*)(bias_t + 8 * g), b1 = *(const f32x4*)(bias_t + 32 + 8 * g);
        p0[4 * g] = b0.x; p0[4 * g + 1] = b0.y; p0[4 * g + 2] = b0.z; p0[4 * g + 3] = b0.w;
        p1[4 * g] = b1.x; p1[4 * g + 1] = b1.y; p1[4 * g + 2] = b1.z; p1[4 * g + 3] = b1.w; }
    const char* kb[4];
#pragma unroll
    for (int dd = 0; dd < 4; ++dd) kb[dd] = K_lds + KB * SHM_K + KSWZ(r32, (dd * 16 + hi * 8) * 2);
#pragma unroll
    for (int d0 = 0; d0 < 8; ++d0) { const char* a = kb[d0 & 3] + (d0 >> 2) * 128;
        bf16x8 b0 = *reinterpret_cast<const bf16x8*>(a);
        bf16x8 b1 = *reinterpret_cast<const bf16x8*>(a + 32 * 256);
        p0 = __builtin_amdgcn_mfma_f32_32x32x16_bf16(b0, qr[d0], p0, 0, 0, 0);
        p1 = __builtin_amdgcn_mfma_f32_32x32x16_bf16(b1, qr[d0], p1, 0, 0, 0); }
}
template <int VB>
__device__ __forceinline__ void pv_tile(f32x16* o, int vb0, bf16x8 pa0, bf16x8 pa1, bf16x8 pa2, bf16x8 pa3) {
#define TRRD(dst, off) asm volatile("ds_read_b64_tr_b16 %0, %1 offset:%2" : "=&v"(dst) : "v"(vb0), "i"(off) : "memory")
#define PV_D0(d0) do { s16x4 l0, l1, l2, l3, h0, h1, h2, h3; constexpr int b_ = VB * SHM_V + v_rd_off(d0, 0, 0); \
        TRRD(l0, b_); TRRD(h0, b_ + 2048); TRRD(l1, b_ + 4096); TRRD(h1, b_ + 6144); TRRD(l2, b_ + 8192); TRRD(h2, b_ + 10240); TRRD(l3, b_ + 12288); TRRD(h3, b_ + 14336); \
        asm volatile("s_waitcnt lgkmcnt(0)" ::: "memory"); SBAR();   \
        o[d0] = __builtin_amdgcn_mfma_f32_32x32x16_bf16(pa0, (bf16x8){l0[0], l0[1], l0[2], l0[3], h0[0], h0[1], h0[2], h0[3]}, o[d0], 0, 0, 0);   \
        o[d0] = __builtin_amdgcn_mfma_f32_32x32x16_bf16(pa1, (bf16x8){l1[0], l1[1], l1[2], l1[3], h1[0], h1[1], h1[2], h1[3]}, o[d0], 0, 0, 0);   \
        o[d0] = __builtin_amdgcn_mfma_f32_32x32x16_bf16(pa2, (bf16x8){l2[0], l2[1], l2[2], l2[3], h2[0], h2[1], h2[2], h2[3]}, o[d0], 0, 0, 0);   \
        o[d0] = __builtin_amdgcn_mfma_f32_32x32x16_bf16(pa3, (bf16x8){l3[0], l3[1], l3[2], l3[3], h3[0], h3[1], h3[2], h3[3]}, o[d0], 0, 0, 0); } while (0)
    PV_D0(0); PV_D0(1); PV_D0(2); PV_D0(3);
#undef PV_D0
#undef TRRD
}

struct BlockRef { const GAS char* Q; const GAS char* K; GAS char* O; const GAS char* SG; const GAS char* CB; int P0; int par; };
struct Seam { bf16x8 qr[8]; bf16x8 st_v0, st_v1, st_k0, st_k1; };
#define KVP(Kp, k0) ((Kp) + (size_t)(k0) * (PITCH * 2))
#define VMW() asm volatile("s_waitcnt vmcnt(0)" ::: "memory")
#define VMWN(n) asm volatile("s_waitcnt vmcnt(%0)" :: "i"(n) : "memory")
#define SLOAD_H(Kp, k0) do { S.st_v0 = ld8(KVP(Kp, k0) + VK_DELTA, kvo0); S.st_v1 = ld8(KVP(Kp, k0) + VK_DELTA, kvo1);              \
                         S.st_k0 = ld8(KVP(Kp, k0), kvo0); S.st_k1 = ld8(KVP(Kp, k0), kvo1); } while (0)
#define SWRITE_HK(bf) do { *(bf16x8*)(K_lds + (bf) * SHM_K + kws) = S.st_k0; *(bf16x8*)(K_lds + (bf) * SHM_K + kws + 32 * 256) = S.st_k1; } while (0)
#define SWRITE_HV(bf) do { *(bf16x8*)(V_lds + (bf) * SHM_V + vst0) = S.st_v0; *(bf16x8*)(V_lds + (bf) * SHM_V + vst1) = S.st_v1; } while (0)
#define SWRITE_H(bf) do { SWRITE_HV(bf); SWRITE_HK(bf); } while (0)
#define QLOAD(blk) do { const GAS char* qb_ = (blk).Q + (size_t)wid * (QBLK * PITCH * 2); _Pragma("unroll") for (int d0 = 0; d0 < 8; ++d0) S.qr[d0] = ld8(qb_ + d0 * 32, qvo); } while (0)
#define GATE_DMA(blk) do { const GAS char* gs_ = (blk).SG + (size_t)wid * (QBLK * PITCH * 2); _Pragma("unroll") for (int i_ = 0; i_ < 8; ++i_) \
        __builtin_amdgcn_global_load_lds((const GAS unsigned*)(gs_ + (size_t)i_ * (4 * PITCH * 2) + gvo), (LAS unsigned*)(lds + GATE_OFF + wid * 8192 + i_ * 1024), 16, 0, 0); } while (0)
#define BIAS_DMA(blk) __builtin_amdgcn_global_load_lds((const GAS unsigned*)((blk).CB + wid * 1024 + bvo), (LAS unsigned*)(lds + BIAS_OFF + (blk).par * (SEQ * 4) + wid * 1024), 16, 0, 0)
__device__ __forceinline__ void fox_prime(const BlockRef& cur, char* lds, Seam& S, const int tid) {
    const int wid = __builtin_amdgcn_readfirstlane(tid >> 6), lane = tid & 63, r32 = lane & 31, hi = lane >> 5;
    const int sr = tid >> 4, sc = (tid & 15) * 8, kws = KSWZ(sr, sc * 2); char* K_lds = lds + 2 * SHM_V;
    unsigned kvo0 = (unsigned)(sr * PITCH + sc) * 2u, kvo1 = kvo0 + 32u * PITCH * 2u, qvo = (unsigned)(r32 * PITCH + hi * 8) * 2u, bvo = (unsigned)(lane * 16), gvo = (unsigned)((lane >> 4) * (PITCH * 2) + (lane & 15) * 16);
    asm volatile("" : "+v"(kvo0), "+v"(kvo1), "+v"(qvo), "+v"(bvo), "+v"(gvo));
    BIAS_DMA(cur); GATE_DMA(cur);
    QLOAD(cur);
    SLOAD_H(cur.K, 0); VMW(); SWRITE_HK(0);
    __syncthreads();
}
__device__ __forceinline__ void fox_block(const BlockRef& cur, const BlockRef& nxt, char* lds, Seam& S, const int tid) {
    const int wid = __builtin_amdgcn_readfirstlane(tid >> 6), lane = tid & 63, r32 = lane & 31, hi = lane >> 5;
    const int NT = (cur.P0 + QB - 1) / KVBLK + 1;
    const int qlo = cur.P0 + wid * QBLK, qm = qlo + r32 - 4 * hi;
    char* V_lds = lds; char* K_lds = lds + 2 * SHM_V;
    float* ws = (float*)(lds + WS_OFF) + wid * 64; float* li_l = ws, * al_l = ws + 32;
    const float* bias_l = (const float*)(lds + BIAS_OFF + cur.par * (SEQ * 4)) + 4 * hi;
    float m_reg = -1e30f, l_reg = 0; f32x16 o[4] = {};
    const int sr = tid >> 4, sc = (tid & 15) * 8, vst0 = v_st(sr, sc), vst1 = v_st(32 + sr, sc), kws = KSWZ(sr, sc * 2);
    const int vb0 = (int)(uintptr_t)V_lds + v_rd_base(lane);
    const GAS char* Kh = cur.K;
    unsigned kvo0 = (unsigned)(sr * PITCH + sc) * 2u, kvo1 = kvo0 + 32u * PITCH * 2u, qvo = (unsigned)(r32 * PITCH + hi * 8) * 2u, bvo = (unsigned)(lane * 16), gvo = (unsigned)((lane >> 4) * (PITCH * 2) + (lane & 15) * 16);
    asm volatile("" : "+v"(kvo0), "+v"(kvo1), "+v"(qvo), "+v"(bvo), "+v"(gvo));
#define RESC(a) do { if (__any((a) < 1.f)) { if (hi == 0) al_l[r32] = (a); asm volatile("s_waitcnt lgkmcnt(0)" ::: "memory");              \
                     for (int d_ = 0; d_ < 4; ++d_) for (int r = 0; r < 16; ++r) o[d_][r] *= al_l[crow(r, hi)]; } } while (0)
#define KBASE(t) ((t) * KVBLK)
#define MASKT(P0_, P1_, t) do { const int kb_ = KBASE(t); if (kb_ + KVBLK - 1 > qlo) mask_tile(P0_, P1_, qm - kb_); } while (0)
    constexpr int NQL = 8;
#define SEAM_K0() do { VMWN(NQL); SWRITE_HK(0); SBAR(); } while (0)
    f32x16 pA0, pA1, pB0, pB1; float mnA, mnB, alA, alB; bf16x8 pa0, pa1, pa2, pa3;
    SWRITE_HV(0); SBAR();
    if (NT > 1) { SLOAD_H(Kh, KBASE(1)); }
    SBAR(); qkt<0>(pA0, pA1, K_lds, r32, hi, S.qr, bias_l + KBASE(0));
    MASKT(pA0, pA1, 0); partialSM(pA0, pA1, m_reg, mnA, alA);
    if (NT > 1) { VMW(); SWRITE_H(1); }
    __syncthreads();
#define HALF_STEP(PX0, PX1, mnX, alX, PY0, PY1, alY, t, KB, VB, SB) do {                                                      \
        SBAR(); qkt<KB>(PX0, PX1, K_lds, r32, hi, S.qr, bias_l + KBASE(t));                                                   \
        finishSM(PY0, PY1, alY, l_reg, pa0, pa1, pa2, pa3); SBAR();                                                           \
        if ((t) + 1 < NT) { SLOAD_H(Kh, KBASE((t) + 1)); SBAR(); }                                                        \
        pv_tile<VB>(o, vb0, pa0, pa1, pa2, pa3); MASKT(PX0, PX1, (t)); partialSM(PX0, PX1, m_reg, mnX, alX);                  \
        __syncthreads();                                                                                                      \
        if ((t) + 1 < NT) { VMW(); SWRITE_H(SB); }                                                                            \
        RESC(alX); __syncthreads(); } while (0)
    for (int t = 1; t + 1 < NT; t += 2) {
        HALF_STEP(pB0, pB1, mnB, alB, pA0, pA1, alA, t, 1, 0, 0);
        HALF_STEP(pA0, pA1, mnA, alA, pB0, pB1, alB, t + 1, 0, 1, 1);
    }
    const bool even = (NT & 1) == 0;
    if (even) { SBAR(); qkt<1>(pB0, pB1, K_lds, r32, hi, S.qr, bias_l + KBASE(NT - 1)); SBAR(); }
    BIAS_DMA(nxt);
    SLOAD_H(nxt.K, 0); SBAR();
    QLOAD(nxt);
    SBAR();
    finishSM(pA0, pA1, alA, l_reg, pa0, pa1, pa2, pa3); SBAR();
    pv_tile<0>(o, vb0, pa0, pa1, pa2, pa3);
    if (even) { MASKT(pB0, pB1, NT - 1); partialSM(pB0, pB1, m_reg, mnB, alB); __syncthreads(); RESC(alB);
        finishSM(pB0, pB1, alB, l_reg, pa0, pa1, pa2, pa3); SBAR(); pv_tile<1>(o, vb0, pa0, pa1, pa2, pa3); }
    SBAR(); SEAM_K0();
    if (hi == 0) li_l[r32] = l_reg; asm volatile("s_waitcnt lgkmcnt(0)" ::: "memory");
    float rli[16];
#pragma unroll
    for (int r = 0; r < 16; ++r) rli[r] = __builtin_amdgcn_rcpf(li_l[crow(r, hi)]);
    char* gate_l = lds + GATE_OFF + wid * 8192 + (4 * hi) * 256 + r32 * 2;
    GAS char* Ow = cur.O + (size_t)wid * (QBLK * PITCH * 2);
#pragma unroll
    for (int r = 0; r < 16; ++r) {
#pragma unroll
        for (int d0 = 0; d0 < 4; ++d0) { const float v = o[d0][r] * rli[r];
            const float vn = __shfl_xor(v, 1);
            if ((r32 & 1) == 0) { unsigned* gp = (unsigned*)(gate_l + ((r & 3) + 8 * (r >> 2)) * 256 + d0 * 64); const unsigned gg = *gp;
                *gp = cvtpk(v * pg8::bf_lo(gg), vn * pg8::bf_hi(gg)); } } }
    asm volatile("s_waitcnt lgkmcnt(0)" ::: "memory"); SBAR();
    { const char* tile_l = lds + GATE_OFF + wid * 8192 + lane * 16;
#pragma unroll
        for (int i = 0; i < 8; ++i) { const v4u t = *(const v4u*)(tile_l + i * 1024); *(GAS v4u*)(Ow + (size_t)i * (4 * PITCH * 2) + gvo) = t; } }
    asm volatile("s_waitcnt lgkmcnt(0)" ::: "memory"); SBAR();
    GATE_DMA(nxt);
    __syncthreads();
#undef RESC
#undef KBASE
#undef MASKT
#undef SEAM_K0
#undef HALF_STEP
}
#undef KVP
#undef QLOAD
#undef VMW
#undef VMWN
#undef SLOAD_H
#undef SWRITE_HK
#undef SWRITE_HV
#undef SWRITE_H
#undef BIAS_DMA
#undef GATE_DMA

struct Tens { const bf16* Q; const bf16* K; bf16* O; const bf16* SG; const float* CB; };
__device__ __forceinline__ BlockRef fox_ref(const Tens& T, int L, int pass, int seq_no) {
    const int xcd = L & 7, k = L >> 3, bh = (k >> 2) * 8 + xcd, x = k & 3, qb = pass ? 7 - x : x, b = bh >> 4, h = bh & 15;
    BlockRef r; const size_t hoff = (size_t)b * SEQ * PITCH + h * AD, qoff = hoff + (size_t)qb * QB * PITCH;
    r.Q = (const GAS char*)(T.Q + qoff); r.O = (GAS char*)(T.O + qoff); r.SG = (const GAS char*)(T.SG + qoff); r.K = (const GAS char*)(T.K + hoff); r.CB = (const GAS char*)(T.CB + (size_t)bh * SEQ); r.P0 = qb * QB; r.par = seq_no & 1;
    return r;
}
__device__ __forceinline__ void fox_phase(char* lds, const Tens& T, int G, int c, const int tid) {
    constexpr int total = NB * NH * 4;
    int L = c; if (L >= total) return;
    if (__builtin_amdgcn_readfirstlane(tid >> 6) >= 4) __builtin_amdgcn_s_setprio(1);
    int pass = 0, seq = 0;
    BlockRef cur = fox_ref(T, L, 0, 0);
    Seam S;
    fox_prime(cur, lds, S, tid);
    for (;;) {
        const bool more_pass = pass == 0, more_item = L + G < total, last = !more_pass && !more_item;
        int passn = pass + 1, Ln = L;
        if (!more_pass) { passn = 0; Ln = more_item ? L + G : L; }
        const BlockRef nxt = fox_ref(T, Ln, passn, seq + 1);
        fox_block(cur, nxt, lds, S, tid);
        if (last) break;
        cur = nxt; pass = passn; L = Ln; ++seq;
    }
    __builtin_amdgcn_s_setprio(0);
}
}

__device__ __forceinline__ float log_sigmoid_(float x) { return x >= 0.f ? -log1pf(expf(-x)) : x - log1pf(expf(x)); }
struct RowArgs {
    const bf16* Hin; const bf16* YP; float* Hout; const float* gain; bf16* HN; float* out;
    const bf16* Wsk; const float* b0; const float* b1;
    unsigned* cnt; int* tokl; float* pw; float* LF; float* tokw; float* tokr;
    const float* SS; float* RSTD;
};
template <int MODE>
__device__ __forceinline__ void row_phase(Frame& F, const RowArgs& A) {
    constexpr int NCT = (MODE == 1) ? 3 : 1, LGP = NCT * 32, RU = (MODE == 1) ? 4 : 2;
    LAS float* PB = (LAS float*)(F.lds + RING_OFF);
    LAS float* LG = PB + 64 * LGP;
    for (int blk = blockIdx.x; blk < M / 64; blk += F.G) {
        const int r0 = blk * 64;
        if constexpr (MODE >= 2)
        for (int k0 = 0; k0 < 8; k0 += RU) {
            f32x4 v[RU][8];
#pragma unroll
            for (int u = 0; u < RU; ++u) { const GAS v2u* xr = (const GAS v2u*)(A.Hin + (size_t)(r0 + F.wave * 8 + k0 + u) * D) + F.lane;
#pragma unroll
                for (int j = 0; j < 8; ++j) { const v2u hb = xr[64 * j]; v[u][j].x = bf_lo(hb.x); v[u][j].y = bf_hi(hb.x); v[u][j].z = bf_lo(hb.y); v[u][j].w = bf_hi(hb.y); } }
            if constexpr (MODE >= 2) {
                v2u ya[RU][8], yb[RU][8];
#pragma unroll
                for (int u = 0; u < RU; ++u) { const int row = r0 + F.wave * 8 + k0 + u;
                    const GAS v2u* y0 = (const GAS v2u*)(A.YP + (size_t)(2 * row) * D) + F.lane; const GAS v2u* y1 = (const GAS v2u*)(A.YP + (size_t)(2 * row + 1) * D) + F.lane;
#pragma unroll
                    for (int j = 0; j < 8; ++j) { ya[u][j] = y0[64 * j]; yb[u][j] = y1[64 * j]; } }
#pragma unroll
                for (int u = 0; u < RU; ++u)
#pragma unroll
                    for (int j = 0; j < 8; ++j) { const v2u a = ya[u][j], b = yb[u][j];
                        v[u][j].x += bf_lo(a.x) + bf_lo(b.x); v[u][j].y += bf_hi(a.x) + bf_hi(b.x); v[u][j].z += bf_lo(a.y) + bf_lo(b.y); v[u][j].w += bf_hi(a.y) + bf_hi(b.y); }
            }
#pragma unroll
            for (int u = 0; u < RU; ++u) {
                const int row = r0 + F.wave * 8 + k0 + u;
                float s = 0.f;
#pragma unroll
                for (int j = 0; j < 8; ++j) s += (v[u][j].x * v[u][j].x + v[u][j].y * v[u][j].y) + (v[u][j].z * v[u][j].z + v[u][j].w * v[u][j].w);
                const float rstd = 1.f / sqrtf(wave_sum(s) * (1.f / D) + RMS_EPS);
                const GAS f32x4* gr = (const GAS f32x4*)A.gain + F.lane;
                if constexpr (MODE == 3) { GAS f32x4* o = (GAS f32x4*)(A.out + (size_t)row * D) + F.lane;
#pragma unroll
                    for (int j = 0; j < 8; ++j) { const f32x4 g = gr[64 * j]; f32x4 w; w.x = v[u][j].x * rstd * g.x; w.y = v[u][j].y * rstd * g.y; w.z = v[u][j].z * rstd * g.z; w.w = v[u][j].w * rstd * g.w; __builtin_nontemporal_store(w, o + 64 * j); } }
                else { GAS v2u* o8 = (GAS v2u*)(A.HN + (size_t)row * D) + F.lane;
#pragma unroll
                    for (int j = 0; j < 8; ++j) { const f32x4 g = gr[64 * j]; v2u w; w.x = pk2(v[u][j].x * rstd * g.x, v[u][j].y * rstd * g.y); w.y = pk2(v[u][j].z * rstd * g.z, v[u][j].w * rstd * g.w); o8[64 * j] = w; } }
            }
        }
        if constexpr (MODE == 1 || MODE == 2) {
            LAS float* RS_l = PB + 4 * 64 * LGP;
            if constexpr (MODE == 1) { if (F.tid < 64) { const GAS f32x4* ss = (const GAS f32x4*)(A.SS + (size_t)(r0 + F.tid) * 32); float t = 0.f;
#pragma unroll
                    for (int j = 0; j < 8; ++j) { const f32x4 q = ss[j]; t += (q.x + q.y) + (q.z + q.w); }
                    const float rs = 1.f / sqrtf(t * (1.f / D) + RMS_EPS); RS_l[F.tid] = rs; A.RSTD[r0 + F.tid] = rs; } }
            VM_WAIT(); __syncthreads();
            const int r32 = F.lane & 31, hi = F.lane >> 5;
            f32x16 acc[2][NCT];
#pragma unroll
            for (int rt = 0; rt < 2; ++rt)
#pragma unroll
                for (int ct = 0; ct < NCT; ++ct) acc[rt][ct] = (f32x16){};
            {
                const bf16* ap = (MODE == 1 ? A.Hin : A.HN) + (size_t)(r0 + r32) * D + F.wave * 256 + 8 * hi;
                const bf16* bp = A.Wsk + (size_t)r32 * D + F.wave * 256 + 8 * hi;
                constexpr int QB = (MODE == 1) ? 4 : 8;
#pragma unroll 1
                for (int kb = 0; kb < 16 / QB; ++kb) {
                    bf16x8 af[2][QB], bfr[NCT][QB];
#pragma unroll
                    for (int q = 0; q < QB; ++q) {
#pragma unroll
                        for (int rt = 0; rt < 2; ++rt) af[rt][q] = *(const GAS bf16x8*)(ap + (size_t)rt * 32 * D + (kb * QB + q) * 16);
#pragma unroll
                        for (int ct = 0; ct < NCT; ++ct) bfr[ct][q] = *(const GAS bf16x8*)(bp + (size_t)ct * 32 * D + (kb * QB + q) * 16); }
#pragma unroll
                    for (int q = 0; q < QB; ++q)
#pragma unroll
                        for (int rt = 0; rt < 2; ++rt)
#pragma unroll
                            for (int ct = 0; ct < NCT; ++ct) acc[rt][ct] = __builtin_amdgcn_mfma_f32_32x32x16_bf16(af[rt][q], bfr[ct][q], acc[rt][ct], 0, 0, 0);
                }
            }
#define RP_STORE(buf) do { _Pragma("unroll") for (int rt = 0; rt < 2; ++rt) _Pragma("unroll") for (int ct = 0; ct < NCT; ++ct) _Pragma("unroll") for (int r = 0; r < 16; ++r) \
                (buf)[(rt * 32 + (r & 3) + 8 * (r >> 2) + 4 * hi) * LGP + ct * 32 + r32] = acc[rt][ct][r]; } while (0)
#define RP_ADD(buf) do { _Pragma("unroll") for (int rt = 0; rt < 2; ++rt) _Pragma("unroll") for (int ct = 0; ct < NCT; ++ct) _Pragma("unroll") for (int r = 0; r < 16; ++r) \
                acc[rt][ct][r] += (buf)[(rt * 32 + (r & 3) + 8 * (r >> 2) + 4 * hi) * LGP + ct * 32 + r32]; } while (0)
            if (F.wave >= 4) RP_STORE(PB + (F.wave - 4) * 64 * LGP);
            LDS_WAIT(); __syncthreads();
            if (F.wave < 4) RP_ADD(PB + F.wave * 64 * LGP);
            LDS_WAIT(); __syncthreads();
            if (F.wave == 2 || F.wave == 3) RP_STORE(PB + (F.wave - 2) * 64 * LGP);
            LDS_WAIT(); __syncthreads();
            if (F.wave < 2) RP_ADD(PB + F.wave * 64 * LGP);
            LDS_WAIT(); __syncthreads();
            if (F.wave == 1) RP_STORE(PB);
            LDS_WAIT(); __syncthreads();
            if (F.wave == 0) { RP_ADD(PB); RP_STORE(LG); }
            LDS_WAIT(); __syncthreads();
#undef RP_STORE
#undef RP_ADD
            if constexpr (MODE == 1) {
                if (F.tid < 64) {
                    const int tok = r0 + F.tid; const LAS float* lg = LG + F.tid * LGP;
                    float gl[8]; const float rs = RS_l[F.tid];
#pragma unroll
                    for (int i = 0; i < 8; ++i) gl[i] = lg[i] * rs + A.b0[i];
                    int gs = 0; float gm = gl[0];
#pragma unroll
                    for (int i = 1; i < 8; ++i) if (gl[i] > gm) { gm = gl[i]; gs = i; }
                    float den = 0.f;
#pragma unroll
                    for (int i = 0; i < 8; ++i) den += expf(gl[i] - gm);
                    const float pg = 1.f / den;
                    float el[8];
#pragma unroll
                    for (int i = 0; i < 8; ++i) el[i] = lg[8 + gs * 8 + i] * rs + A.b1[gs * 8 + i];
                    int i0 = 0; float t0 = el[0];
#pragma unroll
                    for (int i = 1; i < 8; ++i) if (el[i] > t0) { t0 = el[i]; i0 = i; }
                    int i1 = 0; float t1 = -__builtin_inff();
#pragma unroll
                    for (int i = 0; i < 8; ++i) if (i != i0 && el[i] > t1) { t1 = el[i]; i1 = i; }
                    const float w0 = pg / (1.f + expf(t1 - t0)), w1 = pg - w0;
                    const int e0 = gs * 8 + i0, e1 = gs * 8 + i1;
                    const unsigned p0 = __hip_atomic_fetch_add(A.cnt + e0, 1u, RLX_AGENT), p1 = __hip_atomic_fetch_add(A.cnt + e1, 1u, RLX_AGENT);
                    A.tokl[(size_t)e0 * M + p0] = 2 * tok; A.tokl[(size_t)e1 * M + p1] = 2 * tok + 1;
                    A.tokw[(size_t)e0 * M + p0] = w0; A.tokw[(size_t)e1 * M + p1] = w1; A.tokr[(size_t)e0 * M + p0] = rs; A.tokr[(size_t)e1 * M + p1] = rs;
                    A.pw[2 * tok] = w0; A.pw[2 * tok + 1] = w1;
                }
            } else {
#pragma unroll
                for (int q = 0; q < 2; ++q) { const int idx = F.tid + q * 512, tl = idx >> 4, h = idx & 15;
                    A.LF[(size_t)(r0 + tl) * 16 + h] = log_sigmoid_(LG[tl * LGP + h] + A.b0[h]); }
            }
            __syncthreads();
        }
    }
}
__device__ __forceinline__ void cumsum_phase(Frame& F, const float* LF, float* CUMB) {
    LAS float* wt = (LAS float*)(F.lds + RING_OFF);
    for (int bh = blockIdx.x; bh < NB * NH; bh += F.G) {
        const int b = bh >> 4, h = bh & 15, s0 = 4 * F.tid;
        float c0 = LF[(size_t)(b * SEQ + s0) * 16 + h], c1 = c0 + LF[(size_t)(b * SEQ + s0 + 1) * 16 + h], c2 = c1 + LF[(size_t)(b * SEQ + s0 + 2) * 16 + h], c3 = c2 + LF[(size_t)(b * SEQ + s0 + 3) * 16 + h];
        float incl = c3;
#pragma unroll
        for (int o = 1; o < 64; o <<= 1) { const float t = __shfl_up(incl, o); if (F.lane >= o) incl += t; }
        if (F.lane == 63) wt[F.wave] = incl;
        LDS_WAIT(); __syncthreads();
        float off = incl - c3;
        for (int w = 0; w < F.wave; ++w) off += wt[w];
        const float sc = -1.f / fox::SCALE;
        f32x4 o4; o4.x = (off + c0) * sc; o4.y = (off + c1) * sc; o4.z = (off + c2) * sc; o4.w = (off + c3) * sc;
        *(GAS f32x4*)(CUMB + (size_t)bh * SEQ + s0) = o4;
        __syncthreads();
    }
}
__device__ __forceinline__ MoeTab moe_tables(Frame& F, const unsigned* cnt) {
    LAS int* base = (LAS int*)(F.lds + MOE_OFF);
    LAS int* cnt_l = base; LAS int* tstart = base + 64; LAS int* ntile = base + 128; LAS int* Tw = base + 192; LAS int* mt_e = base + 196; LAS int* mt_row0 = base + 196 + MAXMT;
    __syncthreads();
    if (F.tid < 64) {
        const int c = (int)__hip_atomic_load(cnt + F.tid, RLX_AGENT); const int nt = (c + 255) >> 8;
        int incl = nt;
#pragma unroll
        for (int o = 1; o < 64; o <<= 1) { const int t = __shfl_up(incl, o); if (F.lane >= o) incl += t; }
        cnt_l[F.tid] = c; tstart[F.tid] = incl - nt; ntile[F.tid] = nt; if (F.tid == 63) Tw[0] = incl;
    }
    LDS_WAIT(); __syncthreads();
    const int T = Tw[0];
    for (int mt = F.tid; mt < T; mt += NWAVES * 64) { int e = 0;
        for (int k = 0; k < 64; ++k) e += (tstart[k] + ntile[k] <= mt) ? 1 : 0;
        e = e > 63 ? 63 : e; mt_e[mt] = e; mt_row0[mt] = (mt - tstart[e]) * 256; }
    LDS_WAIT(); __syncthreads();
    MoeTab t; t.cnt = cnt_l; t.mt_e = mt_e; t.mt_row0 = mt_row0; t.T = T; return t;
}

#ifndef MK_PER_PHASE
#define MK_PER_PHASE 0
#endif
constexpr int NPHASE = 17;
__global__ void __launch_bounds__(NWAVES * 64, 2) hybrid_fwd(Args args) {
    extern __shared__ __attribute__((aligned(16))) unsigned char lds[];
    Frame F;
    F.lds = (LAS unsigned char*)lds;
    F.MISC = (volatile LAS unsigned*)(F.lds + MISC_OFF);
    F.tid = threadIdx.x; F.lane = F.tid & 63; F.wave = __builtin_amdgcn_readfirstlane(F.tid >> 6);
    const int wave0 = F.wave;
    F.G = gridDim.x; { const int bx = blockIdx.x; F.vcu = (F.G % 8 == 0) ? (bx % 8) * (F.G / 8) + bx / 8 : bx; }
    F.ws = args.ws;
    F.ctl = (gu32*)(args.ws + WS_CTL);
    for (int u = F.tid; u < (LDS_BYTES - LDSCTL_OFF) / 4; u += NWAVES * 64) ((LAS unsigned*)(F.lds + LDSCTL_OFF))[u] = 0u;
    __syncthreads();
    XcdBarrier bar; bar.bar = (unsigned*)(F.ctl + CW_BAR); bar.x = 0; bar.st = nullptr;
    if (!MK_PER_PHASE) bar = xcd_barrier_post((unsigned*)(F.ctl + CW_BAR), F.MISC + 8);
#define GRID_BAR() do { if (MK_PER_PHASE) { if (F.tid == 0) __hip_atomic_store(F.ctl + CW_TMO, 0xBADBA0u, RLX_AGENT); } else { XcdBarrier bb_ = bar; asm volatile("" : "+s"(bb_.bar)); xcd_barrier(bb_, F.tid); } } while (0)
    const int lo = args.ph_lo, hi = args.ph_hi; (void)lo; (void)hi;
#ifndef PH_MASK
#define PH_MASK 0x1ffff
#endif
#if MK_PER_PHASE
#define IN(k) ((((PH_MASK) >> (k)) & 1) && lo <= (k) && (k) < hi)
#else
#define IN(k) ((((PH_MASK) >> (k)) & 1) != 0)
#endif
#define BOTH(k) (IN(k) && IN((k) + 1))
    const int G = F.G, cid = (int)blockIdx.x, cls = ((int)blockIdx.x >> 3) & 1;
#define pHN ((bf16*)(ws + WS_HN))
#define pUA ((bf16*)(ws + WS_UA))
#define pGL ((bf16*)(ws + WS_GL))
#define pOG ((bf16*)(ws + WS_OG))
#define pH2 ((float*)(ws + WS_H2))
#define pHB ((bf16*)(ws + WS_H2 + 64 * MiB))
#define pYP ((bf16*)(ws + WS_YP))
#define pHID ((bf16*)(ws + WS_HID))
#define pTOKL ((int*)(ws + WS_TOKL))
#define pPW ((float*)(ws + WS_PW))
#define pSS ((float*)(ws + WS_SS))
#define pRSTD ((float*)(ws + WS_RSTD))
#define PH() unsigned char* ws; { int l_; asm volatile("v_mbcnt_lo_u32_b32 %0, -1, 0\n\tv_mbcnt_hi_u32_b32 %0, -1, %0" : "=v"(l_)); F.lane = l_; F.wave = wave0; F.tid = wave0 * 64 + l_; \
    unsigned wl_ = __builtin_amdgcn_readfirstlane((unsigned)(uintptr_t)args.ws), wh_ = __builtin_amdgcn_readfirstlane((unsigned)((uintptr_t)args.ws >> 32)); asm volatile("" : "+s"(wl_), "+s"(wh_)); ws = (unsigned char*)(((uintptr_t)wh_ << 32) | wl_); F.ws = ws; }
    if (IN(0)) { PH(); p0_prologue(F, args, ws); if (BOTH(0)) GRID_BAR(); }
    if (IN(1)) { PH(); SchedDense S; S.init(pHN, D, ws + WS_WS5IN, D, M / 256, DS / 256, G, cid); EpiU E{pUA};
        if (cls == 0) { moe_conv(F, args, ws, 0, 0, 3); __syncthreads(); } pg8::gemm_phase<EpiU, SchedDense, true>(F.lds + RING_OFF, F.tid, D, D, D, S, E); if (cls == 1) { __syncthreads(); moe_conv(F, args, ws, 0, 0, 3); } if (BOTH(1)) GRID_BAR(); }
    if (IN(2)) { PH(); SchedS5<1> S; S.init(pUA, ws + WS_PT, 256, 512, G, cid); EpiScan E{pUA, (const float*)(ws + WS_AL)};
        pg8::gemm_phase<EpiScan, SchedS5<1>, false>(F.lds + RING_OFF, F.tid, 512, KP, 512, S, E);
        if (G > 2 * NG && cid >= 2 * NG) conv_range<2>(F, args, ws, 0, CONV_TOTAL_FOX, (cid - 2 * NG) * NWAVES + F.wave, (G - 2 * NG) * NWAVES);
        if (BOTH(2)) GRID_BAR(); }
    if (IN(3)) { PH(); SchedS5<2> S; S.init(pUA, ws + WS_TT, 512, KP, G, cid); EpiY E{pUA, args.in[9], pGL};
        if (G <= 2 * NG && cls == 0) { conv_run<2>(F, args, ws, 0, 1); __syncthreads(); } pg8::gemm_phase<EpiY, SchedS5<2>, true>(F.lds + RING_OFF, F.tid, KP, KP, KP, S, E); if (G <= 2 * NG && cls == 1) { __syncthreads(); conv_run<2>(F, args, ws, 0, 1); } if (BOTH(3)) GRID_BAR(); }
    if (IN(4)) { PH(); SchedDense S; S.init(pGL, DS, ws + WS_WGLU, DS, M / 256, DS / 256, G, cid); EpiGlu E{pGL, args.in[12], pOG};
        if (cls == 0) { moe_conv(F, args, ws, 0, 1, 3); __syncthreads(); } pg8::gemm_phase<EpiGlu, SchedDense, true>(F.lds + RING_OFF, F.tid, DS, DS, DS, S, E); if (cls == 1) { __syncthreads(); moe_conv(F, args, ws, 0, 1, 3); } if (BOTH(4)) GRID_BAR(); }
    if (IN(5)) { PH(); SchedDense S; S.init(pOG, DS, ws + WS_WS5OUT, DS, M / 256, D / 256, G, cid); EpiResB E{args.in[0], pHB, pSS};
        if (cls == 0) { moe_conv(F, args, ws, 0, 2, 3); __syncthreads(); } pg8::gemm_phase<EpiResB, SchedDense, true>(F.lds + RING_OFF, F.tid, DS, DS, DS, S, E); if (cls == 1) { __syncthreads(); moe_conv(F, args, ws, 0, 2, 3); } if (BOTH(5)) GRID_BAR(); }

    {
        constexpr int pR = 6;
        unsigned* const cnt = (unsigned*)(F.ctl + CW_CNT) + 0;
        if (IN(pR)) { PH(); RowArgs A{}; A.Hin = pHB; A.gain = args.in[14]; A.HN = pHN; A.Wsk = (const bf16*)(ws + WS_WR) + (size_t)0 * (256 * 1024); A.b0 = args.in[16]; A.b1 = args.in[18];
            A.cnt = cnt; A.tokl = pTOKL; A.pw = pPW; A.SS = pSS; A.RSTD = pRSTD; A.tokw = (float*)(ws + WS_TOKW); A.tokr = (float*)(ws + WS_TOKR);
            row_phase<1>(F, A); if (BOTH(pR)) GRID_BAR(); }
        if (IN(pR + 1)) { PH(); const MoeTab tab = moe_tables(F, cnt);
            const int nwg_ = tab.T * 4, R_ = (nwg_ + G - 1) / G, Gp = (nwg_ + R_ - 1) / R_, nfree = G - Gp;
            constexpr int IPW = 64;
            const int npre_ = nfree * NWAVES * IPW < CONV_TOTAL_MOE ? nfree * NWAVES * IPW : CONV_TOTAL_MOE;
            if (cid == 0 && F.tid == 0) __hip_atomic_store(F.ctl + CW_NPRE, (unsigned)npre_, RLX_AGENT);
            if (cid < Gp) {
            SchedMoeGU S; S.T.init(tab.T, 4, Gp, cid); S.tab = tab; S.HN = (const char*)pHB; S.W = (const char*)(ws + WS_WGU) + (size_t)0 * NE * 1024 * D * 2; S.tokl = pTOKL; S.tid = F.tid;
            EpiGU E{pHID, tab, (const float*)(ws + WS_TOKR)};
            pg8::gemm_phase<EpiGU, SchedMoeGU, true>(F.lds + RING_OFF, F.tid, D, D, D, S, E);
            } else { conv_range<1>(F, args, ws, 0, npre_, (cid - Gp) * NWAVES + F.wave, nfree * NWAVES); }
            if (BOTH(pR + 1)) GRID_BAR(); }
        if (IN(pR + 2)) { PH(); const MoeTab tab = moe_tables(F, cnt);
            SchedMoeDN S; S.T.init(tab.T, 8, G, cid); S.T.split = 1;   S.tab = tab; S.HID = (const char*)pHID; S.W = (const char*)(ws + WS_WDN) + (size_t)0 * NE * D * DE * 2;
            EpiDN E{tab, pTOKL, (const float*)(ws + WS_TOKW), pYP};
            pg8::gemm_phase<EpiDN, SchedMoeDN, true>(F.lds + RING_OFF, F.tid, DE, DE, DE, S, E); if (BOTH(pR + 2)) GRID_BAR(); }
        }
    {
            if (IN(9)) { PH(); RowArgs A{}; A.Hin = pHB; A.YP = pYP; A.gain = args.in[22]; A.HN = pHN; A.Wsk = (const bf16*)(ws + WS_WF); A.b0 = args.in[24]; A.LF = (float*)(ws + WS_LF);
                row_phase<2>(F, A); if (BOTH(9)) GRID_BAR(); }
            if (IN(10)) { { PH(); cumsum_phase(F, (const float*)(ws + WS_LF), (float*)(ws + WS_CUMB)); }
#pragma unroll 1
                for (int seg = 0; seg < 2; ++seg) { PH();
                    const int split_ = 2 * (int)((blockIdx.x >> 3) & 3);
                    SchedDense S; S.init(pHN, D, ws + WS_WFOXIN, D, M / 256, 4 * D / 256, G, cid); EpiQKVG E{(bf16*)(ws + WS_Q), (size_t)(WS_K - WS_Q) / 2};
                    S.i_begin = seg ? split_ : 0; S.i_end = seg ? (1 << 30) : split_;
                    pg8::gemm_phase<EpiQKVG, SchedDense, true>(F.lds + RING_OFF, F.tid, D, D, D, S, E);
                    if (seg == 0) { asm volatile("s_waitcnt vmcnt(0)" ::: "memory"); __syncthreads();
                        const int npre_ = (int)__hip_atomic_load(F.ctl + CW_NPRE, RLX_AGENT), gw_ = F.vcu * NWAVES + F.wave;
                        conv_range<1>(F, args, ws, npre_, npre_ + (CONV_TOTAL_MOE - npre_) / 2, gw_, G * NWAVES); __syncthreads(); } }
                if (BOTH(10)) GRID_BAR(); }
            if (IN(11)) { PH(); static_assert(WS_V - WS_K == fox::VK_DELTA, "V = K + 64 MiB");
                const fox::Tens T{(const bf16*)(ws + WS_Q), (const bf16*)(ws + WS_K), (bf16*)(ws + WS_Q), (const bf16*)(ws + WS_SG), (const float*)(ws + WS_CUMB)};
                const int npre_ = (int)__hip_atomic_load(F.ctl + CW_NPRE, RLX_AGENT), gw_ = F.vcu * NWAVES + F.wave, mid_ = npre_ + (CONV_TOTAL_MOE - npre_) / 2;
                if (cls == 0) { conv_range<1>(F, args, ws, mid_, CONV_TOTAL_MOE, gw_, G * NWAVES); __syncthreads(); }
                fox::fox_phase((char*)lds + RING_OFF, T, G, cid, F.tid);
                if (cls == 1) { asm volatile("s_waitcnt vmcnt(0)" ::: "memory"); __syncthreads(); conv_range<1>(F, args, ws, mid_, CONV_TOTAL_MOE, gw_, G * NWAVES); }
                if (BOTH(11)) GRID_BAR(); }
            if (IN(12)) { PH(); SchedDense S; S.init(ws + WS_Q, D, ws + WS_WFOXOUT, D, M / 256, D / 256, G, cid); EpiResYPB E{pHB, pYP, pSS};
                pg8::gemm_phase<EpiResYPB, SchedDense, true>(F.lds + RING_OFF, F.tid, D, D, D, S, E); if (BOTH(12)) GRID_BAR(); }
            }
    {
        constexpr int pR = 13;
        unsigned* const cnt = (unsigned*)(F.ctl + CW_CNT) + 64;
        if (IN(pR)) { PH(); RowArgs A{}; A.Hin = pHB; A.gain = args.in[26]; A.HN = pHN; A.Wsk = (const bf16*)(ws + WS_WR) + (size_t)1 * (256 * 1024); A.b0 = args.in[28]; A.b1 = args.in[30];
            A.cnt = cnt; A.tokl = pTOKL; A.pw = pPW; A.SS = pSS; A.RSTD = pRSTD; A.tokw = (float*)(ws + WS_TOKW); A.tokr = (float*)(ws + WS_TOKR);
            row_phase<1>(F, A); if (BOTH(pR)) GRID_BAR(); }
        if (IN(pR + 1)) { PH(); const MoeTab tab = moe_tables(F, cnt);
            SchedMoeGU S; S.T.init(tab.T, 4, G, cid); S.T.split = 1;   S.tab = tab; S.HN = (const char*)pHB; S.W = (const char*)(ws + WS_WGU) + (size_t)1 * NE * 1024 * D * 2; S.tokl = pTOKL; S.tid = F.tid;
            EpiGU E{pHID, tab, (const float*)(ws + WS_TOKR)};
            pg8::gemm_phase<EpiGU, SchedMoeGU, true>(F.lds + RING_OFF, F.tid, D, D, D, S, E); if (BOTH(pR + 1)) GRID_BAR(); }
        if (IN(pR + 2)) { PH(); const MoeTab tab = moe_tables(F, cnt);
            SchedMoeDN S; S.T.init(tab.T, 8, G, cid); S.T.split = 1;   S.tab = tab; S.HID = (const char*)pHID; S.W = (const char*)(ws + WS_WDN) + (size_t)1 * NE * D * DE * 2;
            EpiDN E{tab, pTOKL, (const float*)(ws + WS_TOKW), pYP};
            pg8::gemm_phase<EpiDN, SchedMoeDN, true>(F.lds + RING_OFF, F.tid, DE, DE, DE, S, E); if (BOTH(pR + 2)) GRID_BAR(); }
        }
    if (IN(16)) { PH(); RowArgs A{}; A.Hin = pHB; A.YP = pYP; A.gain = args.in[34]; A.out = args.out; row_phase<3>(F, A); }
#undef IN
#undef BOTH
#undef GRID_BAR
#undef PH
#undef pHN
#undef pUA
#undef pGL
#undef pOG
#undef pH2
#undef pHB
#undef pYP
#undef pHID
#undef pTOKL
#undef pPW
#undef pSS
#undef pRSTD
}

extern "C" void kernel_launch(void* const* d_in, const int* in_sizes, int n_in, void* d_out, int out_size, void* d_ws, size_t ws_size, hipStream_t stream) {
    static int grid = 0;
    if (grid == 0) {
        if (n_in != 35 || in_sizes[0] != M * D || out_size != M * D || ws_size < WS_END) { fprintf(stderr, "kernel_launch: shape/workspace mismatch (n_in %d in0 %d out %d ws %zu need %zu)\n", n_in, n_in > 0 ? in_sizes[0] : -1, out_size, ws_size, (size_t)WS_END); grid = -1; return; }
        int dev = 0, cus = 0, per_cu = 0;
        if (hipGetDevice(&dev) != hipSuccess || hipDeviceGetAttribute(&cus, hipDeviceAttributeMultiprocessorCount, dev) != hipSuccess) { grid = -1; return; }
        if (hipFuncSetAttribute((const void*)hybrid_fwd, hipFuncAttributeMaxDynamicSharedMemorySize, LDS_BYTES) != hipSuccess) { fprintf(stderr, "kernel_launch: hipFuncSetAttribute failed\n"); grid = -1; return; }
        if (hipOccupancyMaxActiveBlocksPerMultiprocessor(&per_cu, (const void*)hybrid_fwd, NWAVES * 64, LDS_BYTES) != hipSuccess || per_cu < 1)
            fprintf(stderr, "kernel_launch: occupancy query reports %d workgroups per CU\n", per_cu);
        (void)hipGetLastError();
        grid = cus;
    }
    if (grid < 0) return;
    if (hipMemsetAsync((char*)d_ws + WS_CTL, 0, CTL_ZERO_BYTES, stream) != hipSuccess) return;
    Args a{};
    for (int i = 0; i < 35; ++i) a.in[i] = (const float*)d_in[i];
    a.out = (float*)d_out; a.ws = (unsigned char*)d_ws;
#if MK_PER_PHASE
    for (int p = 0; p < NPHASE; ++p) { a.ph_lo = p; a.ph_hi = p + 1; hipLaunchKernelGGL(hybrid_fwd, dim3(grid), dim3(NWAVES * 64), LDS_BYTES, stream, a); }
#else
    a.ph_lo = 0; a.ph_hi = NPHASE;
    hipLaunchKernelGGL(hybrid_fwd, dim3(grid), dim3(NWAVES * 64), LDS_BYTES, stream, a);
#endif
    const hipError_t le = hipPeekAtLastError();
    if (le != hipSuccess) fprintf(stderr, "kernel_launch: launch failed: %s\n", hipGetErrorName(le));
}
```

```cpp
#include <hip/hip_runtime.h>
#include <cstdio>
#include <cstdint>

namespace pg8 {
#define PG8_LAS __attribute__((address_space(3)))
typedef unsigned short bf16_t;
typedef short bf16x8 __attribute__((ext_vector_type(8)));
typedef float f32x4 __attribute__((ext_vector_type(4)));
typedef float f32x2 __attribute__((ext_vector_type(2)));
typedef unsigned u32x4 __attribute__((ext_vector_type(4)));
constexpr int BM = 256, BK = 64, HALF = 128, HTB = HALF * BK * 2  , STAGE_BYTES = 8 * HTB, NXCD = 8, WGM = 8;

__host__ __device__ __forceinline__ int lds_byte(int r, int c) { const int st = (r >> 4) * 2 + (c >> 5), rr = r & 15, cc = c & 31, ob = rr * 64 + cc * 2; return st * 1024 + (ob ^ (((ob >> 9) & 1) << 5)); }
__host__ __device__ __forceinline__ void stage_rc(int b, int& R, int& C) { const int st = b / 1024, sb = b % 1024, swz = sb ^ (((sb >> 9) & 1) << 5); R = (st >> 1) * 16 + swz / 64; C = (st & 1) * 32 + (swz % 64) / 2; }
__host__ __device__ __forceinline__ int perm32(int rho) { const int n = rho >> 4, i = rho & 15; return 8 * (i >> 2) + 4 * n + (i & 3); }

struct Unit { int pm, pn, half; };
struct UPtr { const char* A; const char* B; };

struct TileOrder {
    int nM, nN, nwg, G, c;
    __device__ __forceinline__ void init(int nM_, int nN_, int G_, int c_) { nM = nM_; nN = nN_; nwg = nM * nN; G = G_; c = c_; split = 0; }
    int split;
    __device__ __forceinline__ bool next(int i, Unit& u) const {
        if (split) { const int full = (nwg / G) * G, rem = nwg - full;
            if (rem > 0 && 2 * rem <= G && i == nwg / G) { if (c >= 2 * rem) return false; Unit t; const bool ok = next_lin((long)full + (c >> 1), t); u = t; u.half = c & 1; return ok; } }
        return next_lin((long)i * G + c, u);
    }
    __device__ __forceinline__ bool next_lin(const long L, Unit& u) const {
        if (L >= nwg) return false;
        int wgid = (int)L; { const int q = nwg / NXCD, r = nwg % NXCD, xcd = wgid % NXCD, off = wgid / NXCD; wgid = (xcd < r ? xcd * (q + 1) : r * (q + 1) + (xcd - r) * q) + off; }
        const int nig = WGM * nN, gid = wgid / nig, fm = gid * WGM, gsz = (nM - fm) < WGM ? (nM - fm) : WGM;
        u.pm = fm + ((wgid % nig) % gsz); u.pn = (wgid % nig) / gsz; u.half = -1; return true;
    }
};

__device__ __forceinline__ unsigned cvt_pk_bf16(float lo, float hi) { unsigned r; asm volatile("v_cvt_pk_bf16_f32 %0, %1, %2" : "=v"(r) : "v"(lo), "v"(hi)); return r; }
__device__ __forceinline__ float bf_lo(unsigned w) { return __uint_as_float(w << 16); }
__device__ __forceinline__ float bf_hi(unsigned w) { return __uint_as_float(w & 0xffff0000u); }

template <class Epi, class Sched, bool ALIGN_EPI>
__device__ __forceinline__ void gemm_phase(PG8_LAS unsigned char* lds, const int tid, const int K, const int lda, const int ldb, const Sched& S, const Epi& E) {
    const int wid = __builtin_amdgcn_readfirstlane(tid >> 6), lane = tid & 63, wr = wid >> 2, wc = wid & 3, fr = lane & 15, fq = lane >> 4;
    const int nt = K / BK;
    unsigned voffB[2], offC[2][2], offN[2][2];
    const unsigned hstepA = (unsigned)HALF * (unsigned)lda * 2u;
    const size_t hstepB = (size_t)HALF * ldb * 2;
#pragma unroll
    for (int i = 0; i < 2; ++i) { int R, C; stage_rc(tid * 16 + i * 8192, R, C); const int Rb = Epi::PERM ? ((R & ~31) + perm32(R & 31)) : R;
        offC[0][i] = (unsigned)(R * lda + C) * 2u; offC[1][i] = offC[0][i] + hstepA; voffB[i] = (unsigned)(Rb * ldb + C) * 2u; }
    const size_t kstep = (size_t)(BK * 2);
    const unsigned ldsw = (unsigned)wid * 1024u;
    const int aoff = lds_byte(wr * 64 + fr, fq * 8), boff = lds_byte(wc * 32 + fr, fq * 8);
#define PG8_SA(b, h) (((b) * 2 + (h)) * HTB)
#define PG8_SB(b, h) ((4 + (b) * 2 + (h)) * HTB)
#define PG8_STAGEB(bufoff, gbase) do { _Pragma("unroll") for (int _i = 0; _i < 2; ++_i) \
        __builtin_amdgcn_global_load_lds((const unsigned*)((const char*)(gbase) + voffB[_i]), (PG8_LAS unsigned*)(lds + (bufoff) + ldsw + _i * 8192), 16, 0, 0); } while (0)
#define PG8_STAGEA(bufoff, gbase, O, h) do { _Pragma("unroll") for (int _i = 0; _i < 2; ++_i) \
        __builtin_amdgcn_global_load_lds((const unsigned*)((const char*)(gbase) + (Sched::GATHER ? (size_t)0 : (size_t)(h) * hstepA) + (O)[Sched::GATHER ? (h) : 0][_i]), (PG8_LAS unsigned*)(lds + (bufoff) + ldsw + _i * 8192), 16, 0, 0); } while (0)
#define PG8_LDA(dst, b, h) do { _Pragma("unroll") for (int m = 0; m < 4; ++m) _Pragma("unroll") for (int k = 0; k < 2; ++k) dst[m][k] = *(const PG8_LAS bf16x8*)(lds + PG8_SA(b, h) + aoff + m * 2048 + k * 1024); } while (0)
#define PG8_LDB(dst, b, h) do { _Pragma("unroll") for (int n = 0; n < 2; ++n) _Pragma("unroll") for (int k = 0; k < 2; ++k) dst[n][k] = *(const PG8_LAS bf16x8*)(lds + PG8_SB(b, h) + boff + n * 2048 + k * 1024); } while (0)
#define PG8_MMA(ai, bj, At, Bt) do { __builtin_amdgcn_s_setprio(1); _Pragma("unroll") for (int m = 0; m < 4; ++m) _Pragma("unroll") for (int n = 0; n < 2; ++n) _Pragma("unroll") for (int k = 0; k < 2; ++k) \
        acc[ai][bj][m][n] = __builtin_amdgcn_mfma_f32_16x16x32_bf16(Bt[n][k], At[m][k], acc[ai][bj][m][n], 0, 0, 0); __builtin_amdgcn_s_setprio(0); } while (0)
#define PG8_WAIT_V(n) asm volatile("s_waitcnt vmcnt(" #n ")" ::: "memory")
#define PG8_WAIT_L(n) asm volatile("s_waitcnt lgkmcnt(" #n ")" ::: "memory")
#define PG8_BAR __builtin_amdgcn_s_barrier()
#define PG8_SCHED __builtin_amdgcn_sched_barrier(0)
    Unit cur, nxt; int ui = 0;
    if (!S.next(0, cur)) return;
    f32x4 acc[2][2][4][2];
#pragma unroll
    for (int a = 0; a < 2; ++a)
#pragma unroll
        for (int b = 0; b < 2; ++b)
#pragma unroll
            for (int m = 0; m < 4; ++m)
#pragma unroll
                for (int n = 0; n < 2; ++n) acc[a][b][m][n] = (f32x4){0.f, 0.f, 0.f, 0.f};
    bf16x8 At[4][2], B0[2][2], B1[2][2];
    UPtr cp = S.ptrs(cur);
    const char* cA = cp.A; const char* cB = cp.B;
    if constexpr (Sched::GATHER) { S.gather(cur, offC); }
    bool act0 = true, act1 = true;
    if constexpr (Sched::ROWSKIP) { const int v = S.valid(cur); act0 = wr * 64 < v && cur.half != 1; act1 = HALF + wr * 64 < v && cur.half != 0; }
#pragma unroll
    for (int h = 0; h < 2; ++h)
#pragma unroll
        for (int i = 0; i < 2; ++i) offN[h][i] = offC[h][i];
    PG8_STAGEB(PG8_SB(0, 0), cB); PG8_STAGEB(PG8_SB(0, 1), cB + hstepB); PG8_STAGEA(PG8_SA(0, 0), cA, offC, 0); PG8_STAGEA(PG8_SA(0, 1), cA, offC, 1);
    if (wr == 1) PG8_BAR;
    PG8_WAIT_V(2); PG8_BAR;
    PG8_STAGEB(PG8_SB(1, 0), cB + kstep); PG8_STAGEA(PG8_SA(1, 0), cA + kstep, offC, 0); PG8_STAGEB(PG8_SB(1, 1), cB + hstepB + kstep);
    PG8_WAIT_V(6); PG8_BAR;
    for (;;) {
        const bool has_next = S.next(ui + 1, nxt);
        const char* nA = cA; const char* nB = cB;
        if (has_next) { const UPtr np = S.ptrs(nxt); nA = np.A; nB = np.B; if constexpr (Sched::GATHER) { S.gather(nxt, offN); } }
        for (int t = 0; t < nt; t += 2) {
            const bool last = (t == nt - 2);
            const char* a1 = cA + (size_t)(t + 1) * kstep;
            const char* a2 = last ? nA : cA + (size_t)(t + 2) * kstep; const char* b2 = last ? nB : cB + (size_t)(t + 2) * kstep;
            const char* a3 = a2 + kstep; const char* b3 = b2 + kstep;
            unsigned o2[2][2];
#pragma unroll
            for (int h = 0; h < 2; ++h)
#pragma unroll
                for (int i = 0; i < 2; ++i) o2[h][i] = (Sched::GATHER && last) ? offN[h][i] : offC[h][i];
            PG8_LDB(B0, 0, 0); PG8_LDB(B1, 0, 1); PG8_SCHED; if (act0) PG8_LDA(At, 0, 0); PG8_STAGEA(PG8_SA(1, 1), a1, offC, 1);
            PG8_WAIT_V(8); PG8_WAIT_L(0); PG8_BAR; if (act0) { PG8_MMA(0, 0, At, B0); PG8_MMA(0, 1, At, B1); } PG8_BAR; PG8_SCHED;
            if (act1) PG8_LDA(At, 0, 1); PG8_STAGEB(PG8_SB(0, 0), b2); PG8_STAGEB(PG8_SB(0, 1), b2 + hstepB); PG8_STAGEA(PG8_SA(0, 0), a2, o2, 0);
            PG8_WAIT_V(8); PG8_WAIT_L(0); PG8_BAR; if (act1) { PG8_MMA(1, 0, At, B0); PG8_MMA(1, 1, At, B1); } PG8_BAR; PG8_SCHED;
            PG8_LDB(B0, 1, 0); PG8_LDB(B1, 1, 1); PG8_SCHED; if (act0) PG8_LDA(At, 1, 0); PG8_STAGEA(PG8_SA(0, 1), a2, o2, 1);
            PG8_WAIT_V(8); PG8_WAIT_L(0); PG8_BAR; if (act0) { PG8_MMA(0, 0, At, B0); PG8_MMA(0, 1, At, B1); } PG8_BAR; PG8_SCHED;
            if (act1) PG8_LDA(At, 1, 1); PG8_STAGEB(PG8_SB(1, 0), b3); PG8_STAGEB(PG8_SB(1, 1), b3 + hstepB); PG8_STAGEA(PG8_SA(1, 0), a3, o2, 0);
            PG8_WAIT_V(8); PG8_WAIT_L(0); PG8_BAR; if (act1) { PG8_MMA(1, 0, At, B0); PG8_MMA(1, 1, At, B1); } PG8_BAR; PG8_SCHED;
        }
        if constexpr (ALIGN_EPI) { if (wr == 0) PG8_BAR; }
        if constexpr (!Epi::AFTER_DRAIN) { E(acc, cur, wr, wc, fr, fq); }
        if (!has_next) break;
#pragma unroll
        for (int a = 0; a < 2; ++a)
#pragma unroll
            for (int b = 0; b < 2; ++b)
#pragma unroll
                for (int m = 0; m < 4; ++m)
#pragma unroll
                    for (int n = 0; n < 2; ++n) acc[a][b][m][n] = (f32x4){0.f, 0.f, 0.f, 0.f};
        cur = nxt; cA = nA; cB = nB; ++ui;
        if constexpr (Sched::ROWSKIP) { const int v = S.valid(cur); act0 = wr * 64 < v && cur.half != 1; act1 = HALF + wr * 64 < v && cur.half != 0; }
        if constexpr (Sched::GATHER) {
#pragma unroll
            for (int h = 0; h < 2; ++h)
#pragma unroll
                for (int i = 0; i < 2; ++i) offC[h][i] = offN[h][i];
        }
        if constexpr (ALIGN_EPI) { if (wr == 1) PG8_BAR; }
    }
    PG8_WAIT_V(0);
    if constexpr (!ALIGN_EPI) { if (wr == 0) PG8_BAR; }
    PG8_BAR;
    if constexpr (Epi::AFTER_DRAIN) { E.fused(acc, cur, wr, wc, fr, fq, lds, wid, lane); }
#undef PG8_SA
#undef PG8_SB
#undef PG8_STAGEA
#undef PG8_STAGEB
#undef PG8_LDA
#undef PG8_LDB
#undef PG8_MMA
#undef PG8_WAIT_V
#undef PG8_WAIT_L
#undef PG8_BAR
#undef PG8_SCHED
}
}

constexpr int NWAVES = 8;
constexpr int NB = 8, SEQ = 2048, D = 2048, M = NB * SEQ;
constexpr int DS = 1024, NG = 64, GC = 16, NST = 64;
constexpr int LCH = 32, NCH = SEQ / LCH;
constexpr int KP = LCH * GC + 2 * NST;
constexpr int NH = 16, HD = 128;
constexpr int NE = 64, DE = 512, NEG = 8, EPG = 8;
constexpr int FOXN = 4 * D + NH;
constexpr float RMS_EPS = 1e-6f;
constexpr int RT_ROWS = 96;
constexpr int MAXMT = 192;

constexpr size_t MiB = 1u << 20;
constexpr size_t WS_CTL = 0, CTL_ZERO_BYTES = 1 * MiB;
constexpr size_t WS_WS5IN  = 1 * MiB;
constexpr size_t WS_WGLU   = WS_WS5IN + 4 * MiB;
constexpr size_t WS_WS5OUT = WS_WGLU + 2 * MiB;
constexpr size_t WS_WFOXIN = WS_WS5OUT + 4 * MiB;
constexpr size_t WS_WFOXOUT = WS_WFOXIN + 32 * MiB;
constexpr size_t WS_WR     = WS_WFOXOUT + 8 * MiB;
constexpr size_t WS_WF     = WS_WR + 1 * MiB;
constexpr size_t WS_AL     = WS_WF + 512 * 1024;
constexpr size_t WS_LF     = WS_AL + 512 * 1024;
constexpr size_t WS_CUMB   = WS_LF + 1 * MiB;
constexpr size_t WS_PW     = WS_CUMB + 1 * MiB;
constexpr size_t WS_TOKL   = WS_PW + 1 * MiB;
constexpr size_t WS_SS     = 60 * MiB;
constexpr size_t WS_RSTD   = 62 * MiB;
constexpr size_t WS_WGU    = 64 * MiB;
constexpr size_t WS_WDN    = WS_WGU + 512 * MiB;
constexpr size_t WS_HN     = WS_WDN + 256 * MiB;
constexpr size_t WS_H2     = WS_HN + 64 * MiB;
constexpr size_t WS_Q      = WS_H2 + 128 * MiB;
constexpr size_t WS_K      = WS_Q + 64 * MiB, WS_V = WS_K + 64 * MiB, WS_SG = WS_V + 64 * MiB;
constexpr size_t WS_R1     = WS_SG + 64 * MiB;
constexpr size_t WS_TT     = WS_R1;
constexpr size_t WS_PT     = WS_TT + 40 * MiB;
constexpr size_t WS_UA     = WS_PT + 16 * MiB;
constexpr size_t WS_GL     = WS_UA + 40 * MiB;
constexpr size_t WS_OG     = WS_GL + 32 * MiB;
constexpr size_t WS_YP     = WS_R1;
constexpr size_t WS_HID    = WS_YP + 128 * MiB;
constexpr size_t WS_TOKW   = WS_R1 + 176 * MiB;
constexpr size_t WS_TOKR   = WS_TOKW + 4 * MiB;
constexpr size_t WS_END    = WS_TOKR + 4 * MiB;
static_assert(WS_TOKL + 4 * MiB <= WS_WGU && WS_OG + 32 * MiB <= WS_END && WS_HID + 48 * MiB <= WS_END, "d_ws map");
constexpr int CW_TMO = 0, CW_CODE = 1, CW_NPRE = 8;
constexpr int CW_BAR = 4096;
constexpr int CW_CNT = 16384;

constexpr int RING_OFF = 0, RING_BYTES = 131072;
constexpr int LDSCTL_OFF = 151552, MISC_OFF = LDSCTL_OFF + 320;
constexpr int MOE_OFF = LDSCTL_OFF + 512;
constexpr int LDS_BYTES = 155648;
static_assert(MOE_OFF + (64 * 3 + 4 + 2 * MAXMT) * 4 <= LDS_BYTES, "LDS map");

#define GAS __attribute__((address_space(1)))
#define LAS __attribute__((address_space(3)))
typedef unsigned short bf16;
typedef unsigned v4u __attribute__((ext_vector_type(4)));
typedef unsigned v2u __attribute__((ext_vector_type(2)));
typedef float f32x4 __attribute__((ext_vector_type(4)));
typedef float f32x16 __attribute__((ext_vector_type(16)));
typedef short bf16x8 __attribute__((ext_vector_type(8)));
typedef GAS unsigned gu32;
#define RLX_AGENT __ATOMIC_RELAXED, __HIP_MEMORY_SCOPE_AGENT
#define LDS_WAIT() asm volatile("s_waitcnt lgkmcnt(0)" ::: "memory")
#define VM_WAIT() asm volatile("s_waitcnt vmcnt(0)" ::: "memory")
__device__ __forceinline__ unsigned f2bf(float f) { unsigned u = __builtin_bit_cast(unsigned, f); return (u + 0x7fffu + ((u >> 16) & 1u)) >> 16; }
__device__ __forceinline__ unsigned pk2(float lo, float hi) { return f2bf(lo) | (f2bf(hi) << 16); }

#define XB_TMO      128
#define XB_XCNT(j)  (256  + 64 * (j))
#define XB_XSUB(j)  (1280 + 64 * (j))
#define XB_XGEN(j)  (2304 + 64 * (j))
#define XB_TOP      3328
#define XB_TOPGEN   3392
#define XCD_BAR_WORDS 3456
#define XB_SPIN_CAP (1u << 18)

__device__ __forceinline__ unsigned xb_ld(unsigned* p)              { return __hip_atomic_load(p, __ATOMIC_RELAXED, __HIP_MEMORY_SCOPE_AGENT); }
__device__ __forceinline__ unsigned xb_add(unsigned* p, unsigned v) { return __hip_atomic_fetch_add(p, v, __ATOMIC_RELAXED, __HIP_MEMORY_SCOPE_AGENT); }
__device__ __forceinline__ unsigned xb_xcc_id() { return (unsigned)__builtin_amdgcn_s_getreg((3 << 11) | 20) & 0xFu; }
#define XB_SPIN(cond, bar) do { unsigned _sp = 0; while (cond) { __builtin_amdgcn_s_sleep(1); \
    if ((++_sp & 255u) == 0u) { if (xb_ld(&(bar)[XB_TMO])) break; if (_sp > XB_SPIN_CAP) { atomicAdd(&(bar)[XB_TMO], 1u); break; } } } } while (0)

struct XcdBarrier {
    unsigned* bar; unsigned x;
    volatile LAS unsigned* st;
};
__device__ __forceinline__ XcdBarrier xcd_barrier_post(unsigned* bar, volatile LAS unsigned* st) {
    XcdBarrier b; b.bar = bar; b.x = xb_xcc_id(); b.st = st;
    if (threadIdx.x == 0) (void)xb_add(&bar[XB_XCNT(b.x)], 1u);
    return b;
}
__device__ __forceinline__ void xcd_barrier_complete(unsigned* bar, unsigned x, unsigned& nloc, unsigned& nx) {
    const unsigned G = gridDim.x * gridDim.y * gridDim.z;
    unsigned sum, cnt, mine, sp = 0u;
    for (;;) {
        sum = 0u; cnt = 0u; mine = 0u;
#pragma unroll
        for (unsigned j = 0; j < 16; ++j) { const unsigned c = xb_ld(&bar[XB_XCNT(j)]); sum += c; cnt += (c > 0u) ? 1u : 0u; mine = (j == x) ? c : mine; }
        if (sum == G) break;
        __builtin_amdgcn_s_sleep(1);
        if ((++sp & 255u) == 0u) { if (xb_ld(&bar[XB_TMO])) break; if (sp > XB_SPIN_CAP) { atomicAdd(&bar[XB_TMO], 1u); break; } }
    }
    nloc = mine > 0u ? mine : 1u; nx = cnt > 0u ? cnt : 1u;
}
__device__ __forceinline__ void xcd_barrier(const XcdBarrier& b, const int tid) {
    asm volatile("s_waitcnt vmcnt(0)" ::: "memory");
    __syncthreads();
    if (tid == 0) {
        unsigned* bar = b.bar;
        const unsigned bx = xb_xcc_id();
        __builtin_amdgcn_s_waitcnt(0);
        unsigned nloc = b.st[0], nx = b.st[1];
        if (nloc == 0u) { xcd_barrier_complete(bar, bx, nloc, nx); b.st[0] = nloc; b.st[1] = nx; }
        const unsigned old = xb_add(&bar[XB_XSUB(bx)], 1u);
        const unsigned gen = old / nloc;
        if (old + 1u == (gen + 1u) * nloc) {
            __builtin_amdgcn_fence(__ATOMIC_RELEASE, "agent");
            asm volatile("s_waitcnt vmcnt(0)" ::: "memory");
            const unsigned og = xb_add(&bar[XB_TOP], 1u);
            const unsigned tg = og / nx;
            if (og + 1u == (tg + 1u) * nx) { xb_add(&bar[XB_TOPGEN], 1u); xb_add(&bar[XB_XGEN(bx)], 1u); __builtin_amdgcn_fence(__ATOMIC_ACQUIRE, "agent"); }
            else { __builtin_amdgcn_fence(__ATOMIC_ACQUIRE, "agent"); XB_SPIN(xb_ld(&bar[XB_TOPGEN]) == tg, bar); xb_add(&bar[XB_XGEN(bx)], 1u); }
            asm volatile("s_waitcnt vmcnt(0)" ::: "memory");
        } else {
            __builtin_amdgcn_fence(__ATOMIC_ACQUIRE, "agent");
            XB_SPIN(xb_ld(&bar[XB_XGEN(bx)]) == gen, bar);
            asm volatile("s_waitcnt vmcnt(0)" ::: "memory");
        }
    }
    __syncthreads();
}

struct Frame {
    LAS unsigned char* lds;
    volatile LAS unsigned* MISC;
    gu32* ctl;
    int tid, lane, wave;
    int vcu, G;
    unsigned char* ws;
};
__device__ __forceinline__ float wave_sum(float v) {
#pragma unroll
    for (int o = 1; o < 64; o <<= 1) v += __shfl_xor(v, o);
    return v;
}
__device__ __forceinline__ float sigmoidf_(float x) { return __builtin_amdgcn_rcpf(1.f + __builtin_amdgcn_exp2f(-1.4426950408889634f * x)); }
__device__ __forceinline__ float gelu_tanh_(float x) {
    const float u = x * (1.f + 0.044715f * x * x);
    return x * __builtin_amdgcn_rcpf(1.f + __builtin_amdgcn_exp2f(-2.302208198f * u));
}

struct Args { const float* in[35]; float* out; unsigned char* ws; int ph_lo, ph_hi; };

__device__ __forceinline__ void p0_transpose_item(const float* W, int K, int N, int k0, int n0, bf16* dst0, LAS float* scr, int lane) {
    const int cn = n0 + (lane & 31); const bool ok = cn < N;
    float ld[32];
    const GAS float* Wp = (const GAS float*)W + (size_t)(k0 + (lane >> 5)) * N + cn;
#pragma unroll
    for (int i = 0; i < 32; ++i) ld[i] = ok ? Wp[(size_t)(2 * i) * N] : 0.f;
#pragma unroll
    for (int i = 0; i < 32; ++i) scr[(2 * i + (lane >> 5)) * 33 + (lane & 31)] = ld[i];
    LDS_WAIT(); asm volatile("" ::: "memory");
    const int c = lane & 7;
#pragma unroll
    for (int j = 0; j < 4; ++j) { const int n = (lane >> 3) + 8 * j; const LAS float* s = scr + (8 * c) * 33 + n;
        v4u o; o.x = pk2(s[0 * 33], s[1 * 33]); o.y = pk2(s[2 * 33], s[3 * 33]); o.z = pk2(s[4 * 33], s[5 * 33]); o.w = pk2(s[6 * 33], s[7 * 33]);
        *(GAS v4u*)(dst0 + (size_t)n * K + k0 + 8 * c) = o; }
    LDS_WAIT(); asm volatile("" ::: "memory");
}
__device__ __forceinline__ void p0_router_item(const float* wg, const float* we, const float* gain, bf16* WR, int kb, int ng, int lane) {
    const int k = kb * 64 + lane; const float g = gain[k];
    const GAS f32x4* src = ng == 0 ? (const GAS f32x4*)(wg + (size_t)k * 8) : (const GAS f32x4*)(we + (size_t)k * 64 + (ng - 1) * 8);
    const f32x4 v0 = src[0], v1 = src[1];
    GAS bf16* dst = (GAS bf16*)WR + (size_t)(ng == 0 ? 0 : 8 + (ng - 1) * 8) * D + k;
    dst[0 * D] = (bf16)f2bf(g * v0.x); dst[1 * D] = (bf16)f2bf(g * v0.y); dst[2 * D] = (bf16)f2bf(g * v0.z); dst[3 * D] = (bf16)f2bf(g * v0.w);
    dst[4 * D] = (bf16)f2bf(g * v1.x); dst[5 * D] = (bf16)f2bf(g * v1.y); dst[6 * D] = (bf16)f2bf(g * v1.z); dst[7 * D] = (bf16)f2bf(g * v1.w);
    if (ng == 8) for (int n = 72; n < RT_ROWS; ++n) WR[(size_t)n * D + k] = (bf16)0;
}
struct S5P { const float *lre, *lim, *bre, *bim, *cre, *cim, *lstep; };
__device__ __forceinline__ void s5_cis(double th, float& c, float& s, float& sh) {
    const double k = __builtin_rint(th * 0.15915494309189535);
    const float r = (float)__builtin_fma(-k, 6.283185307179586, th);
    c = cosf(r); s = sinf(r); sh = sinf(0.5f * r);
}
__device__ __forceinline__ void s5_pow(const S5P& P, int g, int n, int m, float& pr, float& pi) {
    const float lr = P.lre[g * 64 + n], li = P.lim[g * 64 + n], step = expf(P.lstep[g]);
    float c, s, sh; s5_cis((double)m * ((double)li * (double)step), c, s, sh);
    const float mag = expf((float)m * (lr * step));
    pr = mag * c; pi = mag * s;
}
__device__ __forceinline__ void s5_zoh(const S5P& P, int g, int n, float& fr, float& fi) {
    const float lr = P.lre[g * 64 + n], li = P.lim[g * 64 + n], step = expf(P.lstep[g]);
    float c, s, sh; s5_cis((double)li * (double)step, c, s, sh);
    const float em1 = expm1f(lr * step), mag = em1 + 1.f;
    const float nr = em1 * c - 2.f * sh * sh, ni = mag * s;
    const float den = lr * lr + li * li;
    fr = (nr * lr + ni * li) / den; fi = (ni * lr - nr * li) / den;
}
__device__ __forceinline__ void s5_item_kernel(const S5P& P, bf16* TT, int g, int m, int lane) {
    float pr, pi, fr, fi; s5_pow(P, g, lane, m, pr, pi); s5_zoh(P, g, lane, fr, fi);
    const int co = lane >> 2, ci0 = (lane & 3) * 4;
    const float wr = pr * fr - pi * fi, wi = pr * fi + pi * fr;
    float a0 = 0.f, a1 = 0.f, a2 = 0.f, a3 = 0.f;
    const GAS float* crp = (const GAS float*)P.cre + (size_t)(g * 16 + co) * 64; const GAS float* cmp_ = (const GAS float*)P.cim + (size_t)(g * 16 + co) * 64;
    const GAS f32x4* brp = (const GAS f32x4*)(P.bre + (size_t)(g * 64) * 16 + ci0); const GAS f32x4* bip = (const GAS f32x4*)(P.bim + (size_t)(g * 64) * 16 + ci0);
#pragma unroll 8
    for (int n = 0; n < 64; ++n) {
        const float wrn = __shfl(wr, n), win = __shfl(wi, n);
        const f32x4 br = brp[4 * n], bi = bip[4 * n];
        const float cr = crp[n], cm = cmp_[n];
        const float dr = cr * wrn - cm * win, di = cr * win + cm * wrn;
        a0 += dr * br.x - di * bi.x;
        a1 += dr * br.y - di * bi.y;
        a2 += dr * br.z - di * bi.z;
        a3 += dr * br.w - di * bi.w;
    }
    v2u w; w.x = pk2(a0, a1); w.y = pk2(a2, a3); const v2u z = {0u, 0u};
    bf16* Tg = TT + (size_t)g * 512 * KP;
    for (int j = 0; j + m < LCH; ++j) {
        *(GAS v2u*)(Tg + (size_t)((j + m) * 16 + co) * KP + j * 16 + ci0) = w;
        if (m >= 1) *(GAS v2u*)(Tg + (size_t)(j * 16 + co) * KP + (j + m) * 16 + ci0) = z;
    }
}
__device__ __forceinline__ void s5_item_state(const S5P& P, bf16* TT, int g, int i, int lane) {
    float pr, pi; s5_pow(P, g, lane, i + 1, pr, pi);
    bf16* Tg = TT + (size_t)g * 512 * KP;
#pragma unroll
    for (int co = 0; co < 16; ++co) {
        const float cr = P.cre[(size_t)(g * 16 + co) * 64 + lane], cm = P.cim[(size_t)(g * 16 + co) * 64 + lane];
        const float car = cr * pr - cm * pi, cai = cr * pi + cm * pr;
        *(GAS unsigned*)(Tg + (size_t)(i * 16 + co) * KP + 512 + 2 * lane) = pk2(car, -cai);
    }
}
__device__ __forceinline__ void s5_item_p(const S5P& P, bf16* PT, float* AL, int g, int j, int lane) {
    const int n = lane;
    float qr, qi, fr, fi; s5_pow(P, g, n, LCH - 1 - j, qr, qi); s5_zoh(P, g, n, fr, fi);
    bf16* Pg = PT + (size_t)g * 256 * 512;
#pragma unroll
    for (int h = 0; h < 2; ++h) {
        float re[8], im[8];
#pragma unroll
        for (int q = 0; q < 2; ++q) { const f32x4 br = *(const f32x4*)(P.bre + (size_t)(g * 64 + n) * 16 + h * 8 + q * 4), bi = *(const f32x4*)(P.bim + (size_t)(g * 64 + n) * 16 + h * 8 + q * 4);
#pragma unroll
            for (int e = 0; e < 4; ++e) { const float bbr = fr * br[e] - fi * bi[e], bbi = fr * bi[e] + fi * br[e]; re[q * 4 + e] = qr * bbr - qi * bbi; im[q * 4 + e] = qr * bbi + qi * bbr; } }
        v4u wr_, wi_; wr_.x = pk2(re[0], re[1]); wr_.y = pk2(re[2], re[3]); wr_.z = pk2(re[4], re[5]); wr_.w = pk2(re[6], re[7]);
        wi_.x = pk2(im[0], im[1]); wi_.y = pk2(im[2], im[3]); wi_.z = pk2(im[4], im[5]); wi_.w = pk2(im[6], im[7]);
        const v4u z = {0u, 0u, 0u, 0u};
        *(GAS v4u*)(Pg + (size_t)(2 * n) * 512 + j * 16 + h * 8) = wr_;
        *(GAS v4u*)(Pg + (size_t)(2 * n + 1) * 512 + j * 16 + h * 8) = wi_;
        *(GAS v4u*)(Pg + (size_t)(128 + 2 * n) * 512 + j * 16 + h * 8) = z;
        *(GAS v4u*)(Pg + (size_t)(129 + 2 * n) * 512 + j * 16 + h * 8) = z;
    }
    if (j == 0) { float ar, ai; s5_pow(P, g, n, LCH, ar, ai); AL[(g * 64 + n) * 2] = ar; AL[(g * 64 + n) * 2 + 1] = ai; }
}
__device__ __forceinline__ void rms_row_to_bf16(const float* xrow, const float* gain, bf16* orow, int lane) {
    const GAS f32x4* xr = (const GAS f32x4*)xrow + lane; const GAS f32x4* gr = (const GAS f32x4*)gain + lane;
    f32x4 v[8]; float s = 0.f;
#pragma unroll
    for (int j = 0; j < 8; ++j) { v[j] = xr[64 * j]; s += (v[j].x * v[j].x + v[j].y * v[j].y) + (v[j].z * v[j].z + v[j].w * v[j].w); }
    const float rstd = 1.f / sqrtf(wave_sum(s) * (1.f / D) + RMS_EPS);
    GAS v2u* o8 = (GAS v2u*)orow + lane;
#pragma unroll
    for (int j = 0; j < 8; ++j) { const f32x4 g = gr[64 * j]; v2u w; w.x = pk2(v[j].x * rstd * g.x, v[j].y * rstd * g.y); w.y = pk2(v[j].z * rstd * g.z, v[j].w * rstd * g.w); o8[64 * j] = w; }
}

__device__ __forceinline__ void p0_prologue(Frame& F, const Args& a, unsigned char* ws) {
    LAS float* scr = (LAS float*)(F.lds + RING_OFF + F.wave * 16384);
    const int gw = F.vcu * NWAVES + F.wave, NGW = F.G * NWAVES;
    const S5P P{a.in[3], a.in[4], a.in[5], a.in[6], a.in[7], a.in[8], a.in[10]};
    bf16* TT = (bf16*)(ws + WS_TT); bf16* PT = (bf16*)(ws + WS_PT); float* AL = (float*)(ws + WS_AL);
    for (int it = gw; it < 3 * NG * LCH; it += NGW) {
        const int kind = it / (NG * LCH), r = it % (NG * LCH), g = r / LCH, m = r % LCH;
        if (kind == 0) s5_item_kernel(P, TT, g, m, F.lane);
        else if (kind == 1) s5_item_state(P, TT, g, m, F.lane);
        else s5_item_p(P, PT, AL, g, m, F.lane);
    }
    for (int it = gw; it < 2 * 32 * 9; it += NGW) { const int l = it / 288, r = it % 288, kb = r / 9, ng = r % 9;
        p0_router_item(a.in[l ? 27 : 15], a.in[l ? 29 : 17], a.in[l ? 26 : 14], (bf16*)(ws + WS_WR) + (size_t)l * (256 * 1024), kb, ng, F.lane); }
    constexpr int I_S5IN = 32 * 32, I_GLU = 16 * 32, I_S5OUT = 16 * 64, I_FOXIN = 32 * 257, I_FOXOUT = 32 * 64;
    constexpr int NITEMS = I_S5IN + I_GLU + I_S5OUT;
    for (int it = gw; it < NITEMS; it += NGW) {
        int r = it;
        if (r < I_S5IN) { const int kb = r / 32, nb = r % 32; p0_transpose_item(a.in[2], D, DS, kb * 64, nb * 32, (bf16*)(ws + WS_WS5IN) + (size_t)(nb * 32) * D, scr, F.lane); continue; } r -= I_S5IN;
        if (r < I_GLU) { const int kb = r / 32, nb = r % 32; p0_transpose_item(a.in[11], DS, DS, kb * 64, nb * 32, (bf16*)(ws + WS_WGLU) + (size_t)(nb * 32) * DS, scr, F.lane); continue; } r -= I_GLU;
        { const int kb = r / 64, nb = r % 64; p0_transpose_item(a.in[13], DS, D, kb * 64, nb * 32, (bf16*)(ws + WS_WS5OUT) + (size_t)(nb * 32) * DS, scr, F.lane); }
    }
    for (int m = gw; m < M; m += NGW) rms_row_to_bf16(a.in[0] + (size_t)m * D, a.in[1], (bf16*)(ws + WS_HN) + (size_t)m * D, F.lane);
}

struct ConvItem { const GAS float* Wp; bf16* dst0; const float* gain; int N, K, k0; bool ok, hasg; };
__device__ __forceinline__ ConvItem moe_conv_item(const Args& a, unsigned char* ws, const int l, int r, const int lane) {
    constexpr int I_EXP = 512;
    ConvItem it; it.gain = a.in[l ? 26 : 14];
    const int kind = r / (64 * I_EXP); it.hasg = kind < 2; r -= kind * (64 * I_EXP);
    const int e = r / I_EXP; r -= e * I_EXP;
    if (kind < 2) {
        const int kb = r / 16, nb = r % 16, n0 = nb * 32;
        it.N = DE; it.K = D; it.k0 = kb * 64;
        it.Wp = (const GAS float*)(a.in[(l ? 31 : 19) + kind] + (size_t)e * D * DE) + (size_t)(it.k0 + (lane >> 3)) * DE + n0 + 4 * (lane & 7);
        it.dst0 = (bf16*)(ws + WS_WGU) + ((size_t)l * NE * 1024 + (size_t)e * 1024 + (n0 >> 7) * 256 + kind * 128 + (n0 & 127)) * D;
    } else {
        const int kb = r / 64, nb = r % 64, n0 = nb * 32;
        it.N = D; it.K = DE; it.k0 = kb * 64;
        it.Wp = (const GAS float*)(a.in[l ? 33 : 21] + (size_t)e * DE * D) + (size_t)(it.k0 + (lane >> 3)) * D + n0 + 4 * (lane & 7);
        it.dst0 = (bf16*)(ws + WS_WDN) + ((size_t)l * NE * D + (size_t)e * D + n0) * DE;
    }
    it.ok = true; return it;
}
__device__ __forceinline__ ConvItem fox_conv_item(const Args& a, unsigned char* ws, int r, const int lane) {
    constexpr int I_FOXIN = 32 * 257;
    ConvItem it; it.K = D; it.gain = a.in[14]; it.hasg = false;
    if (r < I_FOXIN) { const int kb = r / 257, nb = r % 257, n0 = nb * 32, cn = n0 + 4 * (lane & 7);
        it.N = FOXN; it.k0 = kb * 64; it.ok = cn < FOXN;
        it.Wp = (const GAS float*)a.in[23] + (size_t)(it.k0 + (lane >> 3)) * FOXN + (it.ok ? cn : 0);
        it.dst0 = nb < 256 ? (bf16*)(ws + WS_WFOXIN) + (size_t)n0 * D : (bf16*)(ws + WS_WF);
    } else { r -= I_FOXIN; const int kb = r / 64, nb = r % 64, n0 = nb * 32;
        it.N = D; it.k0 = kb * 64; it.ok = true;
        it.Wp = (const GAS float*)a.in[25] + (size_t)(it.k0 + (lane >> 3)) * D + n0 + 4 * (lane & 7);
        it.dst0 = (bf16*)(ws + WS_WFOXOUT) + (size_t)n0 * D; }
    return it;
}
template <int KIND>
__device__ __forceinline__ void conv_range(Frame& F, const Args& a, unsigned char* ws, const int r0, const int r_end, const int worker, const int stride) {
    LAS unsigned char* scrb = F.lds + RING_OFF + F.wave * 16384;
    const int lane = F.lane;
    int r = r0 + worker;
    if (r >= r_end) return;
    const int wk = lane >> 3, l7 = lane & 7, wn = 4 * l7, c = l7;
    __builtin_amdgcn_s_waitcnt(0x0F70);
    if constexpr (KIND < 2) {
        const GAS f32x4* gsrc = (const GAS f32x4*)a.in[KIND ? 26 : 14];
#pragma unroll
        for (int i = 0; i < 8; ++i) *(LAS f32x4*)(scrb + 8192 + (i * 64 + lane) * 16) = gsrc[i * 64 + lane];
        LDS_WAIT(); asm volatile("" ::: "memory");
    }
    ConvItem dummy; dummy.Wp = (const GAS float*)a.in[14] + wn; dummy.dst0 = nullptr; dummy.gain = a.in[14]; dummy.N = 0; dummy.K = 0; dummy.k0 = 0; dummy.ok = true; dummy.hasg = false;
#define CONV_ITEM(r) ((r) < r_end ? (KIND < 2 ? moe_conv_item(a, ws, KIND, (r), lane) : fox_conv_item(a, ws, (r), lane)) : dummy)
#define CONV_LOAD(dst, it) { _Pragma("unroll") for (int i = 0; i < 8; ++i) dst[i] = __builtin_nontemporal_load((const GAS f32x4*)(it.Wp + (size_t)(8 * i) * it.N)); }
    const unsigned wq = (unsigned)(l7 ^ wk), wb = (unsigned)wk * 128u;
    unsigned X[8];
#pragma unroll
    for (int m = 0; m < 8; ++m) X[m] = (unsigned)c * 1024u + (unsigned)(wk & 3) * 4u + ((((unsigned)(wk >> 2) ^ (unsigned)c ^ (unsigned)m)) << 4);
#define CONV_PROC(ld, cur) { \
        _Pragma("unroll") for (int i = 0; i < 8; ++i) { const f32x4 v = cur.ok ? ld[i] : f32x4{0.f, 0.f, 0.f, 0.f}; *(LAS f32x4*)(scrb + wb + i * 1024 + ((wq ^ (unsigned)i) << 4)) = v; } \
        LDS_WAIT(); asm volatile("" ::: "memory"); \
        f32x4 g0 = {1.f, 1.f, 1.f, 1.f}, g1 = g0; \
        if constexpr (KIND < 2) { const f32x4 q0 = *(const LAS f32x4*)(scrb + 8192 + (cur.k0 + 8 * c) * 4), q1 = *(const LAS f32x4*)(scrb + 8192 + (cur.k0 + 8 * c) * 4 + 16); g0 = cur.hasg ? q0 : g0; g1 = cur.hasg ? q1 : g1; } \
        _Pragma("unroll") for (int jj = 0; jj < 4; ++jj) { const int n = (lane >> 3) + 8 * jj; float sp[8]; \
            _Pragma("unroll") for (int t = 0; t < 8; ++t) sp[t] = *(const LAS float*)(scrb + X[t ^ (2 * jj)] + t * 128); \
            v4u o; o.x = pk2(sp[0] * g0.x, sp[1] * g0.y); o.y = pk2(sp[2] * g0.z, sp[3] * g0.w); o.z = pk2(sp[4] * g1.x, sp[5] * g1.y); o.w = pk2(sp[6] * g1.z, sp[7] * g1.w); \
            __builtin_nontemporal_store(o, (GAS v4u*)(cur.dst0 + (size_t)n * cur.K + cur.k0 + 8 * c)); } \
        LDS_WAIT(); asm volatile("" ::: "memory"); }
    ConvItem iA = CONV_ITEM(r), iB = CONV_ITEM(r + stride), iC = CONV_ITEM(r + 2 * stride), iD = CONV_ITEM(r + 3 * stride), iE;
    f32x4 A[8], B[8], C[8], Dd[8], Ee[8];
    CONV_LOAD(A, iA)
    __builtin_amdgcn_sched_barrier(0);
    CONV_LOAD(B, iB)
    __builtin_amdgcn_sched_barrier(0);
    CONV_LOAD(C, iC)
    __builtin_amdgcn_sched_barrier(0);
    CONV_LOAD(Dd, iD)
    __builtin_amdgcn_sched_barrier(0);
    for (; r < r_end; r += 5 * stride) {
        iE = CONV_ITEM(r + 4 * stride); CONV_LOAD(Ee, iE)
        CONV_PROC(A, iA)
        iA = CONV_ITEM(r + 5 * stride); CONV_LOAD(A, iA)
        if (r + stride < r_end) CONV_PROC(B, iB)
        iB = CONV_ITEM(r + 6 * stride); CONV_LOAD(B, iB)
        if (r + 2 * stride < r_end) CONV_PROC(C, iC)
        iC = CONV_ITEM(r + 7 * stride); CONV_LOAD(C, iC)
        if (r + 3 * stride < r_end) CONV_PROC(Dd, iD)
        iD = CONV_ITEM(r + 8 * stride); CONV_LOAD(Dd, iD)
        if (r + 4 * stride < r_end) CONV_PROC(Ee, iE)
    }
#undef CONV_PROC
#undef CONV_LOAD
#undef CONV_ITEM
}
constexpr int CONV_TOTAL_MOE = 3 * 64 * 512, CONV_TOTAL_FOX = 32 * 257 + 32 * 64;
template <int KIND>
__device__ __forceinline__ void conv_run(Frame& F, const Args& a, unsigned char* ws, const int slot, const int nslots) {
    const int gw = F.vcu * NWAVES + F.wave, NGW = F.G * NWAVES;
    constexpr int TOTAL = KIND < 2 ? CONV_TOTAL_MOE : CONV_TOTAL_FOX;
    const int nj = (TOTAL + NGW - 1) / NGW, j0 = (nj * slot) / nslots, j1 = (nj * (slot + 1)) / nslots;
    const int re = j1 * NGW < TOTAL ? j1 * NGW : TOTAL;
    conv_range<KIND>(F, a, ws, j0 * NGW, re, gw, NGW);
}
__device__ __forceinline__ void moe_conv(Frame& F, const Args& a, unsigned char* ws, const int l, const int slot, const int nslots) {
    if (l == 0) conv_run<0>(F, a, ws, slot, nslots); else conv_run<1>(F, a, ws, slot, nslots);
}

using pg8::Unit; using pg8::UPtr; using pg8::TileOrder; using pg8::cvt_pk_bf16; using pg8::bf_lo; using pg8::bf_hi;
typedef pg8::f32x4 (AccT)[2][2][4][2];

struct SchedDense {
    static constexpr bool GATHER = false, ROWSKIP = false;
    TileOrder T; const char* A; const char* B; size_t astep, bstep;
    int i_begin, i_end;
    __device__ __forceinline__ void init(const void* A_, int lda, const void* B_, int ldb, int nM, int nN, int G, int c) { T.init(nM, nN, G, c); A = (const char*)A_; B = (const char*)B_; astep = (size_t)256 * lda * 2; bstep = (size_t)256 * ldb * 2; i_begin = 0; i_end = 1 << 30; }
    __device__ __forceinline__ bool next(int i, Unit& u) const { return (i + i_begin < i_end) && T.next(i + i_begin, u); }
    __device__ __forceinline__ UPtr ptrs(const Unit& u) const { UPtr p; p.A = A + (size_t)u.pm * astep; p.B = B + (size_t)u.pn * bstep; return p; }
};
template <int NPN> struct SchedS5 {
    static constexpr bool GATHER = false, ROWSKIP = false;
    int G, c; const char* A; const char* B; size_t bgrp, btile;
    __device__ __forceinline__ void init(const void* A_, const void* B_, int brows_per_group, int ldb, int G_, int c_) { G = G_; c = c_; A = (const char*)A_; B = (const char*)B_; bgrp = (size_t)brows_per_group * ldb * 2; btile = (size_t)256 * ldb * 2; }
    __device__ __forceinline__ bool next(int i, Unit& u) const { const int L = i * G + c; if (L >= NG * 2 * NPN) return false; u.pm = L / NPN; u.pn = L % NPN; u.half = -1; return true; }
    __device__ __forceinline__ UPtr ptrs(const Unit& u) const { UPtr p; p.A = A + (size_t)u.pm * 256 * KP * 2; p.B = B + (size_t)(u.pm >> 1) * bgrp + (size_t)u.pn * btile; return p; }
};
struct MoeTab { const LAS int* cnt; const LAS int* mt_e; const LAS int* mt_row0; int T; };
struct SchedMoeGU {
    static constexpr bool GATHER = true, ROWSKIP = true;
    __device__ __forceinline__ int valid(const Unit& u) const { return tab.cnt[tab.mt_e[u.pm]] - tab.mt_row0[u.pm]; }
    TileOrder T; MoeTab tab; const char* HN; const char* W; const int* tokl; int tid;
    __device__ __forceinline__ bool next(int i, Unit& u) const { return T.next(i, u); }
    __device__ __forceinline__ UPtr ptrs(const Unit& u) const { UPtr p; p.A = HN; p.B = W + ((size_t)tab.mt_e[u.pm] * 1024 + (size_t)u.pn * 256) * D * 2; return p; }
    __device__ __forceinline__ void gather(const Unit& u, unsigned (&off)[2][2]) const {
        const int e = tab.mt_e[u.pm], row0 = tab.mt_row0[u.pm], cnt = tab.cnt[e];
        const GAS int* tl = (const GAS int*)tokl + (size_t)e * M;
        int pr[2][2];
#pragma unroll
        for (int i = 0; i < 2; ++i) { int R, C; pg8::stage_rc(tid * 16 + i * 8192, R, C);
#pragma unroll
            for (int h = 0; h < 2; ++h) { const int idx = row0 + h * 128 + R; pr[h][i] = tl[idx < cnt ? idx : cnt - 1]; } }
#pragma unroll
        for (int i = 0; i < 2; ++i) { int R, C; pg8::stage_rc(tid * 16 + i * 8192, R, C);
#pragma unroll
            for (int h = 0; h < 2; ++h) { const int idx = row0 + h * 128 + R; const int pair = idx < cnt ? pr[h][i] : 0;
                off[h][i] = (unsigned)(pair >> 1) * (unsigned)(D * 2) + (unsigned)C * 2u; } }
    }
};
struct SchedMoeDN {
    static constexpr bool GATHER = false, ROWSKIP = true;
    __device__ __forceinline__ int valid(const Unit& u) const { return tab.cnt[tab.mt_e[u.pm]] - tab.mt_row0[u.pm]; }
    TileOrder T; MoeTab tab; const char* HID; const char* W;
    __device__ __forceinline__ bool next(int i, Unit& u) const { return T.next(i, u); }
    __device__ __forceinline__ UPtr ptrs(const Unit& u) const { UPtr p; p.A = HID + (size_t)u.pm * 256 * DE * 2; p.B = W + ((size_t)tab.mt_e[u.pm] * D + (size_t)u.pn * 256) * DE * 2; return p; }
};

struct EpiU {
    static constexpr bool PERM = true, AFTER_DRAIN = false;
    bf16* UA;
    __device__ __forceinline__ void operator()(const AccT& acc, const Unit& u, int wr, int wc, int fr, int fq) const {
#pragma unroll
        for (int ai = 0; ai < 2; ++ai)
#pragma unroll
            for (int m = 0; m < 4; ++m) { const int t = u.pm * 256 + ai * 128 + wr * 64 + m * 16 + fr;
                const int b = t >> 11, s = t & 2047, ch = s >> 5, j = s & 31;
#pragma unroll
                for (int bj = 0; bj < 2; ++bj) { const int c0 = u.pn * 256 + bj * 128 + wc * 32 + 8 * fq, g = c0 >> 4, hf = (c0 >> 3) & 1;
                    const pg8::f32x4 v0 = acc[ai][bj][m][0], v1 = acc[ai][bj][m][1];
                    v4u w; w.x = cvt_pk_bf16(v0[0], v0[1]); w.y = cvt_pk_bf16(v0[2], v0[3]); w.z = cvt_pk_bf16(v1[0], v1[1]); w.w = cvt_pk_bf16(v1[2], v1[3]);
                    *(GAS v4u*)(UA + ((size_t)(g * 512 + b * 64 + ch) * KP + j * 16 + hf * 8)) = w; } }
    }
};
struct EpiScan {
    static constexpr bool PERM = false, AFTER_DRAIN = true;
    bf16* UA; const float* AL;
    __device__ __forceinline__ void fused(const AccT& acc, const Unit& u, int wr, int wc, int fr, int fq, LAS unsigned char* lds, int wid, int lane) const {
        LAS float* X = (LAS float*)lds;
#pragma unroll
        for (int ai = 0; ai < 2; ++ai)
#pragma unroll
            for (int m = 0; m < 4; ++m) { const int r = ai * 128 + wr * 64 + m * 16 + fr;
#pragma unroll
                for (int n = 0; n < 2; ++n) *(LAS pg8::f32x4*)(X + r * 128 + wc * 32 + n * 16 + 4 * fq) = acc[ai][0][m][n]; }
        LDS_WAIT(); __syncthreads();
        const int tid = wid * 64 + lane;
        if (tid < 256) { const int bl = tid >> 6, n = tid & 63, g = u.pm >> 1;
            const float ar = AL[(g * 64 + n) * 2], ai_ = AL[(g * 64 + n) * 2 + 1];
            float sr = 0.f, si = 0.f;
            bf16* dst = UA + (size_t)(u.pm * 256 + bl * 64) * KP + 512 + 2 * n;
            const LAS float* xs = X + (bl * 64) * 128 + 2 * n;
            for (int c = 0; c < 64; ++c) {
                *(GAS unsigned*)(dst + (size_t)c * KP) = pk2(sr, si);
                const float xr = xs[c * 128], xi = xs[c * 128 + 1];
                const float nr = ar * sr - ai_ * si + xr, ni = ar * si + ai_ * sr + xi; sr = nr; si = ni; }
        }
        __syncthreads();
    }
};
struct EpiY {
    static constexpr bool PERM = true, AFTER_DRAIN = false;
    const bf16* UA; const float* dsk; bf16* GL;
    __device__ __forceinline__ void operator()(const AccT& acc, const Unit& u, int wr, int wc, int fr, int fq) const {
        const int g = u.pm >> 1, n00 = u.pn * 256 + wc * 32 + 8 * fq;
        const GAS bf16* ug = (const GAS bf16*)UA + ((size_t)(g * 512 + (u.pm & 1) * 256 + wr * 64 + fr) * KP + n00);
        v4u uv[4][2]; f32x4 dd[2][2];
#define EY_LOAD(b) { const GAS bf16* p_ = ug + (size_t)(((b) >> 2) * 128 + ((b) & 3) * 16) * KP; uv[(b) & 3][0] = *(const GAS v4u*)p_; uv[(b) & 3][1] = *(const GAS v4u*)(p_ + 128); }
        EY_LOAD(0) EY_LOAD(1) EY_LOAD(2) EY_LOAD(3)
#pragma unroll
        for (int bj = 0; bj < 2; ++bj) { const int hf = ((n00 + bj * 128) >> 3) & 1; dd[bj][0] = *(const GAS f32x4*)(dsk + g * 16 + hf * 8); dd[bj][1] = *(const GAS f32x4*)(dsk + g * 16 + hf * 8 + 4); }
        __builtin_amdgcn_s_waitcnt(0x0F70);
#pragma unroll
        for (int b = 0; b < 8; ++b) { const int ai = b >> 2, m = b & 3;
            const int rl = ai * 128 + wr * 64 + m * 16 + fr, row = (u.pm & 1) * 256 + rl, bb = row >> 6, ch = row & 63;
#pragma unroll
            for (int bj = 0; bj < 2; ++bj) { const int n0 = n00 + bj * 128, i = n0 >> 4, hf = (n0 >> 3) & 1;
                const v4u uu = uv[m][bj]; const f32x4 d0 = dd[bj][0], d1 = dd[bj][1];
                const pg8::f32x4 v0 = acc[ai][bj][m][0], v1 = acc[ai][bj][m][1];
                float y[8];
                y[0] = v0[0] + d0.x * bf_lo(uu.x); y[1] = v0[1] + d0.y * bf_hi(uu.x); y[2] = v0[2] + d0.z * bf_lo(uu.y); y[3] = v0[3] + d0.w * bf_hi(uu.y);
                y[4] = v1[0] + d1.x * bf_lo(uu.z); y[5] = v1[1] + d1.y * bf_hi(uu.z); y[6] = v1[2] + d1.z * bf_lo(uu.w); y[7] = v1[3] + d1.w * bf_hi(uu.w);
#pragma unroll
                for (int e = 0; e < 8; ++e) y[e] = gelu_tanh_(y[e]);
                v4u w; w.x = cvt_pk_bf16(y[0], y[1]); w.y = cvt_pk_bf16(y[2], y[3]); w.z = cvt_pk_bf16(y[4], y[5]); w.w = cvt_pk_bf16(y[6], y[7]);
                const size_t tok = (size_t)bb * SEQ + ch * LCH + i;
                *(GAS v4u*)(GL + tok * DS + g * 16 + hf * 8) = w; }
            if (b + 4 < 8) EY_LOAD(b + 4) }
#undef EY_LOAD
    }
};
struct EpiGlu {
    static constexpr bool PERM = true, AFTER_DRAIN = false;
    const bf16* GL; const float* bias; bf16* OG;
    __device__ __forceinline__ void operator()(const AccT& acc, const Unit& u, int wr, int wc, int fr, int fq) const {
        const int c00 = u.pn * 256 + wc * 32 + 8 * fq;
        const GAS bf16* gp = (const GAS bf16*)GL + ((size_t)u.pm * 256 + wr * 64 + fr) * DS + c00;
        v4u gv[4][2]; f32x4 bb[2][2];
#define EG_LOAD(b) { const GAS bf16* p_ = gp + (size_t)(((b) >> 2) * 128 + ((b) & 3) * 16) * DS; gv[(b) & 3][0] = *(const GAS v4u*)p_; gv[(b) & 3][1] = *(const GAS v4u*)(p_ + 128); }
        EG_LOAD(0) EG_LOAD(1) EG_LOAD(2) EG_LOAD(3)
#pragma unroll
        for (int bj = 0; bj < 2; ++bj) { bb[bj][0] = *(const GAS f32x4*)(bias + c00 + bj * 128); bb[bj][1] = *(const GAS f32x4*)(bias + c00 + bj * 128 + 4); }
        __builtin_amdgcn_s_waitcnt(0x0F70);
#pragma unroll
        for (int b = 0; b < 8; ++b) { const int ai = b >> 2, m = b & 3; const size_t row = (size_t)u.pm * 256 + ai * 128 + wr * 64 + m * 16 + fr;
#pragma unroll
            for (int bj = 0; bj < 2; ++bj) { const int c0 = c00 + bj * 128; const v4u gg = gv[m][bj]; const f32x4 b0 = bb[bj][0], b1 = bb[bj][1];
                const pg8::f32x4 v0 = acc[ai][bj][m][0], v1 = acc[ai][bj][m][1];
                float o[8];
                o[0] = bf_lo(gg.x) * sigmoidf_(v0[0] + b0.x); o[1] = bf_hi(gg.x) * sigmoidf_(v0[1] + b0.y); o[2] = bf_lo(gg.y) * sigmoidf_(v0[2] + b0.z); o[3] = bf_hi(gg.y) * sigmoidf_(v0[3] + b0.w);
                o[4] = bf_lo(gg.z) * sigmoidf_(v1[0] + b1.x); o[5] = bf_hi(gg.z) * sigmoidf_(v1[1] + b1.y); o[6] = bf_lo(gg.w) * sigmoidf_(v1[2] + b1.z); o[7] = bf_hi(gg.w) * sigmoidf_(v1[3] + b1.w);
                v4u w; w.x = cvt_pk_bf16(o[0], o[1]); w.y = cvt_pk_bf16(o[2], o[3]); w.z = cvt_pk_bf16(o[4], o[5]); w.w = cvt_pk_bf16(o[6], o[7]);
                *(GAS v4u*)(OG + row * DS + c0) = w; }
            if (b + 4 < 8) EG_LOAD(b + 4) }
#undef EG_LOAD
    }
};
struct EpiRes {
    static constexpr bool PERM = false, AFTER_DRAIN = false;
    const float* base; float* out;
    __device__ __forceinline__ void operator()(const AccT& acc, const Unit& u, int wr, int wc, int fr, int fq) const {
#pragma unroll
        for (int ai = 0; ai < 2; ++ai)
#pragma unroll
            for (int m = 0; m < 4; ++m) { const size_t off = ((size_t)u.pm * 256 + ai * 128 + wr * 64 + m * 16 + fr) * D + u.pn * 256 + wc * 32 + 4 * fq;
#pragma unroll
                for (int bj = 0; bj < 2; ++bj)
#pragma unroll
                    for (int n = 0; n < 2; ++n) { const f32x4 bs = *(const GAS f32x4*)(base + off + bj * 128 + n * 16); const pg8::f32x4 a = acc[ai][bj][m][n];
                        f32x4 o; o.x = bs.x + a[0]; o.y = bs.y + a[1]; o.z = bs.z + a[2]; o.w = bs.w + a[3];
                        *(GAS f32x4*)(out + off + bj * 128 + n * 16) = o; }
                asm volatile("" ::: "memory"); }
    }
};
struct EpiResYP {
    static constexpr bool PERM = false, AFTER_DRAIN = false;
    float* out; const bf16* YP;
    __device__ __forceinline__ void operator()(const AccT& acc, const Unit& u, int wr, int wc, int fr, int fq) const {
#pragma unroll
        for (int ai = 0; ai < 2; ++ai)
#pragma unroll
            for (int m = 0; m < 4; ++m) { const size_t row = (size_t)u.pm * 256 + ai * 128 + wr * 64 + m * 16 + fr; const int col = u.pn * 256 + wc * 32 + 4 * fq;
#pragma unroll
                for (int bj = 0; bj < 2; ++bj)
#pragma unroll
                    for (int n = 0; n < 2; ++n) { const int c = col + bj * 128 + n * 16;
                        const f32x4 bs = *(const GAS f32x4*)(out + row * D + c); const v2u y0 = *(const GAS v2u*)(YP + (2 * row) * D + c), y1 = *(const GAS v2u*)(YP + (2 * row + 1) * D + c);
                        const pg8::f32x4 a = acc[ai][bj][m][n];
                        f32x4 o; o.x = bs.x + bf_lo(y0.x) + bf_lo(y1.x) + a[0]; o.y = bs.y + bf_hi(y0.x) + bf_hi(y1.x) + a[1]; o.z = bs.z + bf_lo(y0.y) + bf_lo(y1.y) + a[2]; o.w = bs.w + bf_hi(y0.y) + bf_hi(y1.y) + a[3];
                        *(GAS f32x4*)(out + row * D + c) = o; }
                asm volatile("" ::: "memory"); }
    }
};
__device__ __forceinline__ float sumsq8(const v4u w) { float s = 0.f; s += bf_lo(w.x) * bf_lo(w.x) + bf_hi(w.x) * bf_hi(w.x); s += bf_lo(w.y) * bf_lo(w.y) + bf_hi(w.y) * bf_hi(w.y);
    s += bf_lo(w.z) * bf_lo(w.z) + bf_hi(w.z) * bf_hi(w.z); s += bf_lo(w.w) * bf_lo(w.w) + bf_hi(w.w) * bf_hi(w.w); return s; }
struct EpiResB {
    static constexpr bool PERM = true, AFTER_DRAIN = false;
    const float* x; bf16* HB; float* SS;
    __device__ __forceinline__ void operator()(const AccT& acc, const Unit& u, int wr, int wc, int fr, int fq) const {
        const int c00 = u.pn * 256 + wc * 32 + 8 * fq;
        const GAS float* xg = (const GAS float*)x + ((size_t)u.pm * 256 + wr * 64 + fr) * D + c00;
        f32x4 xv[4][2][2];
#define RB_LOAD(b) { const GAS float* p_ = xg + (size_t)(((b) >> 2) * 128 + ((b) & 3) * 16) * D; _Pragma("unroll") for (int bj = 0; bj < 2; ++bj) { xv[(b) & 3][bj][0] = *(const GAS f32x4*)(p_ + bj * 128); xv[(b) & 3][bj][1] = *(const GAS f32x4*)(p_ + bj * 128 + 4); } }
        RB_LOAD(0) RB_LOAD(1) RB_LOAD(2) RB_LOAD(3)
        __builtin_amdgcn_s_waitcnt(0x0F70);
#pragma unroll
        for (int b = 0; b < 8; ++b) { const int ai = b >> 2, m = b & 3; const size_t row = (size_t)u.pm * 256 + ai * 128 + wr * 64 + m * 16 + fr; float ssq = 0.f;
#pragma unroll
            for (int bj = 0; bj < 2; ++bj) { const int c = c00 + bj * 128; const f32x4 x0 = xv[m][bj][0], x1 = xv[m][bj][1];
                const pg8::f32x4 v0 = acc[ai][bj][m][0], v1 = acc[ai][bj][m][1];
                v4u w; w.x = cvt_pk_bf16(x0.x + v0[0], x0.y + v0[1]); w.y = cvt_pk_bf16(x0.z + v0[2], x0.w + v0[3]); w.z = cvt_pk_bf16(x1.x + v1[0], x1.y + v1[1]); w.w = cvt_pk_bf16(x1.z + v1[2], x1.w + v1[3]);
                *(GAS v4u*)(HB + row * D + c) = w; ssq += sumsq8(w); }
            ssq += __shfl_xor(ssq, 16); ssq += __shfl_xor(ssq, 32);
            if (fq == 0) SS[row * 32 + u.pn * 4 + wc] = ssq;
            if (b + 4 < 8) RB_LOAD(b + 4) }
#undef RB_LOAD
    }
};
struct EpiResYPB {
    static constexpr bool PERM = true, AFTER_DRAIN = false;
    bf16* HB; const bf16* YP; float* SS;
    __device__ __forceinline__ void operator()(const AccT& acc, const Unit& u, int wr, int wc, int fr, int fq) const {
        const int c00 = u.pn * 256 + wc * 32 + 8 * fq;
        const size_t r00 = (size_t)u.pm * 256 + wr * 64 + fr;
        const GAS bf16* hg = (const GAS bf16*)HB + r00 * D + c00; const GAS bf16* yg = (const GAS bf16*)YP + (2 * r00) * D + c00;
        v4u hv[4][2], y0v[4][2], y1v[4][2];
#define RY_LOAD(b) { const size_t ro_ = (size_t)(((b) >> 2) * 128 + ((b) & 3) * 16); _Pragma("unroll") for (int bj = 0; bj < 2; ++bj) { \
            hv[(b) & 3][bj] = *(const GAS v4u*)(hg + ro_ * D + bj * 128); y0v[(b) & 3][bj] = *(const GAS v4u*)(yg + (2 * ro_) * D + bj * 128); y1v[(b) & 3][bj] = *(const GAS v4u*)(yg + (2 * ro_ + 1) * D + bj * 128); } }
        RY_LOAD(0) RY_LOAD(1) RY_LOAD(2) RY_LOAD(3)
        __builtin_amdgcn_s_waitcnt(0x0F70);
#pragma unroll
        for (int b = 0; b < 8; ++b) { const int ai = b >> 2, m = b & 3; const size_t row = (size_t)u.pm * 256 + ai * 128 + wr * 64 + m * 16 + fr; float ssq = 0.f;
#pragma unroll
            for (int bj = 0; bj < 2; ++bj) { const int c = c00 + bj * 128; const v4u hb = hv[m][bj], y0 = y0v[m][bj], y1 = y1v[m][bj];
                const pg8::f32x4 v0 = acc[ai][bj][m][0], v1 = acc[ai][bj][m][1];
                v4u w;
                w.x = cvt_pk_bf16(bf_lo(hb.x) + bf_lo(y0.x) + bf_lo(y1.x) + v0[0], bf_hi(hb.x) + bf_hi(y0.x) + bf_hi(y1.x) + v0[1]);
                w.y = cvt_pk_bf16(bf_lo(hb.y) + bf_lo(y0.y) + bf_lo(y1.y) + v0[2], bf_hi(hb.y) + bf_hi(y0.y) + bf_hi(y1.y) + v0[3]);
                w.z = cvt_pk_bf16(bf_lo(hb.z) + bf_lo(y0.z) + bf_lo(y1.z) + v1[0], bf_hi(hb.z) + bf_hi(y0.z) + bf_hi(y1.z) + v1[1]);
                w.w = cvt_pk_bf16(bf_lo(hb.w) + bf_lo(y0.w) + bf_lo(y1.w) + v1[2], bf_hi(hb.w) + bf_hi(y0.w) + bf_hi(y1.w) + v1[3]);
                *(GAS v4u*)(HB + row * D + c) = w; ssq += sumsq8(w); }
            ssq += __shfl_xor(ssq, 16); ssq += __shfl_xor(ssq, 32);
            if (fq == 0) SS[row * 32 + u.pn * 4 + wc] = ssq;
            if (b + 4 < 8) RY_LOAD(b + 4) }
#undef RY_LOAD
    }
};
struct EpiGU {
    static constexpr bool PERM = true, AFTER_DRAIN = false;
    bf16* HID; MoeTab tab; const float* tokr;
    __device__ __forceinline__ void operator()(const AccT& acc, const Unit& u, int wr, int wc, int fr, int fq) const {
        const int e_ = tab.mt_e[u.pm], row0_ = tab.mt_row0[u.pm], cnt_ = tab.cnt[e_];
        const GAS float* tr = (const GAS float*)tokr + (size_t)e_ * M;
        float rsv[8];
#pragma unroll
        for (int b = 0; b < 8; ++b) { const int idx_ = row0_ + (b >> 2) * 128 + wr * 64 + (b & 3) * 16 + fr; rsv[b] = tr[idx_ < cnt_ ? idx_ : cnt_ - 1]; }
        __builtin_amdgcn_s_waitcnt(0x0F70);
#pragma unroll
        for (int ai = 0; ai < 2; ++ai) { if (u.half >= 0 && u.half != ai) continue;
#pragma unroll
            for (int m = 0; m < 4; ++m) { const size_t row = (size_t)u.pm * 256 + ai * 128 + wr * 64 + m * 16 + fr;
                const int idx_ = row0_ + ai * 128 + wr * 64 + m * 16 + fr; const float rs = idx_ < cnt_ ? rsv[ai * 4 + m] : 0.f;
                float h[8];
#pragma unroll
                for (int n = 0; n < 2; ++n)
#pragma unroll
                    for (int e = 0; e < 4; ++e) { const float gt = acc[ai][0][m][n][e] * rs, up = acc[ai][1][m][n][e] * rs; h[n * 4 + e] = gt * sigmoidf_(gt) * up; }
                v4u w; w.x = cvt_pk_bf16(h[0], h[1]); w.y = cvt_pk_bf16(h[2], h[3]); w.z = cvt_pk_bf16(h[4], h[5]); w.w = cvt_pk_bf16(h[6], h[7]);
                *(GAS v4u*)(HID + row * DE + u.pn * 128 + wc * 32 + 8 * fq) = w; } }
    }
};
struct EpiDN {
    static constexpr bool PERM = true, AFTER_DRAIN = false;
    MoeTab tab; const int* tokl; const float* tokw; bf16* YP;
    __device__ __forceinline__ void operator()(const AccT& acc, const Unit& u, int wr, int wc, int fr, int fq) const {
        const int e = tab.mt_e[u.pm], row0 = tab.mt_row0[u.pm], cnt = tab.cnt[e];
        const GAS int* tl = (const GAS int*)tokl + (size_t)e * M; const GAS float* tw = (const GAS float*)tokw + (size_t)e * M;
        int pr[8]; float wg[8];
#pragma unroll
        for (int b = 0; b < 8; ++b) { const int idx = row0 + (b >> 2) * 128 + wr * 64 + (b & 3) * 16 + fr, ic = idx < cnt ? idx : cnt - 1; pr[b] = tl[ic]; wg[b] = tw[ic]; }
        __builtin_amdgcn_s_waitcnt(0x0F70);
#pragma unroll
        for (int ai = 0; ai < 2; ++ai) { if (u.half >= 0 && u.half != ai) continue;
#pragma unroll
            for (int m = 0; m < 4; ++m) { const int idx = row0 + ai * 128 + wr * 64 + m * 16 + fr;
                if (idx < cnt) { const int pair = pr[ai * 4 + m]; const float wgt = wg[ai * 4 + m];
#pragma unroll
                    for (int bj = 0; bj < 2; ++bj) { const pg8::f32x4 v0 = acc[ai][bj][m][0], v1 = acc[ai][bj][m][1];
                        v4u w; w.x = cvt_pk_bf16(v0[0] * wgt, v0[1] * wgt); w.y = cvt_pk_bf16(v0[2] * wgt, v0[3] * wgt); w.z = cvt_pk_bf16(v1[0] * wgt, v1[1] * wgt); w.w = cvt_pk_bf16(v1[2] * wgt, v1[3] * wgt);
                        *(GAS v4u*)(YP + (size_t)pair * D + u.pn * 256 + bj * 128 + wc * 32 + 8 * fq) = w; } } } }
    }
};
struct EpiQKVG {
    static constexpr bool PERM = true, AFTER_DRAIN = false;
    bf16* Q; size_t tstride;
    __device__ __forceinline__ void operator()(const AccT& acc, const Unit& u, int wr, int wc, int fr, int fq) const {
        const int t = u.pn >> 3; bf16* base = Q + (size_t)t * tstride; const int col0 = (u.pn & 7) * 256 + wc * 32 + 8 * fq;
#pragma unroll
        for (int ai = 0; ai < 2; ++ai)
#pragma unroll
            for (int m = 0; m < 4; ++m) { bf16* rowp = base + ((size_t)u.pm * 256 + ai * 128 + wr * 64 + m * 16 + fr) * D + col0;
#pragma unroll
                for (int bj = 0; bj < 2; ++bj) { pg8::f32x4 v0 = acc[ai][bj][m][0], v1 = acc[ai][bj][m][1];
                    if (t == 3) {
#pragma unroll
                        for (int e = 0; e < 4; ++e) { v0[e] = sigmoidf_(v0[e]); v1[e] = sigmoidf_(v1[e]); } }
                    v4u w; w.x = cvt_pk_bf16(v0[0], v0[1]); w.y = cvt_pk_bf16(v0[2], v0[3]); w.z = cvt_pk_bf16(v1[0], v1[1]); w.w = cvt_pk_bf16(v1[2], v1[3]);
                    *(GAS v4u*)(rowp + bj * 128) = w; } }
    }
};

namespace fox {
constexpr int AD = 128, PITCH = 2048;
constexpr float SCALE = 0.08838834764831845f;
constexpr float THR = 24.f;
constexpr int NW = 8, QBLK = 32, KVBLK = 64, QB = NW * QBLK;
constexpr int SHM_V = KVBLK * AD * 2, SHM_K = KVBLK * AD * 2;
constexpr int WS_OFF = 2 * SHM_V + 2 * SHM_K;
constexpr int BIAS_OFF = WS_OFF + NW * 64 * 4;
constexpr int ATT_LDS_BYTES = BIAS_OFF + 2 * SEQ * 4;
constexpr int GATE_OFF = 86016;
static_assert(GATE_OFF >= ATT_LDS_BYTES && GATE_OFF % 16 == 0, "gate tiles above the K/V/bias region");
typedef short s16x4 __attribute__((ext_vector_type(4)));

#define KSWZ(row, colB) ((row) * 256 + ((colB) ^ (((row) & 7) << 4)))
#define SBAR() __builtin_amdgcn_sched_barrier(0)
__device__ __forceinline__ int v_st(int k, int c) { const int kk = (k & ~0xC) | ((k & 4) << 1) | ((k & 8) >> 1); return ((kk >> 3) * 4 + (c >> 5)) * 512 + ((kk & 7) * 32 + (c & 31)) * 2; }
__device__ __forceinline__ int v_rd_base(int lane) { return ((lane & 3) << 3) | (((lane >> 2) & 3) << 6) | (((lane >> 4) & 1) << 5) | (((lane >> 5) & 1) << 8); }
constexpr int v_rd_off(int d0, int ks, int half) { return d0 * 512 + ks * 4096 + half * 2048; }
__device__ __forceinline__ int crow(int r, int hi) { return (r & 3) + 8 * (r >> 2) + 4 * hi; }
__device__ __forceinline__ unsigned cvtpk(float lo, float hi) { unsigned r; asm volatile("v_cvt_pk_bf16_f32 %0, %1, %2" : "=v"(r) : "v"(lo), "v"(hi)); return r; }
__device__ __forceinline__ bf16x8 ld8(const GAS char* ubase, unsigned voff) { return *(const GAS bf16x8*)(ubase + voff); }
constexpr size_t VK_DELTA = (size_t)64 << 20;
__device__ __forceinline__ void mask_tile(f32x16& p0, f32x16& p1, int dq) {
    const float NEG = -__builtin_inff();
#pragma unroll
    for (int r = 0; r < 16; ++r) {
        const int c = (r & 3) + 8 * (r >> 2);
        if (dq - c < 0) p0[r] = NEG;
        if (dq - c - 32 < 0) p1[r] = NEG;
    }
}
__device__ __forceinline__ void partialSM(f32x16& p0, f32x16& p1, float& m_reg, float& mn, float& alpha) {
    float pmax = p0[0]; for (int r = 1; r < 16; ++r) pmax = fmaxf(pmax, p0[r]); for (int r = 0; r < 16; ++r) pmax = fmaxf(pmax, p1[r]);
    { auto rr = __builtin_amdgcn_permlane32_swap(__float_as_uint(pmax), __float_as_uint(pmax), false, false);
      pmax = fmaxf(__uint_as_float(rr[0]), __uint_as_float(rr[1])); }
    constexpr float C2 = 1.4426950408889634f * SCALE;
    if (__builtin_expect(__all((pmax - m_reg) * SCALE <= THR), 1)) { mn = m_reg; alpha = 1.f; }
    else { mn = fmaxf(m_reg, pmax); alpha = __builtin_amdgcn_exp2f((m_reg - mn) * C2); m_reg = mn; }
    const float mnL = -mn * C2;
    for (int r = 0; r < 16; ++r) p0[r] = fmaf(p0[r], C2, mnL); for (int r = 0; r < 16; ++r) p1[r] = fmaf(p1[r], C2, mnL);
    for (int r = 0; r < 16; ++r) p0[r] = __builtin_amdgcn_exp2f(p0[r]);
}
__device__ __forceinline__ void finishSM(f32x16& p0, f32x16& p1, float alpha, float& l_reg, bf16x8& pa0, bf16x8& pa1, bf16x8& pa2, bf16x8& pa3) {
    for (int r = 0; r < 16; ++r) p1[r] = __builtin_amdgcn_exp2f(p1[r]);
    float ps = 0; for (int r = 0; r < 16; ++r) ps += p0[r]; for (int r = 0; r < 16; ++r) ps += p1[r];
    { auto rr = __builtin_amdgcn_permlane32_swap(__float_as_uint(ps), __float_as_uint(ps), false, false);
      ps = __uint_as_float(rr[0]) + __uint_as_float(rr[1]); }
    l_reg = l_reg * alpha + ps;
#define PK4(P, B_, OUT) do { unsigned a0 = cvtpk(P[B_+0], P[B_+1]), a1 = cvtpk(P[B_+2], P[B_+3]);                          \
        unsigned b0 = cvtpk(P[B_+4], P[B_+5]), b1 = cvtpk(P[B_+6], P[B_+7]);                                             \
        auto r0 = __builtin_amdgcn_permlane32_swap(a0, b0, false, false); auto r1 = __builtin_amdgcn_permlane32_swap(a1, b1, false, false); \
        v4u w = {r0[0], r1[0], r0[1], r1[1]}; OUT = *reinterpret_cast<bf16x8*>(&w); } while (0)
    PK4(p0, 0, pa0); PK4(p0, 8, pa1); PK4(p1, 0, pa2); PK4(p1, 8, pa3);
#undef PK4
}
template <int KB>
__device__ __forceinline__ void qkt(f32x16& p0, f32x16& p1, const char* K_lds, int r32, int hi, const bf16x8* qr, const float* bias_t  ) {
#pragma unroll
    for (int g = 0; g < 4; ++g) { const f32x4 b0 = *(const f32x4*)(bias_t + 8 * g), b1 = *(const f32x4*)(bias_t + 32 + 8 * g);
        p0[4 * g] = b0.x; p0[4 * g + 1] = b0.y; p0[4 * g + 2] = b0.z; p0[4 * g + 3] = b0.w;
        p1[4 * g] = b1.x; p1[4 * g + 1] = b1.y; p1[4 * g + 2] = b1.z; p1[4 * g + 3] = b1.w; }
    const char* kb[4];
#pragma unroll
    for (int dd = 0; dd < 4; ++dd) kb[dd] = K_lds + KB * SHM_K + KSWZ(r32, (dd * 16 + hi * 8) * 2);
#pragma unroll
    for (int d0 = 0; d0 < 8; ++d0) { const char* a = kb[d0 & 3] + (d0 >> 2) * 128;
        bf16x8 b0 = *reinterpret_cast<const bf16x8*>(a);
        bf16x8 b1 = *reinterpret_cast<const bf16x8*>(a + 32 * 256);
        p0 = __builtin_amdgcn_mfma_f32_32x32x16_bf16(b0, qr[d0], p0, 0, 0, 0);
        p1 = __builtin_amdgcn_mfma_f32_32x32x16_bf16(b1, qr[d0], p1, 0, 0, 0); }
}
template <int VB>
__device__ __forceinline__ void pv_tile(f32x16* o, int vb0, bf16x8 pa0, bf16x8 pa1, bf16x8 pa2, bf16x8 pa3) {
#define TRRD(dst, off) asm volatile("ds_read_b64_tr_b16 %0, %1 offset:%2" : "=&v"(dst) : "v"(vb0), "i"(off) : "memory")
#define PV_D0(d0) do { s16x4 l0, l1, l2, l3, h0, h1, h2, h3; constexpr int b_ = VB * SHM_V + v_rd_off(d0, 0, 0); \
        TRRD(l0, b_); TRRD(h0, b_ + 2048); TRRD(l1, b_ + 4096); TRRD(h1, b_ + 6144); TRRD(l2, b_ + 8192); TRRD(h2, b_ + 10240); TRRD(l3, b_ + 12288); TRRD(h3, b_ + 14336); \
        asm volatile("s_waitcnt lgkmcnt(0)" ::: "memory"); SBAR();   \
        o[d0] = __builtin_amdgcn_mfma_f32_32x32x16_bf16(pa0, (bf16x8){l0[0], l0[1], l0[2], l0[3], h0[0], h0[1], h0[2], h0[3]}, o[d0], 0, 0, 0);   \
        o[d0] = __builtin_amdgcn_mfma_f32_32x32x16_bf16(pa1, (bf16x8){l1[0], l1[1], l1[2], l1[3], h1[0], h1[1], h1[2], h1[3]}, o[d0], 0, 0, 0);   \
        o[d0] = __builtin_amdgcn_mfma_f32_32x32x16_bf16(pa2, (bf16x8){l2[0], l2[1], l2[2], l2[3], h2[0], h2[1], h2[2], h2[3]}, o[d0], 0, 0, 0);   \
        o[d0] = __builtin_amdgcn_mfma_f32_32x32x16_bf16(pa3, (bf16x8){l3[0], l3[1], l3[2], l3[3], h3[0], h3[1], h3[2], h3[3]}, o[d0], 0, 0, 0); } while (0)
    PV_D0(0); PV_D0(1); PV_D0(2); PV_D0(3);
#undef PV_D0
#undef TRRD
}

struct BlockRef { const GAS char* Q; const GAS char* K; GAS char* O; const GAS char* SG; const GAS char* CB; int P0; int par; };
struct Seam { bf16x8 qr[8]; bf16x8 st_v0, st_v1, st_k0, st_k1; };
#define KVP(Kp, k0) ((Kp) + (size_t)(k0) * (PITCH * 2))
#define VMW() asm volatile("s_waitcnt vmcnt(0)" ::: "memory")
#define VMWN(n) asm volatile("s_waitcnt vmcnt(%0)" :: "i"(n) : "memory")
#define SLOAD_H(Kp, k0) do { S.st_v0 = ld8(KVP(Kp, k0) + VK_DELTA, kvo0); S.st_v1 = ld8(KVP(Kp, k0) + VK_DELTA, kvo1);              \
                         S.st_k0 = ld8(KVP(Kp, k0), kvo0); S.st_k1 = ld8(KVP(Kp, k0), kvo1); } while (0)
#define SWRITE_HK(bf) do { *(bf16x8*)(K_lds + (bf) * SHM_K + kws) = S.st_k0; *(bf16x8*)(K_lds + (bf) * SHM_K + kws + 32 * 256) = S.st_k1; } while (0)
#define SWRITE_HV(bf) do { *(bf16x8*)(V_lds + (bf) * SHM_V + vst0) = S.st_v0; *(bf16x8*)(V_lds + (bf) * SHM_V + vst1) = S.st_v1; } while (0)
#define SWRITE_H(bf) do { SWRITE_HV(bf); SWRITE_HK(bf); } while (0)
#define QLOAD(blk) do { const GAS char* qb_ = (blk).Q + (size_t)wid * (QBLK * PITCH * 2); _Pragma("unroll") for (int d0 = 0; d0 < 8; ++d0) S.qr[d0] = ld8(qb_ + d0 * 32, qvo); } while (0)
#define GATE_DMA(blk) do { const GAS char* gs_ = (blk).SG + (size_t)wid * (QBLK * PITCH * 2); _Pragma("unroll") for (int i_ = 0; i_ < 8; ++i_) \
        __builtin_amdgcn_global_load_lds((const GAS unsigned*)(gs_ + (size_t)i_ * (4 * PITCH * 2) + gvo), (LAS unsigned*)(lds + GATE_OFF + wid * 8192 + i_ * 1024), 16, 0, 0); } while (0)
#define BIAS_DMA(blk) __builtin_amdgcn_global_load_lds((const GAS unsigned*)((blk).CB + wid * 1024 + bvo), (LAS unsigned*)(lds + BIAS_OFF + (blk).par * (SEQ * 4) + wid * 1024), 16, 0, 0)
__device__ __forceinline__ void fox_prime(const BlockRef& cur, char* lds, Seam& S, const int tid) {
    const int wid = __builtin_amdgcn_readfirstlane(tid >> 6), lane = tid & 63, r32 = lane & 31, hi = lane >> 5;
    const int sr = tid >> 4, sc = (tid & 15) * 8, kws = KSWZ(sr, sc * 2); char* K_lds = lds + 2 * SHM_V;
    unsigned kvo0 = (unsigned)(sr * PITCH + sc) * 2u, kvo1 = kvo0 + 32u * PITCH * 2u, qvo = (unsigned)(r32 * PITCH + hi * 8) * 2u, bvo = (unsigned)(lane * 16), gvo = (unsigned)((lane >> 4) * (PITCH * 2) + (lane & 15) * 16);
    asm volatile("" : "+v"(kvo0), "+v"(kvo1), "+v"(qvo), "+v"(bvo), "+v"(gvo));
    BIAS_DMA(cur); GATE_DMA(cur);
    QLOAD(cur);
    SLOAD_H(cur.K, 0); VMW(); SWRITE_HK(0);
    __syncthreads();
}
__device__ __forceinline__ void fox_block(const BlockRef& cur, const BlockRef& nxt, char* lds, Seam& S, const int tid) {
    const int wid = __builtin_amdgcn_readfirstlane(tid >> 6), lane = tid & 63, r32 = lane & 31, hi = lane >> 5;
    const int NT = (cur.P0 + QB - 1) / KVBLK + 1;
    const int qlo = cur.P0 + wid * QBLK, qm = qlo + r32 - 4 * hi;
    char* V_lds = lds; char* K_lds = lds + 2 * SHM_V;
    float* ws = (float*)(lds + WS_OFF) + wid * 64; float* li_l = ws, * al_l = ws + 32;
    const float* bias_l = (const float*)(lds + BIAS_OFF + cur.par * (SEQ * 4)) + 4 * hi;
    float m_reg = -1e30f, l_reg = 0; f32x16 o[4] = {};
    const int sr = tid >> 4, sc = (tid & 15) * 8, vst0 = v_st(sr, sc), vst1 = v_st(32 + sr, sc), kws = KSWZ(sr, sc * 2);
    const int vb0 = (int)(uintptr_t)V_lds + v_rd_base(lane);
    const GAS char* Kh = cur.K;
    unsigned kvo0 = (unsigned)(sr * PITCH + sc) * 2u, kvo1 = kvo0 + 32u * PITCH * 2u, qvo = (unsigned)(r32 * PITCH + hi * 8) * 2u, bvo = (unsigned)(lane * 16), gvo = (unsigned)((lane >> 4) * (PITCH * 2) + (lane & 15) * 16);
    asm volatile("" : "+v"(kvo0), "+v"(kvo1), "+v"(qvo), "+v"(bvo), "+v"(gvo));
#define RESC(a) do { if (__any((a) < 1.f)) { if (hi == 0) al_l[r32] = (a); asm volatile("s_waitcnt lgkmcnt(0)" ::: "memory");              \
                     for (int d_ = 0; d_ < 4; ++d_) for (int r = 0; r < 16; ++r) o[d_][r] *= al_l[crow(r, hi)]; } } while (0)
#define KBASE(t) ((t) * KVBLK)
#define MASKT(P0_, P1_, t) do { const int kb_ = KBASE(t); if (kb_ + KVBLK - 1 > qlo) mask_tile(P0_, P1_, qm - kb_); } while (0)
    constexpr int NQL = 8;
#define SEAM_K0() do { VMWN(NQL); SWRITE_HK(0); SBAR(); } while (0)
    f32x16 pA0, pA1, pB0, pB1; float mnA, mnB, alA, alB; bf16x8 pa0, pa1, pa2, pa3;
    SWRITE_HV(0); SBAR();
    if (NT > 1) { SLOAD_H(Kh, KBASE(1)); }
    SBAR(); qkt<0>(pA0, pA1, K_lds, r32, hi, S.qr, bias_l + KBASE(0));
    MASKT(pA0, pA1, 0); partialSM(pA0, pA1, m_reg, mnA, alA);
    if (NT > 1) { VMW(); SWRITE_H(1); }
    __syncthreads();
#define HALF_STEP(PX0, PX1, mnX, alX, PY0, PY1, alY, t, KB, VB, SB) do {                                                      \
        SBAR(); qkt<KB>(PX0, PX1, K_lds, r32, hi, S.qr, bias_l + KBASE(t));                                                   \
        finishSM(PY0, PY1, alY, l_reg, pa0, pa1, pa2, pa3); SBAR();                                                           \
        if ((t) + 1 < NT) { SLOAD_H(Kh, KBASE((t) + 1)); SBAR(); }                                                        \
        pv_tile<VB>(o, vb0, pa0, pa1, pa2, pa3); MASKT(PX0, PX1, (t)); partialSM(PX0, PX1, m_reg, mnX, alX);                  \
        __syncthreads();                                                                                                      \
        if ((t) + 1 < NT) { VMW(); SWRITE_H(SB); }                                                                            \
        RESC(alX); __syncthreads(); } while (0)
    for (int t = 1; t + 1 < NT; t += 2) {
        HALF_STEP(pB0, pB1, mnB, alB, pA0, pA1, alA, t, 1, 0, 0);
        HALF_STEP(pA0, pA1, mnA, alA, pB0, pB1, alB, t + 1, 0, 1, 1);
    }
    const bool even = (NT & 1) == 0;
    if (even) { SBAR(); qkt<1>(pB0, pB1, K_lds, r32, hi, S.qr, bias_l + KBASE(NT - 1)); SBAR(); }
    BIAS_DMA(nxt);
    SLOAD_H(nxt.K, 0); SBAR();
    QLOAD(nxt);
    SBAR();
    finishSM(pA0, pA1, alA, l_reg, pa0, pa1, pa2, pa3); SBAR();
    pv_tile<0>(o, vb0, pa0, pa1, pa2, pa3);
    if (even) { MASKT(pB0, pB1, NT - 1); partialSM(pB0, pB1, m_reg, mnB, alB); __syncthreads(); RESC(alB);
        finishSM(pB0, pB1, alB, l_reg, pa0, pa1, pa2, pa3); SBAR(); pv_tile<1>(o, vb0, pa0, pa1, pa2, pa3); }
    SBAR(); SEAM_K0();
    if (hi == 0) li_l[r32] = l_reg; asm volatile("s_waitcnt lgkmcnt(0)" ::: "memory");
    float rli[16];
#pragma unroll
    for (int r = 0; r < 16; ++r) rli[r] = __builtin_amdgcn_rcpf(li_l[crow(r, hi)]);
    const char* gate_l = lds + GATE_OFF + wid * 8192 + (4 * hi) * 256 + r32 * 2;
    GAS char* Ow = cur.O + (size_t)wid * (QBLK * PITCH * 2); unsigned ovo = (unsigned)(4 * hi * PITCH + r32) * 2u; asm volatile("" : "+v"(ovo));
#pragma unroll
    for (int r = 0; r < 16; ++r) { GAS char* Or = Ow + (size_t)((r & 3) + 8 * (r >> 2)) * (PITCH * 2);
#pragma unroll
        for (int d0 = 0; d0 < 4; ++d0) { const float v = o[d0][r] * rli[r];
            const float vn = __shfl_xor(v, 1);
            if ((r32 & 1) == 0) { const unsigned gg = *(const unsigned*)(gate_l + ((r & 3) + 8 * (r >> 2)) * 256 + d0 * 64);
                *(GAS unsigned*)(Or + d0 * 64 + ovo) = cvtpk(v * pg8::bf_lo(gg), vn * pg8::bf_hi(gg)); } } }
    asm volatile("s_waitcnt lgkmcnt(0)" ::: "memory"); SBAR();
    GATE_DMA(nxt);
    __syncthreads();
#undef RESC
#undef KBASE
#undef MASKT
#undef SEAM_K0
#undef HALF_STEP
}
#undef KVP
#undef QLOAD
#undef VMW
#undef VMWN
#undef SLOAD_H
#undef SWRITE_HK
#undef SWRITE_HV
#undef SWRITE_H
#undef BIAS_DMA
#undef GATE_DMA

struct Tens { const bf16* Q; const bf16* K; bf16* O; const bf16* SG; const float* CB; };
__device__ __forceinline__ BlockRef fox_ref(const Tens& T, int L, int pass, int seq_no) {
    const int xcd = L & 7, k = L >> 3, bh = (k >> 2) * 8 + xcd, x = k & 3, qb = pass ? 7 - x : x, b = bh >> 4, h = bh & 15;
    BlockRef r; const size_t hoff = (size_t)b * SEQ * PITCH + h * AD, qoff = hoff + (size_t)qb * QB * PITCH;
    r.Q = (const GAS char*)(T.Q + qoff); r.O = (GAS char*)(T.O + qoff); r.SG = (const GAS char*)(T.SG + qoff); r.K = (const GAS char*)(T.K + hoff); r.CB = (const GAS char*)(T.CB + (size_t)bh * SEQ); r.P0 = qb * QB; r.par = seq_no & 1;
    return r;
}
__device__ __forceinline__ void fox_phase(char* lds, const Tens& T, int G, int c, const int tid) {
    constexpr int total = NB * NH * 4;
    int L = c; if (L >= total) return;
    int pass = 0, seq = 0;
    BlockRef cur = fox_ref(T, L, 0, 0);
    Seam S;
    fox_prime(cur, lds, S, tid);
    for (;;) {
        const bool more_pass = pass == 0, more_item = L + G < total, last = !more_pass && !more_item;
        int passn = pass + 1, Ln = L;
        if (!more_pass) { passn = 0; Ln = more_item ? L + G : L; }
        const BlockRef nxt = fox_ref(T, Ln, passn, seq + 1);
        fox_block(cur, nxt, lds, S, tid);
        if (last) break;
        cur = nxt; pass = passn; L = Ln; ++seq;
    }
}
}

__device__ __forceinline__ float log_sigmoid_(float x) { return x >= 0.f ? -log1pf(expf(-x)) : x - log1pf(expf(x)); }
struct RowArgs {
    const bf16* Hin; const bf16* YP; float* Hout; const float* gain; bf16* HN; float* out;
    const bf16* Wsk; const float* b0; const float* b1;
    unsigned* cnt; int* tokl; float* pw; float* LF; float* tokw; float* tokr;
    const float* SS; float* RSTD;
};
template <int MODE>
__device__ __forceinline__ void row_phase(Frame& F, const RowArgs& A) {
    constexpr int NCT = (MODE == 1) ? 3 : 1, LGP = NCT * 32, RU = (MODE == 1) ? 4 : 2;
    LAS float* PB = (LAS float*)(F.lds + RING_OFF);
    LAS float* LG = PB + 64 * LGP;
    for (int blk = blockIdx.x; blk < M / 64; blk += F.G) {
        const int r0 = blk * 64;
        if constexpr (MODE >= 2)
        for (int k0 = 0; k0 < 8; k0 += RU) {
            f32x4 v[RU][8];
#pragma unroll
            for (int u = 0; u < RU; ++u) { const GAS v2u* xr = (const GAS v2u*)(A.Hin + (size_t)(r0 + F.wave * 8 + k0 + u) * D) + F.lane;
#pragma unroll
                for (int j = 0; j < 8; ++j) { const v2u hb = xr[64 * j]; v[u][j].x = bf_lo(hb.x); v[u][j].y = bf_hi(hb.x); v[u][j].z = bf_lo(hb.y); v[u][j].w = bf_hi(hb.y); } }
            if constexpr (MODE >= 2) {
                v2u ya[RU][8], yb[RU][8];
#pragma unroll
                for (int u = 0; u < RU; ++u) { const int row = r0 + F.wave * 8 + k0 + u;
                    const GAS v2u* y0 = (const GAS v2u*)(A.YP + (size_t)(2 * row) * D) + F.lane; const GAS v2u* y1 = (const GAS v2u*)(A.YP + (size_t)(2 * row + 1) * D) + F.lane;
#pragma unroll
                    for (int j = 0; j < 8; ++j) { ya[u][j] = y0[64 * j]; yb[u][j] = y1[64 * j]; } }
#pragma unroll
                for (int u = 0; u < RU; ++u)
#pragma unroll
                    for (int j = 0; j < 8; ++j) { const v2u a = ya[u][j], b = yb[u][j];
                        v[u][j].x += bf_lo(a.x) + bf_lo(b.x); v[u][j].y += bf_hi(a.x) + bf_hi(b.x); v[u][j].z += bf_lo(a.y) + bf_lo(b.y); v[u][j].w += bf_hi(a.y) + bf_hi(b.y); }
            }
#pragma unroll
            for (int u = 0; u < RU; ++u) {
                const int row = r0 + F.wave * 8 + k0 + u;
                float s = 0.f;
#pragma unroll
                for (int j = 0; j < 8; ++j) s += (v[u][j].x * v[u][j].x + v[u][j].y * v[u][j].y) + (v[u][j].z * v[u][j].z + v[u][j].w * v[u][j].w);
                const float rstd = 1.f / sqrtf(wave_sum(s) * (1.f / D) + RMS_EPS);
                const GAS f32x4* gr = (const GAS f32x4*)A.gain + F.lane;
                if constexpr (MODE == 3) { GAS f32x4* o = (GAS f32x4*)(A.out + (size_t)row * D) + F.lane;
#pragma unroll
                    for (int j = 0; j < 8; ++j) { const f32x4 g = gr[64 * j]; f32x4 w; w.x = v[u][j].x * rstd * g.x; w.y = v[u][j].y * rstd * g.y; w.z = v[u][j].z * rstd * g.z; w.w = v[u][j].w * rstd * g.w; __builtin_nontemporal_store(w, o + 64 * j); } }
                else { GAS v2u* o8 = (GAS v2u*)(A.HN + (size_t)row * D) + F.lane;
#pragma unroll
                    for (int j = 0; j < 8; ++j) { const f32x4 g = gr[64 * j]; v2u w; w.x = pk2(v[u][j].x * rstd * g.x, v[u][j].y * rstd * g.y); w.y = pk2(v[u][j].z * rstd * g.z, v[u][j].w * rstd * g.w); o8[64 * j] = w; } }
            }
        }
        if constexpr (MODE == 1 || MODE == 2) {
            LAS float* RS_l = PB + 4 * 64 * LGP;
            if constexpr (MODE == 1) { if (F.tid < 64) { const GAS f32x4* ss = (const GAS f32x4*)(A.SS + (size_t)(r0 + F.tid) * 32); float t = 0.f;
#pragma unroll
                    for (int j = 0; j < 8; ++j) { const f32x4 q = ss[j]; t += (q.x + q.y) + (q.z + q.w); }
                    const float rs = 1.f / sqrtf(t * (1.f / D) + RMS_EPS); RS_l[F.tid] = rs; A.RSTD[r0 + F.tid] = rs; } }
            VM_WAIT(); __syncthreads();
            const int r32 = F.lane & 31, hi = F.lane >> 5;
            f32x16 acc[2][NCT];
#pragma unroll
            for (int rt = 0; rt < 2; ++rt)
#pragma unroll
                for (int ct = 0; ct < NCT; ++ct) acc[rt][ct] = (f32x16){};
            {
                const bf16* ap = (MODE == 1 ? A.Hin : A.HN) + (size_t)(r0 + r32) * D + F.wave * 256 + 8 * hi;
                const bf16* bp = A.Wsk + (size_t)r32 * D + F.wave * 256 + 8 * hi;
                constexpr int QB = (MODE == 1) ? 4 : 8;
#pragma unroll 1
                for (int kb = 0; kb < 16 / QB; ++kb) {
                    bf16x8 af[2][QB], bfr[NCT][QB];
#pragma unroll
                    for (int q = 0; q < QB; ++q) {
#pragma unroll
                        for (int rt = 0; rt < 2; ++rt) af[rt][q] = *(const GAS bf16x8*)(ap + (size_t)rt * 32 * D + (kb * QB + q) * 16);
#pragma unroll
                        for (int ct = 0; ct < NCT; ++ct) bfr[ct][q] = *(const GAS bf16x8*)(bp + (size_t)ct * 32 * D + (kb * QB + q) * 16); }
#pragma unroll
                    for (int q = 0; q < QB; ++q)
#pragma unroll
                        for (int rt = 0; rt < 2; ++rt)
#pragma unroll
                            for (int ct = 0; ct < NCT; ++ct) acc[rt][ct] = __builtin_amdgcn_mfma_f32_32x32x16_bf16(af[rt][q], bfr[ct][q], acc[rt][ct], 0, 0, 0);
                }
            }
#define RP_STORE(buf) do { _Pragma("unroll") for (int rt = 0; rt < 2; ++rt) _Pragma("unroll") for (int ct = 0; ct < NCT; ++ct) _Pragma("unroll") for (int r = 0; r < 16; ++r) \
                (buf)[(rt * 32 + (r & 3) + 8 * (r >> 2) + 4 * hi) * LGP + ct * 32 + r32] = acc[rt][ct][r]; } while (0)
#define RP_ADD(buf) do { _Pragma("unroll") for (int rt = 0; rt < 2; ++rt) _Pragma("unroll") for (int ct = 0; ct < NCT; ++ct) _Pragma("unroll") for (int r = 0; r < 16; ++r) \
                acc[rt][ct][r] += (buf)[(rt * 32 + (r & 3) + 8 * (r >> 2) + 4 * hi) * LGP + ct * 32 + r32]; } while (0)
            if (F.wave >= 4) RP_STORE(PB + (F.wave - 4) * 64 * LGP);
            LDS_WAIT(); __syncthreads();
            if (F.wave < 4) RP_ADD(PB + F.wave * 64 * LGP);
            LDS_WAIT(); __syncthreads();
            if (F.wave == 2 || F.wave == 3) RP_STORE(PB + (F.wave - 2) * 64 * LGP);
            LDS_WAIT(); __syncthreads();
            if (F.wave < 2) RP_ADD(PB + F.wave * 64 * LGP);
            LDS_WAIT(); __syncthreads();
            if (F.wave == 1) RP_STORE(PB);
            LDS_WAIT(); __syncthreads();
            if (F.wave == 0) { RP_ADD(PB); RP_STORE(LG); }
            LDS_WAIT(); __syncthreads();
#undef RP_STORE
#undef RP_ADD
            if constexpr (MODE == 1) {
                if (F.tid < 64) {
                    const int tok = r0 + F.tid; const LAS float* lg = LG + F.tid * LGP;
                    float gl[8]; const float rs = RS_l[F.tid];
#pragma unroll
                    for (int i = 0; i < 8; ++i) gl[i] = lg[i] * rs + A.b0[i];
                    int gs = 0; float gm = gl[0];
#pragma unroll
                    for (int i = 1; i < 8; ++i) if (gl[i] > gm) { gm = gl[i]; gs = i; }
                    float den = 0.f;
#pragma unroll
                    for (int i = 0; i < 8; ++i) den += expf(gl[i] - gm);
                    const float pg = 1.f / den;
                    float el[8];
#pragma unroll
                    for (int i = 0; i < 8; ++i) el[i] = lg[8 + gs * 8 + i] * rs + A.b1[gs * 8 + i];
                    int i0 = 0; float t0 = el[0];
#pragma unroll
                    for (int i = 1; i < 8; ++i) if (el[i] > t0) { t0 = el[i]; i0 = i; }
                    int i1 = 0; float t1 = -__builtin_inff();
#pragma unroll
                    for (int i = 0; i < 8; ++i) if (i != i0 && el[i] > t1) { t1 = el[i]; i1 = i; }
                    const float w0 = pg / (1.f + expf(t1 - t0)), w1 = pg - w0;
                    const int e0 = gs * 8 + i0, e1 = gs * 8 + i1;
                    const unsigned p0 = __hip_atomic_fetch_add(A.cnt + e0, 1u, RLX_AGENT), p1 = __hip_atomic_fetch_add(A.cnt + e1, 1u, RLX_AGENT);
                    A.tokl[(size_t)e0 * M + p0] = 2 * tok; A.tokl[(size_t)e1 * M + p1] = 2 * tok + 1;
                    A.tokw[(size_t)e0 * M + p0] = w0; A.tokw[(size_t)e1 * M + p1] = w1; A.tokr[(size_t)e0 * M + p0] = rs; A.tokr[(size_t)e1 * M + p1] = rs;
                    A.pw[2 * tok] = w0; A.pw[2 * tok + 1] = w1;
                }
            } else {
#pragma unroll
                for (int q = 0; q < 2; ++q) { const int idx = F.tid + q * 512, tl = idx >> 4, h = idx & 15;
                    A.LF[(size_t)(r0 + tl) * 16 + h] = log_sigmoid_(LG[tl * LGP + h] + A.b0[h]); }
            }
            __syncthreads();
        }
    }
}
__device__ __forceinline__ void cumsum_phase(Frame& F, const float* LF, float* CUMB) {
    LAS float* wt = (LAS float*)(F.lds + RING_OFF);
    for (int bh = blockIdx.x; bh < NB * NH; bh += F.G) {
        const int b = bh >> 4, h = bh & 15, s0 = 4 * F.tid;
        float c0 = LF[(size_t)(b * SEQ + s0) * 16 + h], c1 = c0 + LF[(size_t)(b * SEQ + s0 + 1) * 16 + h], c2 = c1 + LF[(size_t)(b * SEQ + s0 + 2) * 16 + h], c3 = c2 + LF[(size_t)(b * SEQ + s0 + 3) * 16 + h];
        float incl = c3;
#pragma unroll
        for (int o = 1; o < 64; o <<= 1) { const float t = __shfl_up(incl, o); if (F.lane >= o) incl += t; }
        if (F.lane == 63) wt[F.wave] = incl;
        LDS_WAIT(); __syncthreads();
        float off = incl - c3;
        for (int w = 0; w < F.wave; ++w) off += wt[w];
        const float sc = -1.f / fox::SCALE;
        f32x4 o4; o4.x = (off + c0) * sc; o4.y = (off + c1) * sc; o4.z = (off + c2) * sc; o4.w = (off + c3) * sc;
        *(GAS f32x4*)(CUMB + (size_t)bh * SEQ + s0) = o4;
        __syncthreads();
    }
}
__device__ __forceinline__ MoeTab moe_tables(Frame& F, const unsigned* cnt) {
    LAS int* base = (LAS int*)(F.lds + MOE_OFF);
    LAS int* cnt_l = base; LAS int* tstart = base + 64; LAS int* ntile = base + 128; LAS int* Tw = base + 192; LAS int* mt_e = base + 196; LAS int* mt_row0 = base + 196 + MAXMT;
    __syncthreads();
    if (F.tid < 64) {
        const int c = (int)__hip_atomic_load(cnt + F.tid, RLX_AGENT); const int nt = (c + 255) >> 8;
        int incl = nt;
#pragma unroll
        for (int o = 1; o < 64; o <<= 1) { const int t = __shfl_up(incl, o); if (F.lane >= o) incl += t; }
        cnt_l[F.tid] = c; tstart[F.tid] = incl - nt; ntile[F.tid] = nt; if (F.tid == 63) Tw[0] = incl;
    }
    LDS_WAIT(); __syncthreads();
    const int T = Tw[0];
    for (int mt = F.tid; mt < T; mt += NWAVES * 64) { int e = 0;
        for (int k = 0; k < 64; ++k) e += (tstart[k] + ntile[k] <= mt) ? 1 : 0;
        e = e > 63 ? 63 : e; mt_e[mt] = e; mt_row0[mt] = (mt - tstart[e]) * 256; }
    LDS_WAIT(); __syncthreads();
    MoeTab t; t.cnt = cnt_l; t.mt_e = mt_e; t.mt_row0 = mt_row0; t.T = T; return t;
}

#ifndef MK_PER_PHASE
#define MK_PER_PHASE 0
#endif
constexpr int NPHASE = 17;
__global__ void __launch_bounds__(NWAVES * 64, 2) hybrid_fwd(Args args) {
    extern __shared__ __attribute__((aligned(16))) unsigned char lds[];
    Frame F;
    F.lds = (LAS unsigned char*)lds;
    F.MISC = (volatile LAS unsigned*)(F.lds + MISC_OFF);
    F.tid = threadIdx.x; F.lane = F.tid & 63; F.wave = __builtin_amdgcn_readfirstlane(F.tid >> 6);
    const int wave0 = F.wave;
    F.G = gridDim.x; { const int bx = blockIdx.x; F.vcu = (F.G % 8 == 0) ? (bx % 8) * (F.G / 8) + bx / 8 : bx; }
    F.ws = args.ws;
    F.ctl = (gu32*)(args.ws + WS_CTL);
    for (int u = F.tid; u < (LDS_BYTES - LDSCTL_OFF) / 4; u += NWAVES * 64) ((LAS unsigned*)(F.lds + LDSCTL_OFF))[u] = 0u;
    __syncthreads();
    XcdBarrier bar; bar.bar = (unsigned*)(F.ctl + CW_BAR); bar.x = 0; bar.st = nullptr;
    if (!MK_PER_PHASE) bar = xcd_barrier_post((unsigned*)(F.ctl + CW_BAR), F.MISC + 8);
#define GRID_BAR() do { if (MK_PER_PHASE) { if (F.tid == 0) __hip_atomic_store(F.ctl + CW_TMO, 0xBADBA0u, RLX_AGENT); } else { XcdBarrier bb_ = bar; asm volatile("" : "+s"(bb_.bar)); xcd_barrier(bb_, F.tid); } } while (0)
    const int lo = args.ph_lo, hi = args.ph_hi; (void)lo; (void)hi;
#ifndef PH_MASK
#define PH_MASK 0x1ffff
#endif
#if MK_PER_PHASE
#define IN(k) ((((PH_MASK) >> (k)) & 1) && lo <= (k) && (k) < hi)
#else
#define IN(k) ((((PH_MASK) >> (k)) & 1) != 0)
#endif
#define BOTH(k) (IN(k) && IN((k) + 1))
    const int G = F.G, cid = (int)blockIdx.x, cls = ((int)blockIdx.x >> 3) & 1;
#define pHN ((bf16*)(ws + WS_HN))
#define pUA ((bf16*)(ws + WS_UA))
#define pGL ((bf16*)(ws + WS_GL))
#define pOG ((bf16*)(ws + WS_OG))
#define pH2 ((float*)(ws + WS_H2))
#define pHB ((bf16*)(ws + WS_H2 + 64 * MiB))
#define pYP ((bf16*)(ws + WS_YP))
#define pHID ((bf16*)(ws + WS_HID))
#define pTOKL ((int*)(ws + WS_TOKL))
#define pPW ((float*)(ws + WS_PW))
#define pSS ((float*)(ws + WS_SS))
#define pRSTD ((float*)(ws + WS_RSTD))
#define PH() unsigned char* ws; { int l_; asm volatile("v_mbcnt_lo_u32_b32 %0, -1, 0\n\tv_mbcnt_hi_u32_b32 %0, -1, %0" : "=v"(l_)); F.lane = l_; F.wave = wave0; F.tid = wave0 * 64 + l_; \
    unsigned wl_ = __builtin_amdgcn_readfirstlane((unsigned)(uintptr_t)args.ws), wh_ = __builtin_amdgcn_readfirstlane((unsigned)((uintptr_t)args.ws >> 32)); asm volatile("" : "+s"(wl_), "+s"(wh_)); ws = (unsigned char*)(((uintptr_t)wh_ << 32) | wl_); F.ws = ws; }
    if (IN(0)) { PH(); p0_prologue(F, args, ws); if (BOTH(0)) GRID_BAR(); }
    if (IN(1)) { PH(); SchedDense S; S.init(pHN, D, ws + WS_WS5IN, D, M / 256, DS / 256, G, cid); EpiU E{pUA};
        if (cls == 0) { moe_conv(F, args, ws, 0, 0, 3); __syncthreads(); } pg8::gemm_phase<EpiU, SchedDense, true>(F.lds + RING_OFF, F.tid, D, D, D, S, E); if (cls == 1) { __syncthreads(); moe_conv(F, args, ws, 0, 0, 3); } if (BOTH(1)) GRID_BAR(); }
    if (IN(2)) { PH(); SchedS5<1> S; S.init(pUA, ws + WS_PT, 256, 512, G, cid); EpiScan E{pUA, (const float*)(ws + WS_AL)};
        pg8::gemm_phase<EpiScan, SchedS5<1>, false>(F.lds + RING_OFF, F.tid, 512, KP, 512, S, E);
        if (G > 2 * NG && cid >= 2 * NG) conv_range<2>(F, args, ws, 0, CONV_TOTAL_FOX, (cid - 2 * NG) * NWAVES + F.wave, (G - 2 * NG) * NWAVES);
        if (BOTH(2)) GRID_BAR(); }
    if (IN(3)) { PH(); SchedS5<2> S; S.init(pUA, ws + WS_TT, 512, KP, G, cid); EpiY E{pUA, args.in[9], pGL};
        if (G <= 2 * NG && cls == 0) { conv_run<2>(F, args, ws, 0, 1); __syncthreads(); } pg8::gemm_phase<EpiY, SchedS5<2>, true>(F.lds + RING_OFF, F.tid, KP, KP, KP, S, E); if (G <= 2 * NG && cls == 1) { __syncthreads(); conv_run<2>(F, args, ws, 0, 1); } if (BOTH(3)) GRID_BAR(); }
    if (IN(4)) { PH(); SchedDense S; S.init(pGL, DS, ws + WS_WGLU, DS, M / 256, DS / 256, G, cid); EpiGlu E{pGL, args.in[12], pOG};
        if (cls == 0) { moe_conv(F, args, ws, 0, 1, 3); __syncthreads(); } pg8::gemm_phase<EpiGlu, SchedDense, true>(F.lds + RING_OFF, F.tid, DS, DS, DS, S, E); if (cls == 1) { __syncthreads(); moe_conv(F, args, ws, 0, 1, 3); } if (BOTH(4)) GRID_BAR(); }
    if (IN(5)) { PH(); SchedDense S; S.init(pOG, DS, ws + WS_WS5OUT, DS, M / 256, D / 256, G, cid); EpiResB E{args.in[0], pHB, pSS};
        if (cls == 0) { moe_conv(F, args, ws, 0, 2, 3); __syncthreads(); } pg8::gemm_phase<EpiResB, SchedDense, true>(F.lds + RING_OFF, F.tid, DS, DS, DS, S, E); if (cls == 1) { __syncthreads(); moe_conv(F, args, ws, 0, 2, 3); } if (BOTH(5)) GRID_BAR(); }

    {
        constexpr int pR = 6;
        unsigned* const cnt = (unsigned*)(F.ctl + CW_CNT) + 0;
        if (IN(pR)) { PH(); RowArgs A{}; A.Hin = pHB; A.gain = args.in[14]; A.HN = pHN; A.Wsk = (const bf16*)(ws + WS_WR) + (size_t)0 * (256 * 1024); A.b0 = args.in[16]; A.b1 = args.in[18];
            A.cnt = cnt; A.tokl = pTOKL; A.pw = pPW; A.SS = pSS; A.RSTD = pRSTD; A.tokw = (float*)(ws + WS_TOKW); A.tokr = (float*)(ws + WS_TOKR);
            row_phase<1>(F, A); if (BOTH(pR)) GRID_BAR(); }
        if (IN(pR + 1)) { PH(); const MoeTab tab = moe_tables(F, cnt);
            const int nwg_ = tab.T * 4, R_ = (nwg_ + G - 1) / G, Gp = (nwg_ + R_ - 1) / R_, nfree = G - Gp;
            constexpr int IPW = 64;
            const int npre_ = nfree * NWAVES * IPW < CONV_TOTAL_MOE ? nfree * NWAVES * IPW : CONV_TOTAL_MOE;
            if (cid == 0 && F.tid == 0) __hip_atomic_store(F.ctl + CW_NPRE, (unsigned)npre_, RLX_AGENT);
            if (cid < Gp) {
            SchedMoeGU S; S.T.init(tab.T, 4, Gp, cid); S.tab = tab; S.HN = (const char*)pHB; S.W = (const char*)(ws + WS_WGU) + (size_t)0 * NE * 1024 * D * 2; S.tokl = pTOKL; S.tid = F.tid;
            EpiGU E{pHID, tab, (const float*)(ws + WS_TOKR)};
            pg8::gemm_phase<EpiGU, SchedMoeGU, true>(F.lds + RING_OFF, F.tid, D, D, D, S, E);
            } else { conv_range<1>(F, args, ws, 0, npre_, (cid - Gp) * NWAVES + F.wave, nfree * NWAVES); }
            if (BOTH(pR + 1)) GRID_BAR(); }
        if (IN(pR + 2)) { PH(); const MoeTab tab = moe_tables(F, cnt);
            SchedMoeDN S; S.T.init(tab.T, 8, G, cid); S.T.split = 1;   S.tab = tab; S.HID = (const char*)pHID; S.W = (const char*)(ws + WS_WDN) + (size_t)0 * NE * D * DE * 2;
            EpiDN E{tab, pTOKL, (const float*)(ws + WS_TOKW), pYP};
            pg8::gemm_phase<EpiDN, SchedMoeDN, true>(F.lds + RING_OFF, F.tid, DE, DE, DE, S, E); if (BOTH(pR + 2)) GRID_BAR(); }
        }
    {
            if (IN(9)) { PH(); RowArgs A{}; A.Hin = pHB; A.YP = pYP; A.gain = args.in[22]; A.HN = pHN; A.Wsk = (const bf16*)(ws + WS_WF); A.b0 = args.in[24]; A.LF = (float*)(ws + WS_LF);
                row_phase<2>(F, A); if (BOTH(9)) GRID_BAR(); }
            if (IN(10)) { { PH(); cumsum_phase(F, (const float*)(ws + WS_LF), (float*)(ws + WS_CUMB)); }
#pragma unroll 1
                for (int seg = 0; seg < 2; ++seg) { PH();
                    const int split_ = 2 * (int)((blockIdx.x >> 3) & 3);
                    SchedDense S; S.init(pHN, D, ws + WS_WFOXIN, D, M / 256, 4 * D / 256, G, cid); EpiQKVG E{(bf16*)(ws + WS_Q), (size_t)(WS_K - WS_Q) / 2};
                    S.i_begin = seg ? split_ : 0; S.i_end = seg ? (1 << 30) : split_;
                    pg8::gemm_phase<EpiQKVG, SchedDense, true>(F.lds + RING_OFF, F.tid, D, D, D, S, E);
                    if (seg == 0) { asm volatile("s_waitcnt vmcnt(0)" ::: "memory"); __syncthreads();
                        const int npre_ = (int)__hip_atomic_load(F.ctl + CW_NPRE, RLX_AGENT), gw_ = F.vcu * NWAVES + F.wave;
                        conv_range<1>(F, args, ws, npre_, npre_ + (CONV_TOTAL_MOE - npre_) / 2, gw_, G * NWAVES); __syncthreads(); } }
                if (BOTH(10)) GRID_BAR(); }
            if (IN(11)) { PH(); static_assert(WS_V - WS_K == fox::VK_DELTA, "V = K + 64 MiB");
                const fox::Tens T{(const bf16*)(ws + WS_Q), (const bf16*)(ws + WS_K), (bf16*)(ws + WS_Q), (const bf16*)(ws + WS_SG), (const float*)(ws + WS_CUMB)};
                const int npre_ = (int)__hip_atomic_load(F.ctl + CW_NPRE, RLX_AGENT), gw_ = F.vcu * NWAVES + F.wave, mid_ = npre_ + (CONV_TOTAL_MOE - npre_) / 2;
                if (cls == 0) { conv_range<1>(F, args, ws, mid_, CONV_TOTAL_MOE, gw_, G * NWAVES); __syncthreads(); }
                fox::fox_phase((char*)lds + RING_OFF, T, G, cid, F.tid);
                if (cls == 1) { asm volatile("s_waitcnt vmcnt(0)" ::: "memory"); __syncthreads(); conv_range<1>(F, args, ws, mid_, CONV_TOTAL_MOE, gw_, G * NWAVES); }
                if (BOTH(11)) GRID_BAR(); }
            if (IN(12)) { PH(); SchedDense S; S.init(ws + WS_Q, D, ws + WS_WFOXOUT, D, M / 256, D / 256, G, cid); EpiResYPB E{pHB, pYP, pSS};
                pg8::gemm_phase<EpiResYPB, SchedDense, true>(F.lds + RING_OFF, F.tid, D, D, D, S, E); if (BOTH(12)) GRID_BAR(); }
            }
    {
        constexpr int pR = 13;
        unsigned* const cnt = (unsigned*)(F.ctl + CW_CNT) + 64;
        if (IN(pR)) { PH(); RowArgs A{}; A.Hin = pHB; A.gain = args.in[26]; A.HN = pHN; A.Wsk = (const bf16*)(ws + WS_WR) + (size_t)1 * (256 * 1024); A.b0 = args.in[28]; A.b1 = args.in[30];
            A.cnt = cnt; A.tokl = pTOKL; A.pw = pPW; A.SS = pSS; A.RSTD = pRSTD; A.tokw = (float*)(ws + WS_TOKW); A.tokr = (float*)(ws + WS_TOKR);
            row_phase<1>(F, A); if (BOTH(pR)) GRID_BAR(); }
        if (IN(pR + 1)) { PH(); const MoeTab tab = moe_tables(F, cnt);
            SchedMoeGU S; S.T.init(tab.T, 4, G, cid); S.T.split = 1;   S.tab = tab; S.HN = (const char*)pHB; S.W = (const char*)(ws + WS_WGU) + (size_t)1 * NE * 1024 * D * 2; S.tokl = pTOKL; S.tid = F.tid;
            EpiGU E{pHID, tab, (const float*)(ws + WS_TOKR)};
            pg8::gemm_phase<EpiGU, SchedMoeGU, true>(F.lds + RING_OFF, F.tid, D, D, D, S, E); if (BOTH(pR + 1)) GRID_BAR(); }
        if (IN(pR + 2)) { PH(); const MoeTab tab = moe_tables(F, cnt);
            SchedMoeDN S; S.T.init(tab.T, 8, G, cid); S.T.split = 1;   S.tab = tab; S.HID = (const char*)pHID; S.W = (const char*)(ws + WS_WDN) + (size_t)1 * NE * D * DE * 2;
            EpiDN E{tab, pTOKL, (const float*)(ws + WS_TOKW), pYP};
            pg8::gemm_phase<EpiDN, SchedMoeDN, true>(F.lds + RING_OFF, F.tid, DE, DE, DE, S, E); if (BOTH(pR + 2)) GRID_BAR(); }
        }
    if (IN(16)) { PH(); RowArgs A{}; A.Hin = pHB; A.YP = pYP; A.gain = args.in[34]; A.out = args.out; row_phase<3>(F, A); }
#undef IN
#undef BOTH
#undef GRID_BAR
#undef PH
#undef pHN
#undef pUA
#undef pGL
#undef pOG
#undef pH2
#undef pHB
#undef pYP
#undef pHID
#undef pTOKL
#undef pPW
#undef pSS
#undef pRSTD
}

extern "C" void kernel_launch(void* const* d_in, const int* in_sizes, int n_in, void* d_out, int out_size, void* d_ws, size_t ws_size, hipStream_t stream) {
    static int grid = 0;
    if (grid == 0) {
        if (n_in != 35 || in_sizes[0] != M * D || out_size != M * D || ws_size < WS_END) { fprintf(stderr, "kernel_launch: shape/workspace mismatch (n_in %d in0 %d out %d ws %zu need %zu)\n", n_in, n_in > 0 ? in_sizes[0] : -1, out_size, ws_size, (size_t)WS_END); grid = -1; return; }
        int dev = 0, cus = 0, per_cu = 0;
        if (hipGetDevice(&dev) != hipSuccess || hipDeviceGetAttribute(&cus, hipDeviceAttributeMultiprocessorCount, dev) != hipSuccess) { grid = -1; return; }
        if (hipFuncSetAttribute((const void*)hybrid_fwd, hipFuncAttributeMaxDynamicSharedMemorySize, LDS_BYTES) != hipSuccess) { fprintf(stderr, "kernel_launch: hipFuncSetAttribute failed\n"); grid = -1; return; }
        if (hipOccupancyMaxActiveBlocksPerMultiprocessor(&per_cu, (const void*)hybrid_fwd, NWAVES * 64, LDS_BYTES) != hipSuccess || per_cu < 1)
            fprintf(stderr, "kernel_launch: occupancy query reports %d workgroups per CU\n", per_cu);
        (void)hipGetLastError();
        grid = cus;
    }
    if (grid < 0) return;
    if (hipMemsetAsync((char*)d_ws + WS_CTL, 0, CTL_ZERO_BYTES, stream) != hipSuccess) return;
    Args a{};
    for (int i = 0; i < 35; ++i) a.in[i] = (const float*)d_in[i];
    a.out = (float*)d_out; a.ws = (unsigned char*)d_ws;
#if MK_PER_PHASE
    for (int p = 0; p < NPHASE; ++p) { a.ph_lo = p; a.ph_hi = p + 1; hipLaunchKernelGGL(hybrid_fwd, dim3(grid), dim3(NWAVES * 64), LDS_BYTES, stream, a); }
#else
    a.ph_lo = 0; a.ph_hi = NPHASE;
    hipLaunchKernelGGL(hybrid_fwd, dim3(grid), dim3(NWAVES * 64), LDS_BYTES, stream, a);
#endif
    const hipError_t le = hipPeekAtLastError();
    if (le != hipSuccess) fprintf(stderr, "kernel_launch: launch failed: %s\n", hipGetErrorName(le));
}
```

```cpp
#include <hip/hip_runtime.h>
#include <cstdio>
#include <cstdint>

namespace pg8 {
#define PG8_LAS __attribute__((address_space(3)))
typedef unsigned short bf16_t;
typedef short bf16x8 __attribute__((ext_vector_type(8)));
typedef float f32x4 __attribute__((ext_vector_type(4)));
typedef float f32x2 __attribute__((ext_vector_type(2)));
typedef unsigned u32x4 __attribute__((ext_vector_type(4)));
constexpr int BM = 256, BK = 64, HALF = 128, HTB = HALF * BK * 2  , STAGE_BYTES = 8 * HTB, NXCD = 8, WGM = 8;

__host__ __device__ __forceinline__ int lds_byte(int r, int c) { const int st = (r >> 4) * 2 + (c >> 5), rr = r & 15, cc = c & 31, ob = rr * 64 + cc * 2; return st * 1024 + (ob ^ (((ob >> 9) & 1) << 5)); }
__host__ __device__ __forceinline__ void stage_rc(int b, int& R, int& C) { const int st = b / 1024, sb = b % 1024, swz = sb ^ (((sb >> 9) & 1) << 5); R = (st >> 1) * 16 + swz / 64; C = (st & 1) * 32 + (swz % 64) / 2; }
__host__ __device__ __forceinline__ int perm32(int rho) { const int n = rho >> 4, i = rho & 15; return 8 * (i >> 2) + 4 * n + (i & 3); }

struct Unit { int pm, pn, half; };
struct UPtr { const char* A; const char* B; };

struct TileOrder {
    int nM, nN, nwg, G, c;
    __device__ __forceinline__ void init(int nM_, int nN_, int G_, int c_) { nM = nM_; nN = nN_; nwg = nM * nN; G = G_; c = c_; split = 0; }
    int split;
    __device__ __forceinline__ bool next(int i, Unit& u) const {
        if (split) { const int full = (nwg / G) * G, rem = nwg - full;
            if (rem > 0 && 2 * rem <= G && i == nwg / G) { if (c >= 2 * rem) return false; Unit t; const bool ok = next_lin((long)full + (c >> 1), t); u = t; u.half = c & 1; return ok; } }
        return next_lin((long)i * G + c, u);
    }
    __device__ __forceinline__ bool next_lin(const long L, Unit& u) const {
        if (L >= nwg) return false;
        int wgid = (int)L; { const int q = nwg / NXCD, r = nwg % NXCD, xcd = wgid % NXCD, off = wgid / NXCD; wgid = (xcd < r ? xcd * (q + 1) : r * (q + 1) + (xcd - r) * q) + off; }
        const int nig = WGM * nN, gid = wgid / nig, fm = gid * WGM, gsz = (nM - fm) < WGM ? (nM - fm) : WGM;
        u.pm = fm + ((wgid % nig) % gsz); u.pn = (wgid % nig) / gsz; u.half = -1; return true;
    }
};

__device__ __forceinline__ unsigned cvt_pk_bf16(float lo, float hi) { unsigned r; asm volatile("v_cvt_pk_bf16_f32 %0, %1, %2" : "=v"(r) : "v"(lo), "v"(hi)); return r; }
__device__ __forceinline__ float bf_lo(unsigned w) { return __uint_as_float(w << 16); }
__device__ __forceinline__ float bf_hi(unsigned w) { return __uint_as_float(w & 0xffff0000u); }

template <class Epi, class Sched, bool ALIGN_EPI>
__device__ __forceinline__ void gemm_phase(PG8_LAS unsigned char* lds, const int tid, const int K, const int lda, const int ldb, const Sched& S, const Epi& E) {
    const int wid = __builtin_amdgcn_readfirstlane(tid >> 6), lane = tid & 63, wr = wid >> 2, wc = wid & 3, fr = lane & 15, fq = lane >> 4;
    const int nt = K / BK;
    unsigned voffB[2], offC[2][2], offN[2][2];
    const unsigned hstepA = (unsigned)HALF * (unsigned)lda * 2u;
    const size_t hstepB = (size_t)HALF * ldb * 2;
#pragma unroll
    for (int i = 0; i < 2; ++i) { int R, C; stage_rc(tid * 16 + i * 8192, R, C); const int Rb = Epi::PERM ? ((R & ~31) + perm32(R & 31)) : R;
        offC[0][i] = (unsigned)(R * lda + C) * 2u; offC[1][i] = offC[0][i] + hstepA; voffB[i] = (unsigned)(Rb * ldb + C) * 2u; }
    const size_t kstep = (size_t)(BK * 2);
    const unsigned ldsw = (unsigned)wid * 1024u;
    const int aoff = lds_byte(wr * 64 + fr, fq * 8), boff = lds_byte(wc * 32 + fr, fq * 8);
#define PG8_SA(b, h) (((b) * 2 + (h)) * HTB)
#define PG8_SB(b, h) ((4 + (b) * 2 + (h)) * HTB)
#define PG8_STAGEB(bufoff, gbase) do { _Pragma("unroll") for (int _i = 0; _i < 2; ++_i) \
        __builtin_amdgcn_global_load_lds((const unsigned*)((const char*)(gbase) + voffB[_i]), (PG8_LAS unsigned*)(lds + (bufoff) + ldsw + _i * 8192), 16, 0, 0); } while (0)
#define PG8_STAGEA(bufoff, gbase, O, h) do { _Pragma("unroll") for (int _i = 0; _i < 2; ++_i) \
        __builtin_amdgcn_global_load_lds((const unsigned*)((const char*)(gbase) + (Sched::GATHER ? (size_t)0 : (size_t)(h) * hstepA) + (O)[Sched::GATHER ? (h) : 0][_i]), (PG8_LAS unsigned*)(lds + (bufoff) + ldsw + _i * 8192), 16, 0, 0); } while (0)
#define PG8_LDA(dst, b, h) do { _Pragma("unroll") for (int m = 0; m < 4; ++m) _Pragma("unroll") for (int k = 0; k < 2; ++k) dst[m][k] = *(const PG8_LAS bf16x8*)(lds + PG8_SA(b, h) + aoff + m * 2048 + k * 1024); } while (0)
#define PG8_LDB(dst, b, h) do { _Pragma("unroll") for (int n = 0; n < 2; ++n) _Pragma("unroll") for (int k = 0; k < 2; ++k) dst[n][k] = *(const PG8_LAS bf16x8*)(lds + PG8_SB(b, h) + boff + n * 2048 + k * 1024); } while (0)
#define PG8_MMA(ai, bj, At, Bt) do { __builtin_amdgcn_s_setprio(1); _Pragma("unroll") for (int m = 0; m < 4; ++m) _Pragma("unroll") for (int n = 0; n < 2; ++n) _Pragma("unroll") for (int k = 0; k < 2; ++k) \
        acc[ai][bj][m][n] = __builtin_amdgcn_mfma_f32_16x16x32_bf16(Bt[n][k], At[m][k], acc[ai][bj][m][n], 0, 0, 0); __builtin_amdgcn_s_setprio(0); } while (0)
#define PG8_WAIT_V(n) asm volatile("s_waitcnt vmcnt(" #n ")" ::: "memory")
#define PG8_WAIT_L(n) asm volatile("s_waitcnt lgkmcnt(" #n ")" ::: "memory")
#define PG8_BAR __builtin_amdgcn_s_barrier()
#define PG8_SCHED __builtin_amdgcn_sched_barrier(0)
    Unit cur, nxt; int ui = 0;
    if (!S.next(0, cur)) return;
    f32x4 acc[2][2][4][2];
#pragma unroll
    for (int a = 0; a < 2; ++a)
#pragma unroll
        for (int b = 0; b < 2; ++b)
#pragma unroll
            for (int m = 0; m < 4; ++m)
#pragma unroll
                for (int n = 0; n < 2; ++n) acc[a][b][m][n] = (f32x4){0.f, 0.f, 0.f, 0.f};
    bf16x8 At[4][2], B0[2][2], B1[2][2];
    UPtr cp = S.ptrs(cur);
    const char* cA = cp.A; const char* cB = cp.B;
    if constexpr (Sched::GATHER) { S.gather(cur, offC); }
    bool act0 = true, act1 = true;
    if constexpr (Sched::ROWSKIP) { const int v = S.valid(cur); act0 = wr * 64 < v && cur.half != 1; act1 = HALF + wr * 64 < v && cur.half != 0; }
#pragma unroll
    for (int h = 0; h < 2; ++h)
#pragma unroll
        for (int i = 0; i < 2; ++i) offN[h][i] = offC[h][i];
    PG8_STAGEB(PG8_SB(0, 0), cB); PG8_STAGEB(PG8_SB(0, 1), cB + hstepB); PG8_STAGEA(PG8_SA(0, 0), cA, offC, 0); PG8_STAGEA(PG8_SA(0, 1), cA, offC, 1);
    if (wr == 1) PG8_BAR;
    PG8_WAIT_V(2); PG8_BAR;
    PG8_STAGEB(PG8_SB(1, 0), cB + kstep); PG8_STAGEA(PG8_SA(1, 0), cA + kstep, offC, 0); PG8_STAGEB(PG8_SB(1, 1), cB + hstepB + kstep);
    PG8_WAIT_V(6); PG8_BAR;
    for (;;) {
        const bool has_next = S.next(ui + 1, nxt);
        const char* nA = cA; const char* nB = cB;
        if (has_next) { const UPtr np = S.ptrs(nxt); nA = np.A; nB = np.B; if constexpr (Sched::GATHER) { S.gather(nxt, offN); } }
        for (int t = 0; t < nt; t += 2) {
            const bool last = (t == nt - 2);
            const char* a1 = cA + (size_t)(t + 1) * kstep;
            const char* a2 = last ? nA : cA + (size_t)(t + 2) * kstep; const char* b2 = last ? nB : cB + (size_t)(t + 2) * kstep;
            const char* a3 = a2 + kstep; const char* b3 = b2 + kstep;
            unsigned o2[2][2];
#pragma unroll
            for (int h = 0; h < 2; ++h)
#pragma unroll
                for (int i = 0; i < 2; ++i) o2[h][i] = (Sched::GATHER && last) ? offN[h][i] : offC[h][i];
            PG8_LDB(B0, 0, 0); PG8_LDB(B1, 0, 1); PG8_SCHED; if (act0) PG8_LDA(At, 0, 0); PG8_STAGEA(PG8_SA(1, 1), a1, offC, 1);
            PG8_WAIT_V(8); PG8_WAIT_L(0); PG8_BAR; if (act0) { PG8_MMA(0, 0, At, B0); PG8_MMA(0, 1, At, B1); } PG8_BAR; PG8_SCHED;
            if (act1) PG8_LDA(At, 0, 1); PG8_STAGEB(PG8_SB(0, 0), b2); PG8_STAGEB(PG8_SB(0, 1), b2 + hstepB); PG8_STAGEA(PG8_SA(0, 0), a2, o2, 0);
            PG8_WAIT_V(8); PG8_WAIT_L(0); PG8_BAR; if (act1) { PG8_MMA(1, 0, At, B0); PG8_MMA(1, 1, At, B1); } PG8_BAR; PG8_SCHED;
            PG8_LDB(B0, 1, 0); PG8_LDB(B1, 1, 1); PG8_SCHED; if (act0) PG8_LDA(At, 1, 0); PG8_STAGEA(PG8_SA(0, 1), a2, o2, 1);
            PG8_WAIT_V(8); PG8_WAIT_L(0); PG8_BAR; if (act0) { PG8_MMA(0, 0, At, B0); PG8_MMA(0, 1, At, B1); } PG8_BAR; PG8_SCHED;
            if (act1) PG8_LDA(At, 1, 1); PG8_STAGEB(PG8_SB(1, 0), b3); PG8_STAGEB(PG8_SB(1, 1), b3 + hstepB); PG8_STAGEA(PG8_SA(1, 0), a3, o2, 0);
            PG8_WAIT_V(8); PG8_WAIT_L(0); PG8_BAR; if (act1) { PG8_MMA(1, 0, At, B0); PG8_MMA(1, 1, At, B1); } PG8_BAR; PG8_SCHED;
        }
        if constexpr (ALIGN_EPI) { if (wr == 0) PG8_BAR; }
        if constexpr (!Epi::AFTER_DRAIN) { E(acc, cur, wr, wc, fr, fq); }
        if (!has_next) break;
#pragma unroll
        for (int a = 0; a < 2; ++a)
#pragma unroll
            for (int b = 0; b < 2; ++b)
#pragma unroll
                for (int m = 0; m < 4; ++m)
#pragma unroll
                    for (int n = 0; n < 2; ++n) acc[a][b][m][n] = (f32x4){0.f, 0.f, 0.f, 0.f};
        cur = nxt; cA = nA; cB = nB; ++ui;
        if constexpr (Sched::ROWSKIP) { const int v = S.valid(cur); act0 = wr * 64 < v && cur.half != 1; act1 = HALF + wr * 64 < v && cur.half != 0; }
        if constexpr (Sched::GATHER) {
#pragma unroll
            for (int h = 0; h < 2; ++h)
#pragma unroll
                for (int i = 0; i < 2; ++i) offC[h][i] = offN[h][i];
        }
        if constexpr (ALIGN_EPI) { if (wr == 1) PG8_BAR; }
    }
    PG8_WAIT_V(0);
    if constexpr (!ALIGN_EPI) { if (wr == 0) PG8_BAR; }
    PG8_BAR;
    if constexpr (Epi::AFTER_DRAIN) { E.fused(acc, cur, wr, wc, fr, fq, lds, wid, lane); }
#undef PG8_SA
#undef PG8_SB
#undef PG8_STAGEA
#undef PG8_STAGEB
#undef PG8_LDA
#undef PG8_LDB
#undef PG8_MMA
#undef PG8_WAIT_V
#undef PG8_WAIT_L
#undef PG8_BAR
#undef PG8_SCHED
}
}

constexpr int NWAVES = 8;
constexpr int NB = 8, SEQ = 2048, D = 2048, M = NB * SEQ;
constexpr int DS = 1024, NG = 64, GC = 16, NST = 64;
constexpr int LCH = 32, NCH = SEQ / LCH;
constexpr int KP = LCH * GC + 2 * NST;
constexpr int NH = 16, HD = 128;
constexpr int NE = 64, DE = 512, NEG = 8, EPG = 8;
constexpr int FOXN = 4 * D + NH;
constexpr float RMS_EPS = 1e-6f;
constexpr int RT_ROWS = 96;
constexpr int MAXMT = 192;

constexpr size_t MiB = 1u << 20;
constexpr size_t WS_CTL = 0, CTL_ZERO_BYTES = 1 * MiB;
constexpr size_t WS_WS5IN  = 1 * MiB;
constexpr size_t WS_WGLU   = WS_WS5IN + 4 * MiB;
constexpr size_t WS_WS5OUT = WS_WGLU + 2 * MiB;
constexpr size_t WS_WFOXIN = WS_WS5OUT + 4 * MiB;
constexpr size_t WS_WFOXOUT = WS_WFOXIN + 32 * MiB;
constexpr size_t WS_WR     = WS_WFOXOUT + 8 * MiB;
constexpr size_t WS_WF     = WS_WR + 1 * MiB;
constexpr size_t WS_AL     = WS_WF + 512 * 1024;
constexpr size_t WS_LF     = WS_AL + 512 * 1024;
constexpr size_t WS_CUMB   = WS_LF + 1 * MiB;
constexpr size_t WS_PW     = WS_CUMB + 1 * MiB;
constexpr size_t WS_TOKL   = WS_PW + 1 * MiB;
constexpr size_t WS_SS     = 60 * MiB;
constexpr size_t WS_RSTD   = 62 * MiB;
constexpr size_t WS_WGU    = 64 * MiB;
constexpr size_t WS_WDN    = WS_WGU + 512 * MiB;
constexpr size_t WS_HN     = WS_WDN + 256 * MiB;
constexpr size_t WS_H2     = WS_HN + 64 * MiB;
constexpr size_t WS_Q      = WS_H2 + 128 * MiB;
constexpr size_t WS_K      = WS_Q + 64 * MiB, WS_V = WS_K + 64 * MiB, WS_SG = WS_V + 64 * MiB;
constexpr size_t WS_R1     = WS_SG + 64 * MiB;
constexpr size_t WS_TT     = WS_R1;
constexpr size_t WS_PT     = WS_TT + 40 * MiB;
constexpr size_t WS_UA     = WS_PT + 16 * MiB;
constexpr size_t WS_GL     = WS_UA + 40 * MiB;
constexpr size_t WS_OG     = WS_GL + 32 * MiB;
constexpr size_t WS_YP     = WS_R1;
constexpr size_t WS_HID    = WS_YP + 128 * MiB;
constexpr size_t WS_TOKW   = WS_R1 + 176 * MiB;
constexpr size_t WS_TOKR   = WS_TOKW + 4 * MiB;
constexpr size_t WS_END    = WS_TOKR + 4 * MiB;
static_assert(WS_TOKL + 4 * MiB <= WS_WGU && WS_OG + 32 * MiB <= WS_END && WS_HID + 48 * MiB <= WS_END, "d_ws map");
constexpr int CW_TMO = 0, CW_CODE = 1, CW_NPRE = 8;
constexpr int CW_BAR = 4096;
constexpr int CW_CNT = 16384;

constexpr int RING_OFF = 0, RING_BYTES = 131072;
constexpr int LDSCTL_OFF = 151552, MISC_OFF = LDSCTL_OFF + 320;
constexpr int MOE_OFF = LDSCTL_OFF + 512;
constexpr int LDS_BYTES = 155648;
static_assert(MOE_OFF + (64 * 3 + 4 + 2 * MAXMT) * 4 <= LDS_BYTES, "LDS map");

#define GAS __attribute__((address_space(1)))
#define LAS __attribute__((address_space(3)))
typedef unsigned short bf16;
typedef unsigned v4u __attribute__((ext_vector_type(4)));
typedef unsigned v2u __attribute__((ext_vector_type(2)));
typedef float f32x4 __attribute__((ext_vector_type(4)));
typedef float f32x16 __attribute__((ext_vector_type(16)));
typedef short bf16x8 __attribute__((ext_vector_type(8)));
typedef GAS unsigned gu32;
#define RLX_AGENT __ATOMIC_RELAXED, __HIP_MEMORY_SCOPE_AGENT
#define LDS_WAIT() asm volatile("s_waitcnt lgkmcnt(0)" ::: "memory")
#define VM_WAIT() asm volatile("s_waitcnt vmcnt(0)" ::: "memory")
__device__ __forceinline__ unsigned f2bf(float f) { unsigned u = __builtin_bit_cast(unsigned, f); return (u + 0x7fffu + ((u >> 16) & 1u)) >> 16; }
__device__ __forceinline__ unsigned pk2(float lo, float hi) { return pg8::cvt_pk_bf16(lo, hi); }

#define XB_TMO      128
#define XB_XCNT(j)  (256  + 64 * (j))
#define XB_XSUB(j)  (1280 + 64 * (j))
#define XB_XGEN(j)  (2304 + 64 * (j))
#define XB_TOP      3328
#define XB_TOPGEN   3392
#define XCD_BAR_WORDS 3456
#define XB_SPIN_CAP (1u << 18)

__device__ __forceinline__ unsigned xb_ld(unsigned* p)              { return __hip_atomic_load(p, __ATOMIC_RELAXED, __HIP_MEMORY_SCOPE_AGENT); }
__device__ __forceinline__ unsigned xb_add(unsigned* p, unsigned v) { return __hip_atomic_fetch_add(p, v, __ATOMIC_RELAXED, __HIP_MEMORY_SCOPE_AGENT); }
__device__ __forceinline__ unsigned xb_xcc_id() { return (unsigned)__builtin_amdgcn_s_getreg((3 << 11) | 20) & 0xFu; }
#define XB_SPIN(cond, bar) do { unsigned _sp = 0; while (cond) { __builtin_amdgcn_s_sleep(1); \
    if ((++_sp & 255u) == 0u) { if (xb_ld(&(bar)[XB_TMO])) break; if (_sp > XB_SPIN_CAP) { atomicAdd(&(bar)[XB_TMO], 1u); break; } } } } while (0)

struct XcdBarrier {
    unsigned* bar; unsigned x;
    volatile LAS unsigned* st;
};
__device__ __forceinline__ XcdBarrier xcd_barrier_post(unsigned* bar, volatile LAS unsigned* st) {
    XcdBarrier b; b.bar = bar; b.x = xb_xcc_id(); b.st = st;
    if (threadIdx.x == 0) (void)xb_add(&bar[XB_XCNT(b.x)], 1u);
    return b;
}
__device__ __forceinline__ void xcd_barrier_complete(unsigned* bar, unsigned x, unsigned& nloc, unsigned& nx) {
    const unsigned G = gridDim.x * gridDim.y * gridDim.z;
    unsigned sum, cnt, mine, sp = 0u;
    for (;;) {
        sum = 0u; cnt = 0u; mine = 0u;
#pragma unroll
        for (unsigned j = 0; j < 16; ++j) { const unsigned c = xb_ld(&bar[XB_XCNT(j)]); sum += c; cnt += (c > 0u) ? 1u : 0u; mine = (j == x) ? c : mine; }
        if (sum == G) break;
        __builtin_amdgcn_s_sleep(1);
        if ((++sp & 255u) == 0u) { if (xb_ld(&bar[XB_TMO])) break; if (sp > XB_SPIN_CAP) { atomicAdd(&bar[XB_TMO], 1u); break; } }
    }
    nloc = mine > 0u ? mine : 1u; nx = cnt > 0u ? cnt : 1u;
}
__device__ __forceinline__ void xcd_barrier(const XcdBarrier& b, const int tid) {
    asm volatile("s_waitcnt vmcnt(0)" ::: "memory");
    __syncthreads();
    if (tid == 0) {
        unsigned* bar = b.bar;
        const unsigned bx = xb_xcc_id();
        __builtin_amdgcn_s_waitcnt(0);
        unsigned nloc = b.st[0], nx = b.st[1];
        if (nloc == 0u) { xcd_barrier_complete(bar, bx, nloc, nx); b.st[0] = nloc; b.st[1] = nx; }
        const unsigned old = xb_add(&bar[XB_XSUB(bx)], 1u);
        const unsigned gen = old / nloc;
        if (old + 1u == (gen + 1u) * nloc) {
            __builtin_amdgcn_fence(__ATOMIC_RELEASE, "agent");
            asm volatile("s_waitcnt vmcnt(0)" ::: "memory");
            const unsigned og = xb_add(&bar[XB_TOP], 1u);
            const unsigned tg = og / nx;
            if (og + 1u == (tg + 1u) * nx) { xb_add(&bar[XB_TOPGEN], 1u); xb_add(&bar[XB_XGEN(bx)], 1u); __builtin_amdgcn_fence(__ATOMIC_ACQUIRE, "agent"); }
            else { __builtin_amdgcn_fence(__ATOMIC_ACQUIRE, "agent"); XB_SPIN(xb_ld(&bar[XB_TOPGEN]) == tg, bar); xb_add(&bar[XB_XGEN(bx)], 1u); }
            asm volatile("s_waitcnt vmcnt(0)" ::: "memory");
        } else {
            __builtin_amdgcn_fence(__ATOMIC_ACQUIRE, "agent");
            XB_SPIN(xb_ld(&bar[XB_XGEN(bx)]) == gen, bar);
            asm volatile("s_waitcnt vmcnt(0)" ::: "memory");
        }
    }
    __syncthreads();
}

struct Frame {
    LAS unsigned char* lds;
    volatile LAS unsigned* MISC;
    gu32* ctl;
    int tid, lane, wave;
    int vcu, G;
    unsigned char* ws;
};
__device__ __forceinline__ float wave_sum(float v) {
#pragma unroll
    for (int o = 1; o < 64; o <<= 1) v += __shfl_xor(v, o);
    return v;
}
__device__ __forceinline__ float sigmoidf_(float x) { return __builtin_amdgcn_rcpf(1.f + __builtin_amdgcn_exp2f(-1.4426950408889634f * x)); }
__device__ __forceinline__ float gelu_tanh_(float x) {
    const float u = x * (1.f + 0.044715f * x * x);
    return x * __builtin_amdgcn_rcpf(1.f + __builtin_amdgcn_exp2f(-2.302208198f * u));
}

struct Args { const float* in[35]; float* out; unsigned char* ws; int ph_lo, ph_hi; };

__device__ __forceinline__ void p0_transpose_item(const float* W, int K, int N, int k0, int n0, bf16* dst0, LAS float* scr, int lane) {
    const int cn = n0 + (lane & 31); const bool ok = cn < N;
    float ld[32];
    const GAS float* Wp = (const GAS float*)W + (size_t)(k0 + (lane >> 5)) * N + cn;
#pragma unroll
    for (int i = 0; i < 32; ++i) ld[i] = ok ? Wp[(size_t)(2 * i) * N] : 0.f;
#pragma unroll
    for (int i = 0; i < 32; ++i) scr[(2 * i + (lane >> 5)) * 33 + (lane & 31)] = ld[i];
    LDS_WAIT(); asm volatile("" ::: "memory");
    const int c = lane & 7;
#pragma unroll
    for (int j = 0; j < 4; ++j) { const int n = (lane >> 3) + 8 * j; const LAS float* s = scr + (8 * c) * 33 + n;
        v4u o; o.x = pk2(s[0 * 33], s[1 * 33]); o.y = pk2(s[2 * 33], s[3 * 33]); o.z = pk2(s[4 * 33], s[5 * 33]); o.w = pk2(s[6 * 33], s[7 * 33]);
        *(GAS v4u*)(dst0 + (size_t)n * K + k0 + 8 * c) = o; }
    LDS_WAIT(); asm volatile("" ::: "memory");
}
__device__ __forceinline__ void p0_router_item(const float* wg, const float* we, const float* gain, bf16* WR, int kb, int ng, int lane) {
    const int k = kb * 64 + lane; const float g = gain[k];
    const GAS f32x4* src = ng == 0 ? (const GAS f32x4*)(wg + (size_t)k * 8) : (const GAS f32x4*)(we + (size_t)k * 64 + (ng - 1) * 8);
    const f32x4 v0 = src[0], v1 = src[1];
    GAS bf16* dst = (GAS bf16*)WR + (size_t)(ng == 0 ? 0 : 8 + (ng - 1) * 8) * D + k;
    dst[0 * D] = (bf16)f2bf(g * v0.x); dst[1 * D] = (bf16)f2bf(g * v0.y); dst[2 * D] = (bf16)f2bf(g * v0.z); dst[3 * D] = (bf16)f2bf(g * v0.w);
    dst[4 * D] = (bf16)f2bf(g * v1.x); dst[5 * D] = (bf16)f2bf(g * v1.y); dst[6 * D] = (bf16)f2bf(g * v1.z); dst[7 * D] = (bf16)f2bf(g * v1.w);
    if (ng == 8) for (int n = 72; n < RT_ROWS; ++n) WR[(size_t)n * D + k] = (bf16)0;
}
struct S5P { const float *lre, *lim, *bre, *bim, *cre, *cim, *lstep; };
__device__ __forceinline__ void s5_cis(double th, float& c, float& s, float& sh) {
    const double k = __builtin_rint(th * 0.15915494309189535);
    const float r = (float)__builtin_fma(-k, 6.283185307179586, th);
    c = cosf(r); s = sinf(r); sh = sinf(0.5f * r);
}
__device__ __forceinline__ void s5_pow(const S5P& P, int g, int n, int m, float& pr, float& pi) {
    const float lr = P.lre[g * 64 + n], li = P.lim[g * 64 + n], step = expf(P.lstep[g]);
    float c, s, sh; s5_cis((double)m * ((double)li * (double)step), c, s, sh);
    const float mag = expf((float)m * (lr * step));
    pr = mag * c; pi = mag * s;
}
__device__ __forceinline__ void s5_zoh(const S5P& P, int g, int n, float& fr, float& fi) {
    const float lr = P.lre[g * 64 + n], li = P.lim[g * 64 + n], step = expf(P.lstep[g]);
    float c, s, sh; s5_cis((double)li * (double)step, c, s, sh);
    const float em1 = expm1f(lr * step), mag = em1 + 1.f;
    const float nr = em1 * c - 2.f * sh * sh, ni = mag * s;
    const float den = lr * lr + li * li;
    fr = (nr * lr + ni * li) / den; fi = (ni * lr - nr * li) / den;
}
__device__ __forceinline__ void s5_item_kernel(const S5P& P, bf16* TT, int g, int m, int lane) {
    float pr, pi, fr, fi; s5_pow(P, g, lane, m, pr, pi); s5_zoh(P, g, lane, fr, fi);
    const int co = lane >> 2, ci0 = (lane & 3) * 4;
    const float wr = pr * fr - pi * fi, wi = pr * fi + pi * fr;
    float a0 = 0.f, a1 = 0.f, a2 = 0.f, a3 = 0.f;
    const GAS float* crp = (const GAS float*)P.cre + (size_t)(g * 16 + co) * 64; const GAS float* cmp_ = (const GAS float*)P.cim + (size_t)(g * 16 + co) * 64;
    const GAS f32x4* brp = (const GAS f32x4*)(P.bre + (size_t)(g * 64) * 16 + ci0); const GAS f32x4* bip = (const GAS f32x4*)(P.bim + (size_t)(g * 64) * 16 + ci0);
#pragma unroll 8
    for (int n = 0; n < 64; ++n) {
        const float wrn = __shfl(wr, n), win = __shfl(wi, n);
        const f32x4 br = brp[4 * n], bi = bip[4 * n];
        const float cr = crp[n], cm = cmp_[n];
        const float dr = cr * wrn - cm * win, di = cr * win + cm * wrn;
        a0 += dr * br.x - di * bi.x;
        a1 += dr * br.y - di * bi.y;
        a2 += dr * br.z - di * bi.z;
        a3 += dr * br.w - di * bi.w;
    }
    v2u w; w.x = pk2(a0, a1); w.y = pk2(a2, a3); const v2u z = {0u, 0u};
    bf16* Tg = TT + (size_t)g * 512 * KP;
    for (int j = 0; j + m < LCH; ++j) {
        *(GAS v2u*)(Tg + (size_t)((j + m) * 16 + co) * KP + j * 16 + ci0) = w;
        if (m >= 1) *(GAS v2u*)(Tg + (size_t)(j * 16 + co) * KP + (j + m) * 16 + ci0) = z;
    }
}
__device__ __forceinline__ void s5_item_state(const S5P& P, bf16* TT, int g, int i, int lane) {
    float pr, pi; s5_pow(P, g, lane, i + 1, pr, pi);
    bf16* Tg = TT + (size_t)g * 512 * KP;
#pragma unroll
    for (int co = 0; co < 16; ++co) {
        const float cr = P.cre[(size_t)(g * 16 + co) * 64 + lane], cm = P.cim[(size_t)(g * 16 + co) * 64 + lane];
        const float car = cr * pr - cm * pi, cai = cr * pi + cm * pr;
        *(GAS unsigned*)(Tg + (size_t)(i * 16 + co) * KP + 512 + 2 * lane) = pk2(car, -cai);
    }
}
__device__ __forceinline__ void s5_item_p(const S5P& P, bf16* PT, float* AL, int g, int j, int lane) {
    const int n = lane;
    float qr, qi, fr, fi; s5_pow(P, g, n, LCH - 1 - j, qr, qi); s5_zoh(P, g, n, fr, fi);
    bf16* Pg = PT + (size_t)g * 256 * 512;
#pragma unroll
    for (int h = 0; h < 2; ++h) {
        float re[8], im[8];
#pragma unroll
        for (int q = 0; q < 2; ++q) { const f32x4 br = *(const f32x4*)(P.bre + (size_t)(g * 64 + n) * 16 + h * 8 + q * 4), bi = *(const f32x4*)(P.bim + (size_t)(g * 64 + n) * 16 + h * 8 + q * 4);
#pragma unroll
            for (int e = 0; e < 4; ++e) { const float bbr = fr * br[e] - fi * bi[e], bbi = fr * bi[e] + fi * br[e]; re[q * 4 + e] = qr * bbr - qi * bbi; im[q * 4 + e] = qr * bbi + qi * bbr; } }
        v4u wr_, wi_; wr_.x = pk2(re[0], re[1]); wr_.y = pk2(re[2], re[3]); wr_.z = pk2(re[4], re[5]); wr_.w = pk2(re[6], re[7]);
        wi_.x = pk2(im[0], im[1]); wi_.y = pk2(im[2], im[3]); wi_.z = pk2(im[4], im[5]); wi_.w = pk2(im[6], im[7]);
        const v4u z = {0u, 0u, 0u, 0u};
        *(GAS v4u*)(Pg + (size_t)(2 * n) * 512 + j * 16 + h * 8) = wr_;
        *(GAS v4u*)(Pg + (size_t)(2 * n + 1) * 512 + j * 16 + h * 8) = wi_;
        *(GAS v4u*)(Pg + (size_t)(128 + 2 * n) * 512 + j * 16 + h * 8) = z;
        *(GAS v4u*)(Pg + (size_t)(129 + 2 * n) * 512 + j * 16 + h * 8) = z;
    }
    if (j == 0) { float ar, ai; s5_pow(P, g, n, LCH, ar, ai); AL[(g * 64 + n) * 2] = ar; AL[(g * 64 + n) * 2 + 1] = ai; }
}
__device__ __forceinline__ void rms_row_to_bf16(const float* xrow, const float* gain, bf16* orow, int lane) {
    const GAS f32x4* xr = (const GAS f32x4*)xrow + lane; const GAS f32x4* gr = (const GAS f32x4*)gain + lane;
    f32x4 v[8]; float s = 0.f;
#pragma unroll
    for (int j = 0; j < 8; ++j) { v[j] = xr[64 * j]; s += (v[j].x * v[j].x + v[j].y * v[j].y) + (v[j].z * v[j].z + v[j].w * v[j].w); }
    const float rstd = 1.f / sqrtf(wave_sum(s) * (1.f / D) + RMS_EPS);
    GAS v2u* o8 = (GAS v2u*)orow + lane;
#pragma unroll
    for (int j = 0; j < 8; ++j) { const f32x4 g = gr[64 * j]; v2u w; w.x = pk2(v[j].x * rstd * g.x, v[j].y * rstd * g.y); w.y = pk2(v[j].z * rstd * g.z, v[j].w * rstd * g.w); o8[64 * j] = w; }
}

__device__ __forceinline__ void p0_prologue(Frame& F, const Args& a, unsigned char* ws) {
    LAS float* scr = (LAS float*)(F.lds + RING_OFF + F.wave * 16384);
    const int gw = F.vcu * NWAVES + F.wave, NGW = F.G * NWAVES;
    const S5P P{a.in[3], a.in[4], a.in[5], a.in[6], a.in[7], a.in[8], a.in[10]};
    bf16* TT = (bf16*)(ws + WS_TT); bf16* PT = (bf16*)(ws + WS_PT); float* AL = (float*)(ws + WS_AL);
    for (int it = gw; it < 3 * NG * LCH; it += NGW) {
        const int kind = it / (NG * LCH), r = it % (NG * LCH), g = r / LCH, m = r % LCH;
        if (kind == 0) s5_item_kernel(P, TT, g, m, F.lane);
        else if (kind == 1) s5_item_state(P, TT, g, m, F.lane);
        else s5_item_p(P, PT, AL, g, m, F.lane);
    }
    for (int it = gw; it < 2 * 32 * 9; it += NGW) { const int l = it / 288, r = it % 288, kb = r / 9, ng = r % 9;
        p0_router_item(a.in[l ? 27 : 15], a.in[l ? 29 : 17], a.in[l ? 26 : 14], (bf16*)(ws + WS_WR) + (size_t)l * (256 * 1024), kb, ng, F.lane); }
    constexpr int I_S5IN = 32 * 32, I_GLU = 16 * 32, I_S5OUT = 16 * 64, I_FOXIN = 32 * 257, I_FOXOUT = 32 * 64;
    constexpr int NITEMS = I_S5IN + I_GLU + I_S5OUT;
    for (int it = gw; it < NITEMS; it += NGW) {
        int r = it;
        if (r < I_S5IN) { const int kb = r / 32, nb = r % 32; p0_transpose_item(a.in[2], D, DS, kb * 64, nb * 32, (bf16*)(ws + WS_WS5IN) + (size_t)(nb * 32) * D, scr, F.lane); continue; } r -= I_S5IN;
        if (r < I_GLU) { const int kb = r / 32, nb = r % 32; p0_transpose_item(a.in[11], DS, DS, kb * 64, nb * 32, (bf16*)(ws + WS_WGLU) + (size_t)(nb * 32) * DS, scr, F.lane); continue; } r -= I_GLU;
        { const int kb = r / 64, nb = r % 64; p0_transpose_item(a.in[13], DS, D, kb * 64, nb * 32, (bf16*)(ws + WS_WS5OUT) + (size_t)(nb * 32) * DS, scr, F.lane); }
    }
    for (int m = gw; m < M; m += NGW) rms_row_to_bf16(a.in[0] + (size_t)m * D, a.in[1], (bf16*)(ws + WS_HN) + (size_t)m * D, F.lane);
}

struct ConvItem { const GAS float* Wp; bf16* dst0; const float* gain; int N, K, k0; bool ok, hasg; };
__device__ __forceinline__ ConvItem moe_conv_item(const Args& a, unsigned char* ws, const int l, int r, const int lane) {
    constexpr int I_EXP = 512;
    ConvItem it; it.gain = a.in[l ? 26 : 14];
    const int kind = r / (64 * I_EXP); it.hasg = kind < 2; r -= kind * (64 * I_EXP);
    const int e = r / I_EXP; r -= e * I_EXP;
    if (kind < 2) {
        const int kb = r / 16, nb = r % 16, n0 = nb * 32;
        it.N = DE; it.K = D; it.k0 = kb * 64;
        it.Wp = (const GAS float*)(a.in[(l ? 31 : 19) + kind] + (size_t)e * D * DE) + (size_t)(it.k0 + (lane >> 3)) * DE + n0 + 4 * (lane & 7);
        it.dst0 = (bf16*)(ws + WS_WGU) + ((size_t)l * NE * 1024 + (size_t)e * 1024 + (n0 >> 7) * 256 + kind * 128 + (n0 & 127)) * D;
    } else {
        const int kb = r / 64, nb = r % 64, n0 = nb * 32;
        it.N = D; it.K = DE; it.k0 = kb * 64;
        it.Wp = (const GAS float*)(a.in[l ? 33 : 21] + (size_t)e * DE * D) + (size_t)(it.k0 + (lane >> 3)) * D + n0 + 4 * (lane & 7);
        it.dst0 = (bf16*)(ws + WS_WDN) + ((size_t)l * NE * D + (size_t)e * D + n0) * DE;
    }
    it.ok = true; return it;
}
__device__ __forceinline__ ConvItem fox_conv_item(const Args& a, unsigned char* ws, int r, const int lane) {
    constexpr int I_FOXIN = 32 * 257;
    ConvItem it; it.K = D; it.gain = a.in[14]; it.hasg = false;
    if (r < I_FOXIN) { const int kb = r / 257, nb = r % 257, n0 = nb * 32, cn = n0 + 4 * (lane & 7);
        it.N = FOXN; it.k0 = kb * 64; it.ok = cn < FOXN;
        it.Wp = (const GAS float*)a.in[23] + (size_t)(it.k0 + (lane >> 3)) * FOXN + (it.ok ? cn : 0);
        it.dst0 = nb < 256 ? (bf16*)(ws + WS_WFOXIN) + (size_t)n0 * D : (bf16*)(ws + WS_WF);
    } else { r -= I_FOXIN; const int kb = r / 64, nb = r % 64, n0 = nb * 32;
        it.N = D; it.k0 = kb * 64; it.ok = true;
        it.Wp = (const GAS float*)a.in[25] + (size_t)(it.k0 + (lane >> 3)) * D + n0 + 4 * (lane & 7);
        it.dst0 = (bf16*)(ws + WS_WFOXOUT) + (size_t)n0 * D; }
    return it;
}
template <int KIND>
__device__ __forceinline__ void conv_range(Frame& F, const Args& a, unsigned char* ws, const int r0, const int r_end, const int worker, const int stride) {
    LAS unsigned char* scrb = F.lds + RING_OFF + F.wave * 16384;
    const int lane = F.lane;
    int r = r0 + worker;
    if (r >= r_end) return;
    const int wk = lane >> 3, l7 = lane & 7, wn = 4 * l7, c = l7;
    __builtin_amdgcn_s_waitcnt(0x0F70);
    if constexpr (KIND < 2) {
        const GAS f32x4* gsrc = (const GAS f32x4*)a.in[KIND ? 26 : 14];
#pragma unroll
        for (int i = 0; i < 8; ++i) *(LAS f32x4*)(scrb + 8192 + (i * 64 + lane) * 16) = gsrc[i * 64 + lane];
        LDS_WAIT(); asm volatile("" ::: "memory");
    }
    ConvItem dummy; dummy.Wp = (const GAS float*)a.in[14] + wn; dummy.dst0 = nullptr; dummy.gain = a.in[14]; dummy.N = 0; dummy.K = 0; dummy.k0 = 0; dummy.ok = true; dummy.hasg = false;
#define CONV_ITEM(r) ((r) < r_end ? (KIND < 2 ? moe_conv_item(a, ws, KIND, (r), lane) : fox_conv_item(a, ws, (r), lane)) : dummy)
#define CONV_LOAD(dst, it) { _Pragma("unroll") for (int i = 0; i < 8; ++i) dst[i] = __builtin_nontemporal_load((const GAS f32x4*)(it.Wp + (size_t)(8 * i) * it.N)); }
    const unsigned wq = (unsigned)(l7 ^ wk), wb = (unsigned)wk * 128u;
    unsigned X[8];
#pragma unroll
    for (int m = 0; m < 8; ++m) X[m] = (unsigned)c * 1024u + (unsigned)(wk & 3) * 4u + ((((unsigned)(wk >> 2) ^ (unsigned)c ^ (unsigned)m)) << 4);
#define CONV_PROC(ld, cur) { \
        _Pragma("unroll") for (int i = 0; i < 8; ++i) { const f32x4 v = cur.ok ? ld[i] : f32x4{0.f, 0.f, 0.f, 0.f}; *(LAS f32x4*)(scrb + wb + i * 1024 + ((wq ^ (unsigned)i) << 4)) = v; } \
        LDS_WAIT(); asm volatile("" ::: "memory"); \
        f32x4 g0 = {1.f, 1.f, 1.f, 1.f}, g1 = g0; \
        if constexpr (KIND < 2) { const f32x4 q0 = *(const LAS f32x4*)(scrb + 8192 + (cur.k0 + 8 * c) * 4), q1 = *(const LAS f32x4*)(scrb + 8192 + (cur.k0 + 8 * c) * 4 + 16); g0 = cur.hasg ? q0 : g0; g1 = cur.hasg ? q1 : g1; } \
        _Pragma("unroll") for (int jj = 0; jj < 4; ++jj) { const int n = (lane >> 3) + 8 * jj; float sp[8]; \
            _Pragma("unroll") for (int t = 0; t < 8; ++t) sp[t] = *(const LAS float*)(scrb + X[t ^ (2 * jj)] + t * 128); \
            v4u o; o.x = pk2(sp[0] * g0.x, sp[1] * g0.y); o.y = pk2(sp[2] * g0.z, sp[3] * g0.w); o.z = pk2(sp[4] * g1.x, sp[5] * g1.y); o.w = pk2(sp[6] * g1.z, sp[7] * g1.w); \
            __builtin_nontemporal_store(o, (GAS v4u*)(cur.dst0 + (size_t)n * cur.K + cur.k0 + 8 * c)); } \
        LDS_WAIT(); asm volatile("" ::: "memory"); }
    ConvItem iA = CONV_ITEM(r), iB = CONV_ITEM(r + stride), iC = CONV_ITEM(r + 2 * stride), iD = CONV_ITEM(r + 3 * stride), iE;
    f32x4 A[8], B[8], C[8], Dd[8], Ee[8];
    CONV_LOAD(A, iA)
    __builtin_amdgcn_sched_barrier(0);
    CONV_LOAD(B, iB)
    __builtin_amdgcn_sched_barrier(0);
    CONV_LOAD(C, iC)
    __builtin_amdgcn_sched_barrier(0);
    CONV_LOAD(Dd, iD)
    __builtin_amdgcn_sched_barrier(0);
    for (; r < r_end; r += 5 * stride) {
        iE = CONV_ITEM(r + 4 * stride); CONV_LOAD(Ee, iE)
        CONV_PROC(A, iA)
        iA = CONV_ITEM(r + 5 * stride); CONV_LOAD(A, iA)
        if (r + stride < r_end) CONV_PROC(B, iB)
        iB = CONV_ITEM(r + 6 * stride); CONV_LOAD(B, iB)
        if (r + 2 * stride < r_end) CONV_PROC(C, iC)
        iC = CONV_ITEM(r + 7 * stride); CONV_LOAD(C, iC)
        if (r + 3 * stride < r_end) CONV_PROC(Dd, iD)
        iD = CONV_ITEM(r + 8 * stride); CONV_LOAD(Dd, iD)
        if (r + 4 * stride < r_end) CONV_PROC(Ee, iE)
    }
#undef CONV_PROC
#undef CONV_LOAD
#undef CONV_ITEM
}
constexpr int CONV_TOTAL_MOE = 3 * 64 * 512, CONV_TOTAL_FOX = 32 * 257 + 32 * 64;
template <int KIND>
__device__ __forceinline__ void conv_run(Frame& F, const Args& a, unsigned char* ws, const int slot, const int nslots) {
    const int gw = F.vcu * NWAVES + F.wave, NGW = F.G * NWAVES;
    constexpr int TOTAL = KIND < 2 ? CONV_TOTAL_MOE : CONV_TOTAL_FOX;
    const int nj = (TOTAL + NGW - 1) / NGW, j0 = (nj * slot) / nslots, j1 = (nj * (slot + 1)) / nslots;
    const int re = j1 * NGW < TOTAL ? j1 * NGW : TOTAL;
    conv_range<KIND>(F, a, ws, j0 * NGW, re, gw, NGW);
}
__device__ __forceinline__ void moe_conv(Frame& F, const Args& a, unsigned char* ws, const int l, const int slot, const int nslots) {
    if (l == 0) conv_run<0>(F, a, ws, slot, nslots); else conv_run<1>(F, a, ws, slot, nslots);
}

using pg8::Unit; using pg8::UPtr; using pg8::TileOrder; using pg8::cvt_pk_bf16; using pg8::bf_lo; using pg8::bf_hi;
typedef pg8::f32x4 (AccT)[2][2][4][2];

struct SchedDense {
    static constexpr bool GATHER = false, ROWSKIP = false;
    TileOrder T; const char* A; const char* B; size_t astep, bstep;
    int i_begin, i_end;
    __device__ __forceinline__ void init(const void* A_, int lda, const void* B_, int ldb, int nM, int nN, int G, int c) { T.init(nM, nN, G, c); A = (const char*)A_; B = (const char*)B_; astep = (size_t)256 * lda * 2; bstep = (size_t)256 * ldb * 2; i_begin = 0; i_end = 1 << 30; }
    __device__ __forceinline__ bool next(int i, Unit& u) const { return (i + i_begin < i_end) && T.next(i + i_begin, u); }
    __device__ __forceinline__ UPtr ptrs(const Unit& u) const { UPtr p; p.A = A + (size_t)u.pm * astep; p.B = B + (size_t)u.pn * bstep; return p; }
};
template <int NPN> struct SchedS5 {
    static constexpr bool GATHER = false, ROWSKIP = false;
    int G, c; const char* A; const char* B; size_t bgrp, btile;
    __device__ __forceinline__ void init(const void* A_, const void* B_, int brows_per_group, int ldb, int G_, int c_) { G = G_; c = c_; A = (const char*)A_; B = (const char*)B_; bgrp = (size_t)brows_per_group * ldb * 2; btile = (size_t)256 * ldb * 2; }
    __device__ __forceinline__ bool next(int i, Unit& u) const { const int L = i * G + c; if (L >= NG * 2 * NPN) return false; u.pm = L / NPN; u.pn = L % NPN; u.half = -1; return true; }
    __device__ __forceinline__ UPtr ptrs(const Unit& u) const { UPtr p; p.A = A + (size_t)u.pm * 256 * KP * 2; p.B = B + (size_t)(u.pm >> 1) * bgrp + (size_t)u.pn * btile; return p; }
};
struct MoeTab { const LAS int* cnt; const LAS int* mt_e; const LAS int* mt_row0; int T; };
struct SchedMoeGU {
    static constexpr bool GATHER = true, ROWSKIP = true;
    __device__ __forceinline__ int valid(const Unit& u) const { return tab.cnt[tab.mt_e[u.pm]] - tab.mt_row0[u.pm]; }
    TileOrder T; MoeTab tab; const char* HN; const char* W; const int* tokl; int tid;
    __device__ __forceinline__ bool next(int i, Unit& u) const { return T.next(i, u); }
    __device__ __forceinline__ UPtr ptrs(const Unit& u) const { UPtr p; p.A = HN; p.B = W + ((size_t)tab.mt_e[u.pm] * 1024 + (size_t)u.pn * 256) * D * 2; return p; }
    __device__ __forceinline__ void gather(const Unit& u, unsigned (&off)[2][2]) const {
        const int e = tab.mt_e[u.pm], row0 = tab.mt_row0[u.pm], cnt = tab.cnt[e];
        const GAS int* tl = (const GAS int*)tokl + (size_t)e * M;
        int pr[2][2];
#pragma unroll
        for (int i = 0; i < 2; ++i) { int R, C; pg8::stage_rc(tid * 16 + i * 8192, R, C);
#pragma unroll
            for (int h = 0; h < 2; ++h) { const int idx = row0 + h * 128 + R; pr[h][i] = tl[idx < cnt ? idx : cnt - 1]; } }
#pragma unroll
        for (int i = 0; i < 2; ++i) { int R, C; pg8::stage_rc(tid * 16 + i * 8192, R, C);
#pragma unroll
            for (int h = 0; h < 2; ++h) { const int idx = row0 + h * 128 + R; const int pair = idx < cnt ? pr[h][i] : 0;
                off[h][i] = (unsigned)(pair >> 1) * (unsigned)(D * 2) + (unsigned)C * 2u; } }
    }
};
struct SchedMoeDN {
    static constexpr bool GATHER = false, ROWSKIP = true;
    __device__ __forceinline__ int valid(const Unit& u) const { return tab.cnt[tab.mt_e[u.pm]] - tab.mt_row0[u.pm]; }
    TileOrder T; MoeTab tab; const char* HID; const char* W;
    __device__ __forceinline__ bool next(int i, Unit& u) const { return T.next(i, u); }
    __device__ __forceinline__ UPtr ptrs(const Unit& u) const { UPtr p; p.A = HID + (size_t)u.pm * 256 * DE * 2; p.B = W + ((size_t)tab.mt_e[u.pm] * D + (size_t)u.pn * 256) * DE * 2; return p; }
};

struct EpiU {
    static constexpr bool PERM = true, AFTER_DRAIN = false;
    bf16* UA;
    __device__ __forceinline__ void operator()(const AccT& acc, const Unit& u, int wr, int wc, int fr, int fq) const {
#pragma unroll
        for (int ai = 0; ai < 2; ++ai)
#pragma unroll
            for (int m = 0; m < 4; ++m) { const int t = u.pm * 256 + ai * 128 + wr * 64 + m * 16 + fr;
                const int b = t >> 11, s = t & 2047, ch = s >> 5, j = s & 31;
#pragma unroll
                for (int bj = 0; bj < 2; ++bj) { const int c0 = u.pn * 256 + bj * 128 + wc * 32 + 8 * fq, g = c0 >> 4, hf = (c0 >> 3) & 1;
                    const pg8::f32x4 v0 = acc[ai][bj][m][0], v1 = acc[ai][bj][m][1];
                    v4u w; w.x = cvt_pk_bf16(v0[0], v0[1]); w.y = cvt_pk_bf16(v0[2], v0[3]); w.z = cvt_pk_bf16(v1[0], v1[1]); w.w = cvt_pk_bf16(v1[2], v1[3]);
                    *(GAS v4u*)(UA + ((size_t)(g * 512 + b * 64 + ch) * KP + j * 16 + hf * 8)) = w; } }
    }
};
struct EpiScan {
    static constexpr bool PERM = false, AFTER_DRAIN = true;
    bf16* UA; const float* AL;
    __device__ __forceinline__ void fused(const AccT& acc, const Unit& u, int wr, int wc, int fr, int fq, LAS unsigned char* lds, int wid, int lane) const {
        LAS float* X = (LAS float*)lds;
#pragma unroll
        for (int ai = 0; ai < 2; ++ai)
#pragma unroll
            for (int m = 0; m < 4; ++m) { const int r = ai * 128 + wr * 64 + m * 16 + fr;
#pragma unroll
                for (int n = 0; n < 2; ++n) *(LAS pg8::f32x4*)(X + r * 128 + wc * 32 + n * 16 + 4 * fq) = acc[ai][0][m][n]; }
        LDS_WAIT(); __syncthreads();
        const int tid = wid * 64 + lane;
        if (tid < 256) { const int bl = tid >> 6, n = tid & 63, g = u.pm >> 1;
            const float ar = AL[(g * 64 + n) * 2], ai_ = AL[(g * 64 + n) * 2 + 1];
            float sr = 0.f, si = 0.f;
            bf16* dst = UA + (size_t)(u.pm * 256 + bl * 64) * KP + 512 + 2 * n;
            const LAS float* xs = X + (bl * 64) * 128 + 2 * n;
            for (int c = 0; c < 64; ++c) {
                *(GAS unsigned*)(dst + (size_t)c * KP) = pk2(sr, si);
                const float xr = xs[c * 128], xi = xs[c * 128 + 1];
                const float nr = ar * sr - ai_ * si + xr, ni = ar * si + ai_ * sr + xi; sr = nr; si = ni; }
        }
        __syncthreads();
    }
};
struct EpiY {
    static constexpr bool PERM = true, AFTER_DRAIN = false;
    const bf16* UA; const float* dsk; bf16* GL;
    __device__ __forceinline__ void operator()(const AccT& acc, const Unit& u, int wr, int wc, int fr, int fq) const {
        const int g = u.pm >> 1, n00 = u.pn * 256 + wc * 32 + 8 * fq;
        const GAS bf16* ug = (const GAS bf16*)UA + ((size_t)(g * 512 + (u.pm & 1) * 256 + wr * 64 + fr) * KP + n00);
        v4u uv[4][2]; f32x4 dd[2][2];
#define EY_LOAD(b) { const GAS bf16* p_ = ug + (size_t)(((b) >> 2) * 128 + ((b) & 3) * 16) * KP; uv[(b) & 3][0] = *(const GAS v4u*)p_; uv[(b) & 3][1] = *(const GAS v4u*)(p_ + 128); }
        EY_LOAD(0) EY_LOAD(1) EY_LOAD(2) EY_LOAD(3)
#pragma unroll
        for (int bj = 0; bj < 2; ++bj) { const int hf = ((n00 + bj * 128) >> 3) & 1; dd[bj][0] = *(const GAS f32x4*)(dsk + g * 16 + hf * 8); dd[bj][1] = *(const GAS f32x4*)(dsk + g * 16 + hf * 8 + 4); }
        __builtin_amdgcn_s_waitcnt(0x0F70);
#pragma unroll
        for (int b = 0; b < 8; ++b) { const int ai = b >> 2, m = b & 3;
            const int rl = ai * 128 + wr * 64 + m * 16 + fr, row = (u.pm & 1) * 256 + rl, bb = row >> 6, ch = row & 63;
#pragma unroll
            for (int bj = 0; bj < 2; ++bj) { const int n0 = n00 + bj * 128, i = n0 >> 4, hf = (n0 >> 3) & 1;
                const v4u uu = uv[m][bj]; const f32x4 d0 = dd[bj][0], d1 = dd[bj][1];
                const pg8::f32x4 v0 = acc[ai][bj][m][0], v1 = acc[ai][bj][m][1];
                float y[8];
                y[0] = v0[0] + d0.x * bf_lo(uu.x); y[1] = v0[1] + d0.y * bf_hi(uu.x); y[2] = v0[2] + d0.z * bf_lo(uu.y); y[3] = v0[3] + d0.w * bf_hi(uu.y);
                y[4] = v1[0] + d1.x * bf_lo(uu.z); y[5] = v1[1] + d1.y * bf_hi(uu.z); y[6] = v1[2] + d1.z * bf_lo(uu.w); y[7] = v1[3] + d1.w * bf_hi(uu.w);
#pragma unroll
                for (int e = 0; e < 8; ++e) y[e] = gelu_tanh_(y[e]);
                v4u w; w.x = cvt_pk_bf16(y[0], y[1]); w.y = cvt_pk_bf16(y[2], y[3]); w.z = cvt_pk_bf16(y[4], y[5]); w.w = cvt_pk_bf16(y[6], y[7]);
                const size_t tok = (size_t)bb * SEQ + ch * LCH + i;
                *(GAS v4u*)(GL + tok * DS + g * 16 + hf * 8) = w; }
            if (b + 4 < 8) EY_LOAD(b + 4) }
#undef EY_LOAD
    }
};
struct EpiGlu {
    static constexpr bool PERM = true, AFTER_DRAIN = false;
    const bf16* GL; const float* bias; bf16* OG;
    __device__ __forceinline__ void operator()(const AccT& acc, const Unit& u, int wr, int wc, int fr, int fq) const {
        const int c00 = u.pn * 256 + wc * 32 + 8 * fq;
        const GAS bf16* gp = (const GAS bf16*)GL + ((size_t)u.pm * 256 + wr * 64 + fr) * DS + c00;
        v4u gv[4][2]; f32x4 bb[2][2];
#define EG_LOAD(b) { const GAS bf16* p_ = gp + (size_t)(((b) >> 2) * 128 + ((b) & 3) * 16) * DS; gv[(b) & 3][0] = *(const GAS v4u*)p_; gv[(b) & 3][1] = *(const GAS v4u*)(p_ + 128); }
        EG_LOAD(0) EG_LOAD(1) EG_LOAD(2) EG_LOAD(3)
#pragma unroll
        for (int bj = 0; bj < 2; ++bj) { bb[bj][0] = *(const GAS f32x4*)(bias + c00 + bj * 128); bb[bj][1] = *(const GAS f32x4*)(bias + c00 + bj * 128 + 4); }
        __builtin_amdgcn_s_waitcnt(0x0F70);
#pragma unroll
        for (int b = 0; b < 8; ++b) { const int ai = b >> 2, m = b & 3; const size_t row = (size_t)u.pm * 256 + ai * 128 + wr * 64 + m * 16 + fr;
#pragma unroll
            for (int bj = 0; bj < 2; ++bj) { const int c0 = c00 + bj * 128; const v4u gg = gv[m][bj]; const f32x4 b0 = bb[bj][0], b1 = bb[bj][1];
                const pg8::f32x4 v0 = acc[ai][bj][m][0], v1 = acc[ai][bj][m][1];
                float o[8];
                o[0] = bf_lo(gg.x) * sigmoidf_(v0[0] + b0.x); o[1] = bf_hi(gg.x) * sigmoidf_(v0[1] + b0.y); o[2] = bf_lo(gg.y) * sigmoidf_(v0[2] + b0.z); o[3] = bf_hi(gg.y) * sigmoidf_(v0[3] + b0.w);
                o[4] = bf_lo(gg.z) * sigmoidf_(v1[0] + b1.x); o[5] = bf_hi(gg.z) * sigmoidf_(v1[1] + b1.y); o[6] = bf_lo(gg.w) * sigmoidf_(v1[2] + b1.z); o[7] = bf_hi(gg.w) * sigmoidf_(v1[3] + b1.w);
                v4u w; w.x = cvt_pk_bf16(o[0], o[1]); w.y = cvt_pk_bf16(o[2], o[3]); w.z = cvt_pk_bf16(o[4], o[5]); w.w = cvt_pk_bf16(o[6], o[7]);
                *(GAS v4u*)(OG + row * DS + c0) = w; }
            if (b + 4 < 8) EG_LOAD(b + 4) }
#undef EG_LOAD
    }
};
struct EpiRes {
    static constexpr bool PERM = false, AFTER_DRAIN = false;
    const float* base; float* out;
    __device__ __forceinline__ void operator()(const AccT& acc, const Unit& u, int wr, int wc, int fr, int fq) const {
#pragma unroll
        for (int ai = 0; ai < 2; ++ai)
#pragma unroll
            for (int m = 0; m < 4; ++m) { const size_t off = ((size_t)u.pm * 256 + ai * 128 + wr * 64 + m * 16 + fr) * D + u.pn * 256 + wc * 32 + 4 * fq;
#pragma unroll
                for (int bj = 0; bj < 2; ++bj)
#pragma unroll
                    for (int n = 0; n < 2; ++n) { const f32x4 bs = *(const GAS f32x4*)(base + off + bj * 128 + n * 16); const pg8::f32x4 a = acc[ai][bj][m][n];
                        f32x4 o; o.x = bs.x + a[0]; o.y = bs.y + a[1]; o.z = bs.z + a[2]; o.w = bs.w + a[3];
                        *(GAS f32x4*)(out + off + bj * 128 + n * 16) = o; }
                asm volatile("" ::: "memory"); }
    }
};
struct EpiResYP {
    static constexpr bool PERM = false, AFTER_DRAIN = false;
    float* out; const bf16* YP;
    __device__ __forceinline__ void operator()(const AccT& acc, const Unit& u, int wr, int wc, int fr, int fq) const {
#pragma unroll
        for (int ai = 0; ai < 2; ++ai)
#pragma unroll
            for (int m = 0; m < 4; ++m) { const size_t row = (size_t)u.pm * 256 + ai * 128 + wr * 64 + m * 16 + fr; const int col = u.pn * 256 + wc * 32 + 4 * fq;
#pragma unroll
                for (int bj = 0; bj < 2; ++bj)
#pragma unroll
                    for (int n = 0; n < 2; ++n) { const int c = col + bj * 128 + n * 16;
                        const f32x4 bs = *(const GAS f32x4*)(out + row * D + c); const v2u y0 = *(const GAS v2u*)(YP + (2 * row) * D + c), y1 = *(const GAS v2u*)(YP + (2 * row + 1) * D + c);
                        const pg8::f32x4 a = acc[ai][bj][m][n];
                        f32x4 o; o.x = bs.x + bf_lo(y0.x) + bf_lo(y1.x) + a[0]; o.y = bs.y + bf_hi(y0.x) + bf_hi(y1.x) + a[1]; o.z = bs.z + bf_lo(y0.y) + bf_lo(y1.y) + a[2]; o.w = bs.w + bf_hi(y0.y) + bf_hi(y1.y) + a[3];
                        *(GAS f32x4*)(out + row * D + c) = o; }
                asm volatile("" ::: "memory"); }
    }
};
__device__ __forceinline__ float sumsq8(const v4u w) { float s = 0.f; s += bf_lo(w.x) * bf_lo(w.x) + bf_hi(w.x) * bf_hi(w.x); s += bf_lo(w.y) * bf_lo(w.y) + bf_hi(w.y) * bf_hi(w.y);
    s += bf_lo(w.z) * bf_lo(w.z) + bf_hi(w.z) * bf_hi(w.z); s += bf_lo(w.w) * bf_lo(w.w) + bf_hi(w.w) * bf_hi(w.w); return s; }
struct EpiResB {
    static constexpr bool PERM = true, AFTER_DRAIN = false;
    const float* x; bf16* HB; float* SS;
    __device__ __forceinline__ void operator()(const AccT& acc, const Unit& u, int wr, int wc, int fr, int fq) const {
        const int c00 = u.pn * 256 + wc * 32 + 8 * fq;
        const GAS float* xg = (const GAS float*)x + ((size_t)u.pm * 256 + wr * 64 + fr) * D + c00;
        f32x4 xv[4][2][2];
#define RB_LOAD(b) { const GAS float* p_ = xg + (size_t)(((b) >> 2) * 128 + ((b) & 3) * 16) * D; _Pragma("unroll") for (int bj = 0; bj < 2; ++bj) { xv[(b) & 3][bj][0] = *(const GAS f32x4*)(p_ + bj * 128); xv[(b) & 3][bj][1] = *(const GAS f32x4*)(p_ + bj * 128 + 4); } }
        RB_LOAD(0) RB_LOAD(1) RB_LOAD(2) RB_LOAD(3)
        __builtin_amdgcn_s_waitcnt(0x0F70);
#pragma unroll
        for (int b = 0; b < 8; ++b) { const int ai = b >> 2, m = b & 3; const size_t row = (size_t)u.pm * 256 + ai * 128 + wr * 64 + m * 16 + fr; float ssq = 0.f;
#pragma unroll
            for (int bj = 0; bj < 2; ++bj) { const int c = c00 + bj * 128; const f32x4 x0 = xv[m][bj][0], x1 = xv[m][bj][1];
                const pg8::f32x4 v0 = acc[ai][bj][m][0], v1 = acc[ai][bj][m][1];
                v4u w; w.x = cvt_pk_bf16(x0.x + v0[0], x0.y + v0[1]); w.y = cvt_pk_bf16(x0.z + v0[2], x0.w + v0[3]); w.z = cvt_pk_bf16(x1.x + v1[0], x1.y + v1[1]); w.w = cvt_pk_bf16(x1.z + v1[2], x1.w + v1[3]);
                *(GAS v4u*)(HB + row * D + c) = w; ssq += sumsq8(w); }
            ssq += __shfl_xor(ssq, 16); ssq += __shfl_xor(ssq, 32);
            if (fq == 0) SS[row * 32 + u.pn * 4 + wc] = ssq;
            if (b + 4 < 8) RB_LOAD(b + 4) }
#undef RB_LOAD
    }
};
struct EpiResYPB {
    static constexpr bool PERM = true, AFTER_DRAIN = false;
    bf16* HB; const bf16* YP; float* SS;
    __device__ __forceinline__ void operator()(const AccT& acc, const Unit& u, int wr, int wc, int fr, int fq) const {
        const int c00 = u.pn * 256 + wc * 32 + 8 * fq;
        const size_t r00 = (size_t)u.pm * 256 + wr * 64 + fr;
        const GAS bf16* hg = (const GAS bf16*)HB + r00 * D + c00; const GAS bf16* yg = (const GAS bf16*)YP + (2 * r00) * D + c00;
        v4u hv[4][2], y0v[4][2], y1v[4][2];
#define RY_LOAD(b) { const size_t ro_ = (size_t)(((b) >> 2) * 128 + ((b) & 3) * 16); _Pragma("unroll") for (int bj = 0; bj < 2; ++bj) { \
            hv[(b) & 3][bj] = *(const GAS v4u*)(hg + ro_ * D + bj * 128); y0v[(b) & 3][bj] = *(const GAS v4u*)(yg + (2 * ro_) * D + bj * 128); y1v[(b) & 3][bj] = *(const GAS v4u*)(yg + (2 * ro_ + 1) * D + bj * 128); } }
        RY_LOAD(0) RY_LOAD(1) RY_LOAD(2) RY_LOAD(3)
        __builtin_amdgcn_s_waitcnt(0x0F70);
#pragma unroll
        for (int b = 0; b < 8; ++b) { const int ai = b >> 2, m = b & 3; const size_t row = (size_t)u.pm * 256 + ai * 128 + wr * 64 + m * 16 + fr; float ssq = 0.f;
#pragma unroll
            for (int bj = 0; bj < 2; ++bj) { const int c = c00 + bj * 128; const v4u hb = hv[m][bj], y0 = y0v[m][bj], y1 = y1v[m][bj];
                const pg8::f32x4 v0 = acc[ai][bj][m][0], v1 = acc[ai][bj][m][1];
                v4u w;
                w.x = cvt_pk_bf16(bf_lo(hb.x) + bf_lo(y0.x) + bf_lo(y1.x) + v0[0], bf_hi(hb.x) + bf_hi(y0.x) + bf_hi(y1.x) + v0[1]);
                w.y = cvt_pk_bf16(bf_lo(hb.y) + bf_lo(y0.y) + bf_lo(y1.y) + v0[2], bf_hi(hb.y) + bf_hi(y0.y) + bf_hi(y1.y) + v0[3]);
                w.z = cvt_pk_bf16(bf_lo(hb.z) + bf_lo(y0.z) + bf_lo(y1.z) + v1[0], bf_hi(hb.z) + bf_hi(y0.z) + bf_hi(y1.z) + v1[1]);
                w.w = cvt_pk_bf16(bf_lo(hb.w) + bf_lo(y0.w) + bf_lo(y1.w) + v1[2], bf_hi(hb.w) + bf_hi(y0.w) + bf_hi(y1.w) + v1[3]);
                *(GAS v4u*)(HB + row * D + c) = w; ssq += sumsq8(w); }
            ssq += __shfl_xor(ssq, 16); ssq += __shfl_xor(ssq, 32);
            if (fq == 0) SS[row * 32 + u.pn * 4 + wc] = ssq;
            if (b + 4 < 8) RY_LOAD(b + 4) }
#undef RY_LOAD
    }
};
struct EpiGU {
    static constexpr bool PERM = true, AFTER_DRAIN = false;
    bf16* HID; MoeTab tab; const float* tokr;
    __device__ __forceinline__ void operator()(const AccT& acc, const Unit& u, int wr, int wc, int fr, int fq) const {
        const int e_ = tab.mt_e[u.pm], row0_ = tab.mt_row0[u.pm], cnt_ = tab.cnt[e_];
        const GAS float* tr = (const GAS float*)tokr + (size_t)e_ * M;
        float rsv[8];
#pragma unroll
        for (int b = 0; b < 8; ++b) { const int idx_ = row0_ + (b >> 2) * 128 + wr * 64 + (b & 3) * 16 + fr; rsv[b] = tr[idx_ < cnt_ ? idx_ : cnt_ - 1]; }
        __builtin_amdgcn_s_waitcnt(0x0F70);
#pragma unroll
        for (int ai = 0; ai < 2; ++ai) { if (u.half >= 0 && u.half != ai) continue;
#pragma unroll
            for (int m = 0; m < 4; ++m) { const size_t row = (size_t)u.pm * 256 + ai * 128 + wr * 64 + m * 16 + fr;
                const int idx_ = row0_ + ai * 128 + wr * 64 + m * 16 + fr; const float rs = idx_ < cnt_ ? rsv[ai * 4 + m] : 0.f;
                float h[8];
#pragma unroll
                for (int n = 0; n < 2; ++n)
#pragma unroll
                    for (int e = 0; e < 4; ++e) { const float gt = acc[ai][0][m][n][e] * rs, up = acc[ai][1][m][n][e] * rs; h[n * 4 + e] = gt * sigmoidf_(gt) * up; }
                v4u w; w.x = cvt_pk_bf16(h[0], h[1]); w.y = cvt_pk_bf16(h[2], h[3]); w.z = cvt_pk_bf16(h[4], h[5]); w.w = cvt_pk_bf16(h[6], h[7]);
                *(GAS v4u*)(HID + row * DE + u.pn * 128 + wc * 32 + 8 * fq) = w; } }
    }
};
struct EpiDN {
    static constexpr bool PERM = true, AFTER_DRAIN = false;
    MoeTab tab; const int* tokl; const float* tokw; bf16* YP;
    __device__ __forceinline__ void operator()(const AccT& acc, const Unit& u, int wr, int wc, int fr, int fq) const {
        const int e = tab.mt_e[u.pm], row0 = tab.mt_row0[u.pm], cnt = tab.cnt[e];
        const GAS int* tl = (const GAS int*)tokl + (size_t)e * M; const GAS float* tw = (const GAS float*)tokw + (size_t)e * M;
        int pr[8]; float wg[8];
#pragma unroll
        for (int b = 0; b < 8; ++b) { const int idx = row0 + (b >> 2) * 128 + wr * 64 + (b & 3) * 16 + fr, ic = idx < cnt ? idx : cnt - 1; pr[b] = tl[ic]; wg[b] = tw[ic]; }
        __builtin_amdgcn_s_waitcnt(0x0F70);
#pragma unroll
        for (int ai = 0; ai < 2; ++ai) { if (u.half >= 0 && u.half != ai) continue;
#pragma unroll
            for (int m = 0; m < 4; ++m) { const int idx = row0 + ai * 128 + wr * 64 + m * 16 + fr;
                if (idx < cnt) { const int pair = pr[ai * 4 + m]; const float wgt = wg[ai * 4 + m];
#pragma unroll
                    for (int bj = 0; bj < 2; ++bj) { const pg8::f32x4 v0 = acc[ai][bj][m][0], v1 = acc[ai][bj][m][1];
                        v4u w; w.x = cvt_pk_bf16(v0[0] * wgt, v0[1] * wgt); w.y = cvt_pk_bf16(v0[2] * wgt, v0[3] * wgt); w.z = cvt_pk_bf16(v1[0] * wgt, v1[1] * wgt); w.w = cvt_pk_bf16(v1[2] * wgt, v1[3] * wgt);
                        *(GAS v4u*)(YP + (size_t)pair * D + u.pn * 256 + bj * 128 + wc * 32 + 8 * fq) = w; } } } }
    }
};
struct EpiQKVG {
    static constexpr bool PERM = true, AFTER_DRAIN = false;
    bf16* Q; size_t tstride;
    __device__ __forceinline__ void operator()(const AccT& acc, const Unit& u, int wr, int wc, int fr, int fq) const {
        const int t = u.pn >> 3; bf16* base = Q + (size_t)t * tstride; const int col0 = (u.pn & 7) * 256 + wc * 32 + 8 * fq;
#pragma unroll
        for (int ai = 0; ai < 2; ++ai)
#pragma unroll
            for (int m = 0; m < 4; ++m) { bf16* rowp = base + ((size_t)u.pm * 256 + ai * 128 + wr * 64 + m * 16 + fr) * D + col0;
#pragma unroll
                for (int bj = 0; bj < 2; ++bj) { pg8::f32x4 v0 = acc[ai][bj][m][0], v1 = acc[ai][bj][m][1];
                    if (t == 3) {
#pragma unroll
                        for (int e = 0; e < 4; ++e) { v0[e] = sigmoidf_(v0[e]); v1[e] = sigmoidf_(v1[e]); } }
                    v4u w; w.x = cvt_pk_bf16(v0[0], v0[1]); w.y = cvt_pk_bf16(v0[2], v0[3]); w.z = cvt_pk_bf16(v1[0], v1[1]); w.w = cvt_pk_bf16(v1[2], v1[3]);
                    *(GAS v4u*)(rowp + bj * 128) = w; } }
    }
};

namespace fox {
constexpr int AD = 128, PITCH = 2048;
constexpr float SCALE = 0.08838834764831845f;
constexpr float THR = 24.f;
constexpr int NW = 8, QBLK = 32, KVBLK = 64, QB = NW * QBLK;
constexpr int SHM_V = KVBLK * AD * 2, SHM_K = KVBLK * AD * 2;
constexpr int WS_OFF = 2 * SHM_V + 2 * SHM_K;
constexpr int BIAS_OFF = WS_OFF + NW * 64 * 4;
constexpr int ATT_LDS_BYTES = BIAS_OFF + 2 * SEQ * 4;
constexpr int GATE_OFF = 86016;
static_assert(GATE_OFF >= ATT_LDS_BYTES && GATE_OFF % 16 == 0, "gate tiles above the K/V/bias region");
typedef short s16x4 __attribute__((ext_vector_type(4)));

#define KSWZ(row, colB) ((row) * 256 + ((colB) ^ (((row) & 7) << 4)))
#define SBAR() __builtin_amdgcn_sched_barrier(0)
__device__ __forceinline__ int v_st(int k, int c) { const int kk = (k & ~0xC) | ((k & 4) << 1) | ((k & 8) >> 1); return ((kk >> 3) * 4 + (c >> 5)) * 512 + ((kk & 7) * 32 + (c & 31)) * 2; }
__device__ __forceinline__ int v_rd_base(int lane) { return ((lane & 3) << 3) | (((lane >> 2) & 3) << 6) | (((lane >> 4) & 1) << 5) | (((lane >> 5) & 1) << 8); }
constexpr int v_rd_off(int d0, int ks, int half) { return d0 * 512 + ks * 4096 + half * 2048; }
__device__ __forceinline__ int crow(int r, int hi) { return (r & 3) + 8 * (r >> 2) + 4 * hi; }
__device__ __forceinline__ unsigned cvtpk(float lo, float hi) { unsigned r; asm volatile("v_cvt_pk_bf16_f32 %0, %1, %2" : "=v"(r) : "v"(lo), "v"(hi)); return r; }
__device__ __forceinline__ bf16x8 ld8(const GAS char* ubase, unsigned voff) { return *(const GAS bf16x8*)(ubase + voff); }
constexpr size_t VK_DELTA = (size_t)64 << 20;
__device__ __forceinline__ void mask_tile(f32x16& p0, f32x16& p1, int dq) {
    const float NEG = -__builtin_inff();
#pragma unroll
    for (int r = 0; r < 16; ++r) {
        const int c = (r & 3) + 8 * (r >> 2);
        if (dq - c < 0) p0[r] = NEG;
        if (dq - c - 32 < 0) p1[r] = NEG;
    }
}
__device__ __forceinline__ void partialSM(f32x16& p0, f32x16& p1, float& m_reg, float& mn, float& alpha) {
    float pmax = p0[0]; for (int r = 1; r < 16; ++r) pmax = fmaxf(pmax, p0[r]); for (int r = 0; r < 16; ++r) pmax = fmaxf(pmax, p1[r]);
    { auto rr = __builtin_amdgcn_permlane32_swap(__float_as_uint(pmax), __float_as_uint(pmax), false, false);
      pmax = fmaxf(__uint_as_float(rr[0]), __uint_as_float(rr[1])); }
    constexpr float C2 = 1.4426950408889634f * SCALE;
    if (__builtin_expect(__all((pmax - m_reg) * SCALE <= THR), 1)) { mn = m_reg; alpha = 1.f; }
    else { mn = fmaxf(m_reg, pmax); alpha = __builtin_amdgcn_exp2f((m_reg - mn) * C2); m_reg = mn; }
    const float mnL = -mn * C2;
    for (int r = 0; r < 16; ++r) p0[r] = fmaf(p0[r], C2, mnL); for (int r = 0; r < 16; ++r) p1[r] = fmaf(p1[r], C2, mnL);
    for (int r = 0; r < 16; ++r) p0[r] = __builtin_amdgcn_exp2f(p0[r]);
}
__device__ __forceinline__ void finishSM(f32x16& p0, f32x16& p1, float alpha, float& l_reg, bf16x8& pa0, bf16x8& pa1, bf16x8& pa2, bf16x8& pa3) {
    for (int r = 0; r < 16; ++r) p1[r] = __builtin_amdgcn_exp2f(p1[r]);
    float ps = 0; for (int r = 0; r < 16; ++r) ps += p0[r]; for (int r = 0; r < 16; ++r) ps += p1[r];
    { auto rr = __builtin_amdgcn_permlane32_swap(__float_as_uint(ps), __float_as_uint(ps), false, false);
      ps = __uint_as_float(rr[0]) + __uint_as_float(rr[1]); }
    l_reg = l_reg * alpha + ps;
#define PK4(P, B_, OUT) do { unsigned a0 = cvtpk(P[B_+0], P[B_+1]), a1 = cvtpk(P[B_+2], P[B_+3]);                          \
        unsigned b0 = cvtpk(P[B_+4], P[B_+5]), b1 = cvtpk(P[B_+6], P[B_+7]);                                             \
        auto r0 = __builtin_amdgcn_permlane32_swap(a0, b0, false, false); auto r1 = __builtin_amdgcn_permlane32_swap(a1, b1, false, false); \
        v4u w = {r0[0], r1[0], r0[1], r1[1]}; OUT = *reinterpret_cast<bf16x8*>(&w); } while (0)
    PK4(p0, 0, pa0); PK4(p0, 8, pa1); PK4(p1, 0, pa2); PK4(p1, 8, pa3);
#undef PK4
}
template <int KB>
__device__ __forceinline__ void qkt(f32x16& p0, f32x16& p1, const char* K_lds, int r32, int hi, const bf16x8* qr, const float* bias_t  ) {
#pragma unroll
    for (int g = 0; g < 4; ++g) { const f32x4 b0 = *(const f32x4*)(bias_t + 8 * g), b1 = *(const f32x4*)(bias_t + 32 + 8 * g);
        p0[4 * g] = b0.x; p0[4 * g + 1] = b0.y; p0[4 * g + 2] = b0.z; p0[4 * g + 3] = b0.w;
        p1[4 * g] = b1.x; p1[4 * g + 1] = b1.y; p1[4 * g + 2] = b1.z; p1[4 * g + 3] = b1.w; }
    const char* kb[4];
#pragma unroll
    for (int dd = 0; dd < 4; ++dd) kb[dd] = K_lds + KB * SHM_K + KSWZ(r32, (dd * 16 + hi * 8) * 2);
#pragma unroll
    for (int d0 = 0; d0 < 8; ++d0) { const char* a = kb[d0 & 3] + (d0 >> 2) * 128;
        bf16x8 b0 = *reinterpret_cast<const bf16x8*>(a);
        bf16x8 b1 = *reinterpret_cast<const bf16x8*>(a + 32 * 256);
        p0 = __builtin_amdgcn_mfma_f32_32x32x16_bf16(b0, qr[d0], p0, 0, 0, 0);
        p1 = __builtin_amdgcn_mfma_f32_32x32x16_bf16(b1, qr[d0], p1, 0, 0, 0); }
}
template <int VB>
__device__ __forceinline__ void pv_tile(f32x16* o, int vb0, bf16x8 pa0, bf16x8 pa1, bf16x8 pa2, bf16x8 pa3) {
#define TRRD(dst, off) asm volatile("ds_read_b64_tr_b16 %0, %1 offset:%2" : "=&v"(dst) : "v"(vb0), "i"(off) : "memory")
#define PV_D0(d0) do { s16x4 l0, l1, l2, l3, h0, h1, h2, h3; constexpr int b_ = VB * SHM_V + v_rd_off(d0, 0, 0); \
        TRRD(l0, b_); TRRD(h0, b_ + 2048); TRRD(l1, b_ + 4096); TRRD(h1, b_ + 6144); TRRD(l2, b_ + 8192); TRRD(h2, b_ + 10240); TRRD(l3, b_ + 12288); TRRD(h3, b_ + 14336); \
        asm volatile("s_waitcnt lgkmcnt(0)" ::: "memory"); SBAR();   \
        o[d0] = __builtin_amdgcn_mfma_f32_32x32x16_bf16(pa0, (bf16x8){l0[0], l0[1], l0[2], l0[3], h0[0], h0[1], h0[2], h0[3]}, o[d0], 0, 0, 0);   \
        o[d0] = __builtin_amdgcn_mfma_f32_32x32x16_bf16(pa1, (bf16x8){l1[0], l1[1], l1[2], l1[3], h1[0], h1[1], h1[2], h1[3]}, o[d0], 0, 0, 0);   \
        o[d0] = __builtin_amdgcn_mfma_f32_32x32x16_bf16(pa2, (bf16x8){l2[0], l2[1], l2[2], l2[3], h2[0], h2[1], h2[2], h2[3]}, o[d0], 0, 0, 0);   \
        o[d0] = __builtin_amdgcn_mfma_f32_32x32x16_bf16(pa3, (bf16x8){l3[0], l3[1], l3[2], l3[3], h3[0], h3[1], h3[2], h3[3]}, o[d0], 0, 0, 0); } while (0)
    PV_D0(0); PV_D0(1); PV_D0(2); PV_D0(3);
#undef PV_D0
#undef TRRD
}

struct BlockRef { const GAS char* Q; const GAS char* K; GAS char* O; const GAS char* SG; const GAS char* CB; int P0; int par; };
struct Seam { bf16x8 qr[8]; bf16x8 st_v0, st_v1, st_k0, st_k1; };
#define KVP(Kp, k0) ((Kp) + (size_t)(k0) * (PITCH * 2))
#define VMW() asm volatile("s_waitcnt vmcnt(0)" ::: "memory")
#define VMWN(n) asm volatile("s_waitcnt vmcnt(%0)" :: "i"(n) : "memory")
#define SLOAD_H(Kp, k0) do { S.st_v0 = ld8(KVP(Kp, k0) + VK_DELTA, kvo0); S.st_v1 = ld8(KVP(Kp, k0) + VK_DELTA, kvo1);              \
                         S.st_k0 = ld8(KVP(Kp, k0), kvo0); S.st_k1 = ld8(KVP(Kp, k0), kvo1); } while (0)
#define SWRITE_HK(bf) do { *(bf16x8*)(K_lds + (bf) * SHM_K + kws) = S.st_k0; *(bf16x8*)(K_lds + (bf) * SHM_K + kws + 32 * 256) = S.st_k1; } while (0)
#define SWRITE_HV(bf) do { *(bf16x8*)(V_lds + (bf) * SHM_V + vst0) = S.st_v0; *(bf16x8*)(V_lds + (bf) * SHM_V + vst1) = S.st_v1; } while (0)
#define SWRITE_H(bf) do { SWRITE_HV(bf); SWRITE_HK(bf); } while (0)
#define QLOAD(blk) do { const GAS char* qb_ = (blk).Q + (size_t)wid * (QBLK * PITCH * 2); _Pragma("unroll") for (int d0 = 0; d0 < 8; ++d0) S.qr[d0] = ld8(qb_ + d0 * 32, qvo); } while (0)
#define GATE_DMA(blk) do { const GAS char* gs_ = (blk).SG + (size_t)wid * (QBLK * PITCH * 2); _Pragma("unroll") for (int i_ = 0; i_ < 8; ++i_) \
        __builtin_amdgcn_global_load_lds((const GAS unsigned*)(gs_ + (size_t)i_ * (4 * PITCH * 2) + gvo), (LAS unsigned*)(lds + GATE_OFF + wid * 8192 + i_ * 1024), 16, 0, 0); } while (0)
#define BIAS_DMA(blk) __builtin_amdgcn_global_load_lds((const GAS unsigned*)((blk).CB + wid * 1024 + bvo), (LAS unsigned*)(lds + BIAS_OFF + (blk).par * (SEQ * 4) + wid * 1024), 16, 0, 0)
__device__ __forceinline__ void fox_prime(const BlockRef& cur, char* lds, Seam& S, const int tid) {
    const int wid = __builtin_amdgcn_readfirstlane(tid >> 6), lane = tid & 63, r32 = lane & 31, hi = lane >> 5;
    const int sr = tid >> 4, sc = (tid & 15) * 8, kws = KSWZ(sr, sc * 2); char* K_lds = lds + 2 * SHM_V;
    unsigned kvo0 = (unsigned)(sr * PITCH + sc) * 2u, kvo1 = kvo0 + 32u * PITCH * 2u, qvo = (unsigned)(r32 * PITCH + hi * 8) * 2u, bvo = (unsigned)(lane * 16), gvo = (unsigned)((lane >> 4) * (PITCH * 2) + (lane & 15) * 16);
    asm volatile("" : "+v"(kvo0), "+v"(kvo1), "+v"(qvo), "+v"(bvo), "+v"(gvo));
    BIAS_DMA(cur); GATE_DMA(cur);
    QLOAD(cur);
    SLOAD_H(cur.K, 0); VMW(); SWRITE_HK(0);
    __syncthreads();
}
__device__ __forceinline__ void fox_block(const BlockRef& cur, const BlockRef& nxt, char* lds, Seam& S, const int tid) {
    const int wid = __builtin_amdgcn_readfirstlane(tid >> 6), lane = tid & 63, r32 = lane & 31, hi = lane >> 5;
    const int NT = (cur.P0 + QB - 1) / KVBLK + 1;
    const int qlo = cur.P0 + wid * QBLK, qm = qlo + r32 - 4 * hi;
    char* V_lds = lds; char* K_lds = lds + 2 * SHM_V;
    float* ws = (float*)(lds + WS_OFF) + wid * 64; float* li_l = ws, * al_l = ws + 32;
    const float* bias_l = (const float*)(lds + BIAS_OFF + cur.par * (SEQ * 4)) + 4 * hi;
    float m_reg = -1e30f, l_reg = 0; f32x16 o[4] = {};
    const int sr = tid >> 4, sc = (tid & 15) * 8, vst0 = v_st(sr, sc), vst1 = v_st(32 + sr, sc), kws = KSWZ(sr, sc * 2);
    const int vb0 = (int)(uintptr_t)V_lds + v_rd_base(lane);
    const GAS char* Kh = cur.K;
    unsigned kvo0 = (unsigned)(sr * PITCH + sc) * 2u, kvo1 = kvo0 + 32u * PITCH * 2u, qvo = (unsigned)(r32 * PITCH + hi * 8) * 2u, bvo = (unsigned)(lane * 16), gvo = (unsigned)((lane >> 4) * (PITCH * 2) + (lane & 15) * 16);
    asm volatile("" : "+v"(kvo0), "+v"(kvo1), "+v"(qvo), "+v"(bvo), "+v"(gvo));
#define RESC(a) do { if (__any((a) < 1.f)) { if (hi == 0) al_l[r32] = (a); asm volatile("s_waitcnt lgkmcnt(0)" ::: "memory");              \
                     for (int d_ = 0; d_ < 4; ++d_) for (int r = 0; r < 16; ++r) o[d_][r] *= al_l[crow(r, hi)]; } } while (0)
#define KBASE(t) ((t) * KVBLK)
#define MASKT(P0_, P1_, t) do { const int kb_ = KBASE(t); if (kb_ + KVBLK - 1 > qlo) mask_tile(P0_, P1_, qm - kb_); } while (0)
    constexpr int NQL = 8;
#define SEAM_K0() do { VMWN(NQL); SWRITE_HK(0); SBAR(); } while (0)
    f32x16 pA0, pA1, pB0, pB1; float mnA, mnB, alA, alB; bf16x8 pa0, pa1, pa2, pa3;
    SWRITE_HV(0); SBAR();
    if (NT > 1) { SLOAD_H(Kh, KBASE(1)); }
    SBAR(); qkt<0>(pA0, pA1, K_lds, r32, hi, S.qr, bias_l + KBASE(0));
    MASKT(pA0, pA1, 0); partialSM(pA0, pA1, m_reg, mnA, alA);
    if (NT > 1) { VMW(); SWRITE_H(1); }
    __syncthreads();
#define HALF_STEP(PX0, PX1, mnX, alX, PY0, PY1, alY, t, KB, VB, SB) do {                                                      \
        SBAR(); qkt<KB>(PX0, PX1, K_lds, r32, hi, S.qr, bias_l + KBASE(t));                                                   \
        finishSM(PY0, PY1, alY, l_reg, pa0, pa1, pa2, pa3); SBAR();                                                           \
        if ((t) + 1 < NT) { SLOAD_H(Kh, KBASE((t) + 1)); SBAR(); }                                                        \
        pv_tile<VB>(o, vb0, pa0, pa1, pa2, pa3); MASKT(PX0, PX1, (t)); partialSM(PX0, PX1, m_reg, mnX, alX);                  \
        __syncthreads();                                                                                                      \
        if ((t) + 1 < NT) { VMW(); SWRITE_H(SB); }                                                                            \
        RESC(alX); __syncthreads(); } while (0)
    for (int t = 1; t + 1 < NT; t += 2) {
        HALF_STEP(pB0, pB1, mnB, alB, pA0, pA1, alA, t, 1, 0, 0);
        HALF_STEP(pA0, pA1, mnA, alA, pB0, pB1, alB, t + 1, 0, 1, 1);
    }
    const bool even = (NT & 1) == 0;
    if (even) { SBAR(); qkt<1>(pB0, pB1, K_lds, r32, hi, S.qr, bias_l + KBASE(NT - 1)); SBAR(); }
    BIAS_DMA(nxt);
    SLOAD_H(nxt.K, 0); SBAR();
    QLOAD(nxt);
    SBAR();
    finishSM(pA0, pA1, alA, l_reg, pa0, pa1, pa2, pa3); SBAR();
    pv_tile<0>(o, vb0, pa0, pa1, pa2, pa3);
    if (even) { MASKT(pB0, pB1, NT - 1); partialSM(pB0, pB1, m_reg, mnB, alB); __syncthreads(); RESC(alB);
        finishSM(pB0, pB1, alB, l_reg, pa0, pa1, pa2, pa3); SBAR(); pv_tile<1>(o, vb0, pa0, pa1, pa2, pa3); }
    SBAR(); SEAM_K0();
    if (hi == 0) li_l[r32] = l_reg; asm volatile("s_waitcnt lgkmcnt(0)" ::: "memory");
    float rli[16];
#pragma unroll
    for (int r = 0; r < 16; ++r) rli[r] = __builtin_amdgcn_rcpf(li_l[crow(r, hi)]);
    const char* gate_l = lds + GATE_OFF + wid * 8192 + (4 * hi) * 256 + r32 * 2;
    GAS char* Ow = cur.O + (size_t)wid * (QBLK * PITCH * 2); unsigned ovo = (unsigned)(4 * hi * PITCH + r32) * 2u; asm volatile("" : "+v"(ovo));
#pragma unroll
    for (int r = 0; r < 16; ++r) { GAS char* Or = Ow + (size_t)((r & 3) + 8 * (r >> 2)) * (PITCH * 2);
#pragma unroll
        for (int d0 = 0; d0 < 4; ++d0) { const float v = o[d0][r] * rli[r];
            const float vn = __shfl_xor(v, 1);
            if ((r32 & 1) == 0) { const unsigned gg = *(const unsigned*)(gate_l + ((r & 3) + 8 * (r >> 2)) * 256 + d0 * 64);
                *(GAS unsigned*)(Or + d0 * 64 + ovo) = cvtpk(v * pg8::bf_lo(gg), vn * pg8::bf_hi(gg)); } } }
    asm volatile("s_waitcnt lgkmcnt(0)" ::: "memory"); SBAR();
    GATE_DMA(nxt);
    __syncthreads();
#undef RESC
#undef KBASE
#undef MASKT
#undef SEAM_K0
#undef HALF_STEP
}
#undef KVP
#undef QLOAD
#undef VMW
#undef VMWN
#undef SLOAD_H
#undef SWRITE_HK
#undef SWRITE_HV
#undef SWRITE_H
#undef BIAS_DMA
#undef GATE_DMA

struct Tens { const bf16* Q; const bf16* K; bf16* O; const bf16* SG; const float* CB; };
__device__ __forceinline__ BlockRef fox_ref(const Tens& T, int L, int pass, int seq_no) {
    const int xcd = L & 7, k = L >> 3, bh = (k >> 2) * 8 + xcd, x = k & 3, qb = pass ? 7 - x : x, b = bh >> 4, h = bh & 15;
    BlockRef r; const size_t hoff = (size_t)b * SEQ * PITCH + h * AD, qoff = hoff + (size_t)qb * QB * PITCH;
    r.Q = (const GAS char*)(T.Q + qoff); r.O = (GAS char*)(T.O + qoff); r.SG = (const GAS char*)(T.SG + qoff); r.K = (const GAS char*)(T.K + hoff); r.CB = (const GAS char*)(T.CB + (size_t)bh * SEQ); r.P0 = qb * QB; r.par = seq_no & 1;
    return r;
}
__device__ __forceinline__ void fox_phase(char* lds, const Tens& T, int G, int c, const int tid) {
    constexpr int total = NB * NH * 4;
    int L = c; if (L >= total) return;
    int pass = 0, seq = 0;
    BlockRef cur = fox_ref(T, L, 0, 0);
    Seam S;
    fox_prime(cur, lds, S, tid);
    for (;;) {
        const bool more_pass = pass == 0, more_item = L + G < total, last = !more_pass && !more_item;
        int passn = pass + 1, Ln = L;
        if (!more_pass) { passn = 0; Ln = more_item ? L + G : L; }
        const BlockRef nxt = fox_ref(T, Ln, passn, seq + 1);
        fox_block(cur, nxt, lds, S, tid);
        if (last) break;
        cur = nxt; pass = passn; L = Ln; ++seq;
    }
}
}

__device__ __forceinline__ float log_sigmoid_(float x) { return x >= 0.f ? -log1pf(expf(-x)) : x - log1pf(expf(x)); }
struct RowArgs {
    const bf16* Hin; const bf16* YP; float* Hout; const float* gain; bf16* HN; float* out;
    const bf16* Wsk; const float* b0; const float* b1;
    unsigned* cnt; int* tokl; float* pw; float* LF; float* tokw; float* tokr;
    const float* SS; float* RSTD;
};
template <int MODE>
__device__ __forceinline__ void row_phase(Frame& F, const RowArgs& A) {
    constexpr int NCT = (MODE == 1) ? 3 : 1, LGP = NCT * 32, RU = (MODE == 1) ? 4 : 2;
    LAS float* PB = (LAS float*)(F.lds + RING_OFF);
    LAS float* LG = PB + 64 * LGP;
    for (int blk = blockIdx.x; blk < M / 64; blk += F.G) {
        const int r0 = blk * 64;
        if constexpr (MODE >= 2)
        for (int k0 = 0; k0 < 8; k0 += RU) {
            f32x4 v[RU][8];
#pragma unroll
            for (int u = 0; u < RU; ++u) { const GAS v2u* xr = (const GAS v2u*)(A.Hin + (size_t)(r0 + F.wave * 8 + k0 + u) * D) + F.lane;
#pragma unroll
                for (int j = 0; j < 8; ++j) { const v2u hb = xr[64 * j]; v[u][j].x = bf_lo(hb.x); v[u][j].y = bf_hi(hb.x); v[u][j].z = bf_lo(hb.y); v[u][j].w = bf_hi(hb.y); } }
            if constexpr (MODE >= 2) {
                v2u ya[RU][8], yb[RU][8];
#pragma unroll
                for (int u = 0; u < RU; ++u) { const int row = r0 + F.wave * 8 + k0 + u;
                    const GAS v2u* y0 = (const GAS v2u*)(A.YP + (size_t)(2 * row) * D) + F.lane; const GAS v2u* y1 = (const GAS v2u*)(A.YP + (size_t)(2 * row + 1) * D) + F.lane;
#pragma unroll
                    for (int j = 0; j < 8; ++j) { ya[u][j] = y0[64 * j]; yb[u][j] = y1[64 * j]; } }
#pragma unroll
                for (int u = 0; u < RU; ++u)
#pragma unroll
                    for (int j = 0; j < 8; ++j) { const v2u a = ya[u][j], b = yb[u][j];
                        v[u][j].x += bf_lo(a.x) + bf_lo(b.x); v[u][j].y += bf_hi(a.x) + bf_hi(b.x); v[u][j].z += bf_lo(a.y) + bf_lo(b.y); v[u][j].w += bf_hi(a.y) + bf_hi(b.y); }
            }
#pragma unroll
            for (int u = 0; u < RU; ++u) {
                const int row = r0 + F.wave * 8 + k0 + u;
                float s = 0.f;
#pragma unroll
                for (int j = 0; j < 8; ++j) s += (v[u][j].x * v[u][j].x + v[u][j].y * v[u][j].y) + (v[u][j].z * v[u][j].z + v[u][j].w * v[u][j].w);
                const float rstd = 1.f / sqrtf(wave_sum(s) * (1.f / D) + RMS_EPS);
                const GAS f32x4* gr = (const GAS f32x4*)A.gain + F.lane;
                if constexpr (MODE == 3) { GAS f32x4* o = (GAS f32x4*)(A.out + (size_t)row * D) + F.lane;
#pragma unroll
                    for (int j = 0; j < 8; ++j) { const f32x4 g = gr[64 * j]; f32x4 w; w.x = v[u][j].x * rstd * g.x; w.y = v[u][j].y * rstd * g.y; w.z = v[u][j].z * rstd * g.z; w.w = v[u][j].w * rstd * g.w; __builtin_nontemporal_store(w, o + 64 * j); } }
                else { GAS v2u* o8 = (GAS v2u*)(A.HN + (size_t)row * D) + F.lane;
#pragma unroll
                    for (int j = 0; j < 8; ++j) { const f32x4 g = gr[64 * j]; v2u w; w.x = pk2(v[u][j].x * rstd * g.x, v[u][j].y * rstd * g.y); w.y = pk2(v[u][j].z * rstd * g.z, v[u][j].w * rstd * g.w); o8[64 * j] = w; } }
            }
        }
        if constexpr (MODE == 1 || MODE == 2) {
            LAS float* RS_l = PB + 4 * 64 * LGP;
            if constexpr (MODE == 1) { if (F.tid < 64) { const GAS f32x4* ss = (const GAS f32x4*)(A.SS + (size_t)(r0 + F.tid) * 32); float t = 0.f;
#pragma unroll
                    for (int j = 0; j < 8; ++j) { const f32x4 q = ss[j]; t += (q.x + q.y) + (q.z + q.w); }
                    const float rs = 1.f / sqrtf(t * (1.f / D) + RMS_EPS); RS_l[F.tid] = rs; A.RSTD[r0 + F.tid] = rs; } }
            VM_WAIT(); __syncthreads();
            const int r32 = F.lane & 31, hi = F.lane >> 5;
            f32x16 acc[2][NCT];
#pragma unroll
            for (int rt = 0; rt < 2; ++rt)
#pragma unroll
                for (int ct = 0; ct < NCT; ++ct) acc[rt][ct] = (f32x16){};
            {
                const bf16* ap = (MODE == 1 ? A.Hin : A.HN) + (size_t)(r0 + r32) * D + F.wave * 256 + 8 * hi;
                const bf16* bp = A.Wsk + (size_t)r32 * D + F.wave * 256 + 8 * hi;
                constexpr int QB = (MODE == 1) ? 4 : 8;
#pragma unroll 1
                for (int kb = 0; kb < 16 / QB; ++kb) {
                    bf16x8 af[2][QB], bfr[NCT][QB];
#pragma unroll
                    for (int q = 0; q < QB; ++q) {
#pragma unroll
                        for (int rt = 0; rt < 2; ++rt) af[rt][q] = *(const GAS bf16x8*)(ap + (size_t)rt * 32 * D + (kb * QB + q) * 16);
#pragma unroll
                        for (int ct = 0; ct < NCT; ++ct) bfr[ct][q] = *(const GAS bf16x8*)(bp + (size_t)ct * 32 * D + (kb * QB + q) * 16); }
#pragma unroll
                    for (int q = 0; q < QB; ++q)
#pragma unroll
                        for (int rt = 0; rt < 2; ++rt)
#pragma unroll
                            for (int ct = 0; ct < NCT; ++ct) acc[rt][ct] = __builtin_amdgcn_mfma_f32_32x32x16_bf16(af[rt][q], bfr[ct][q], acc[rt][ct], 0, 0, 0);
                }
            }
#define RP_STORE(buf) do { _Pragma("unroll") for (int rt = 0; rt < 2; ++rt) _Pragma("unroll") for (int ct = 0; ct < NCT; ++ct) _Pragma("unroll") for (int r = 0; r < 16; ++r) \
                (buf)[(rt * 32 + (r & 3) + 8 * (r >> 2) + 4 * hi) * LGP + ct * 32 + r32] = acc[rt][ct][r]; } while (0)
#define RP_ADD(buf) do { _Pragma("unroll") for (int rt = 0; rt < 2; ++rt) _Pragma("unroll") for (int ct = 0; ct < NCT; ++ct) _Pragma("unroll") for (int r = 0; r < 16; ++r) \
                acc[rt][ct][r] += (buf)[(rt * 32 + (r & 3) + 8 * (r >> 2) + 4 * hi) * LGP + ct * 32 + r32]; } while (0)
            if (F.wave >= 4) RP_STORE(PB + (F.wave - 4) * 64 * LGP);
            LDS_WAIT(); __syncthreads();
            if (F.wave < 4) RP_ADD(PB + F.wave * 64 * LGP);
            LDS_WAIT(); __syncthreads();
            if (F.wave == 2 || F.wave == 3) RP_STORE(PB + (F.wave - 2) * 64 * LGP);
            LDS_WAIT(); __syncthreads();
            if (F.wave < 2) RP_ADD(PB + F.wave * 64 * LGP);
            LDS_WAIT(); __syncthreads();
            if (F.wave == 1) RP_STORE(PB);
            LDS_WAIT(); __syncthreads();
            if (F.wave == 0) { RP_ADD(PB); RP_STORE(LG); }
            LDS_WAIT(); __syncthreads();
#undef RP_STORE
#undef RP_ADD
            if constexpr (MODE == 1) {
                if (F.tid < 64) {
                    const int tok = r0 + F.tid; const LAS float* lg = LG + F.tid * LGP;
                    float gl[8]; const float rs = RS_l[F.tid];
#pragma unroll
                    for (int i = 0; i < 8; ++i) gl[i] = lg[i] * rs + A.b0[i];
                    int gs = 0; float gm = gl[0];
#pragma unroll
                    for (int i = 1; i < 8; ++i) if (gl[i] > gm) { gm = gl[i]; gs = i; }
                    float den = 0.f;
#pragma unroll
                    for (int i = 0; i < 8; ++i) den += expf(gl[i] - gm);
                    const float pg = 1.f / den;
                    float el[8];
#pragma unroll
                    for (int i = 0; i < 8; ++i) el[i] = lg[8 + gs * 8 + i] * rs + A.b1[gs * 8 + i];
                    int i0 = 0; float t0 = el[0];
#pragma unroll
                    for (int i = 1; i < 8; ++i) if (el[i] > t0) { t0 = el[i]; i0 = i; }
                    int i1 = 0; float t1 = -__builtin_inff();
#pragma unroll
                    for (int i = 0; i < 8; ++i) if (i != i0 && el[i] > t1) { t1 = el[i]; i1 = i; }
                    const float w0 = pg / (1.f + expf(t1 - t0)), w1 = pg - w0;
                    const int e0 = gs * 8 + i0, e1 = gs * 8 + i1;
                    const unsigned p0 = __hip_atomic_fetch_add(A.cnt + e0, 1u, RLX_AGENT), p1 = __hip_atomic_fetch_add(A.cnt + e1, 1u, RLX_AGENT);
                    A.tokl[(size_t)e0 * M + p0] = 2 * tok; A.tokl[(size_t)e1 * M + p1] = 2 * tok + 1;
                    A.tokw[(size_t)e0 * M + p0] = w0; A.tokw[(size_t)e1 * M + p1] = w1; A.tokr[(size_t)e0 * M + p0] = rs; A.tokr[(size_t)e1 * M + p1] = rs;
                    A.pw[2 * tok] = w0; A.pw[2 * tok + 1] = w1;
                }
            } else {
#pragma unroll
                for (int q = 0; q < 2; ++q) { const int idx = F.tid + q * 512, tl = idx >> 4, h = idx & 15;
                    A.LF[(size_t)(r0 + tl) * 16 + h] = log_sigmoid_(LG[tl * LGP + h] + A.b0[h]); }
            }
            __syncthreads();
        }
    }
}
__device__ __forceinline__ void cumsum_phase(Frame& F, const float* LF, float* CUMB) {
    LAS float* wt = (LAS float*)(F.lds + RING_OFF);
    for (int bh = blockIdx.x; bh < NB * NH; bh += F.G) {
        const int b = bh >> 4, h = bh & 15, s0 = 4 * F.tid;
        float c0 = LF[(size_t)(b * SEQ + s0) * 16 + h], c1 = c0 + LF[(size_t)(b * SEQ + s0 + 1) * 16 + h], c2 = c1 + LF[(size_t)(b * SEQ + s0 + 2) * 16 + h], c3 = c2 + LF[(size_t)(b * SEQ + s0 + 3) * 16 + h];
        float incl = c3;
#pragma unroll
        for (int o = 1; o < 64; o <<= 1) { const float t = __shfl_up(incl, o); if (F.lane >= o) incl += t; }
        if (F.lane == 63) wt[F.wave] = incl;
        LDS_WAIT(); __syncthreads();
        float off = incl - c3;
        for (int w = 0; w < F.wave; ++w) off += wt[w];
        const float sc = -1.f / fox::SCALE;
        f32x4 o4; o4.x = (off + c0) * sc; o4.y = (off + c1) * sc; o4.z = (off + c2) * sc; o4.w = (off + c3) * sc;
        *(GAS f32x4*)(CUMB + (size_t)bh * SEQ + s0) = o4;
        __syncthreads();
    }
}
__device__ __forceinline__ MoeTab moe_tables(Frame& F, const unsigned* cnt) {
    LAS int* base = (LAS int*)(F.lds + MOE_OFF);
    LAS int* cnt_l = base; LAS int* tstart = base + 64; LAS int* ntile = base + 128; LAS int* Tw = base + 192; LAS int* mt_e = base + 196; LAS int* mt_row0 = base + 196 + MAXMT;
    __syncthreads();
    if (F.tid < 64) {
        const int c = (int)__hip_atomic_load(cnt + F.tid, RLX_AGENT); const int nt = (c + 255) >> 8;
        int incl = nt;
#pragma unroll
        for (int o = 1; o < 64; o <<= 1) { const int t = __shfl_up(incl, o); if (F.lane >= o) incl += t; }
        cnt_l[F.tid] = c; tstart[F.tid] = incl - nt; ntile[F.tid] = nt; if (F.tid == 63) Tw[0] = incl;
    }
    LDS_WAIT(); __syncthreads();
    const int T = Tw[0];
    for (int mt = F.tid; mt < T; mt += NWAVES * 64) { int e = 0;
        for (int k = 0; k < 64; ++k) e += (tstart[k] + ntile[k] <= mt) ? 1 : 0;
        e = e > 63 ? 63 : e; mt_e[mt] = e; mt_row0[mt] = (mt - tstart[e]) * 256; }
    LDS_WAIT(); __syncthreads();
    MoeTab t; t.cnt = cnt_l; t.mt_e = mt_e; t.mt_row0 = mt_row0; t.T = T; return t;
}

#ifndef MK_PER_PHASE
#define MK_PER_PHASE 0
#endif
constexpr int NPHASE = 17;
__global__ void __launch_bounds__(NWAVES * 64, 2) hybrid_fwd(Args args) {
    extern __shared__ __attribute__((aligned(16))) unsigned char lds[];
    Frame F;
    F.lds = (LAS unsigned char*)lds;
    F.MISC = (volatile LAS unsigned*)(F.lds + MISC_OFF);
    F.tid = threadIdx.x; F.lane = F.tid & 63; F.wave = __builtin_amdgcn_readfirstlane(F.tid >> 6);
    const int wave0 = F.wave;
    F.G = gridDim.x; { const int bx = blockIdx.x; F.vcu = (F.G % 8 == 0) ? (bx % 8) * (F.G / 8) + bx / 8 : bx; }
    F.ws = args.ws;
    F.ctl = (gu32*)(args.ws + WS_CTL);
    for (int u = F.tid; u < (LDS_BYTES - LDSCTL_OFF) / 4; u += NWAVES * 64) ((LAS unsigned*)(F.lds + LDSCTL_OFF))[u] = 0u;
    __syncthreads();
    XcdBarrier bar; bar.bar = (unsigned*)(F.ctl + CW_BAR); bar.x = 0; bar.st = nullptr;
    if (!MK_PER_PHASE) bar = xcd_barrier_post((unsigned*)(F.ctl + CW_BAR), F.MISC + 8);
#define GRID_BAR() do { if (MK_PER_PHASE) { if (F.tid == 0) __hip_atomic_store(F.ctl + CW_TMO, 0xBADBA0u, RLX_AGENT); } else { XcdBarrier bb_ = bar; asm volatile("" : "+s"(bb_.bar)); xcd_barrier(bb_, F.tid); } } while (0)
    const int lo = args.ph_lo, hi = args.ph_hi; (void)lo; (void)hi;
#ifndef PH_MASK
#define PH_MASK 0x1ffff
#endif
#if MK_PER_PHASE
#define IN(k) ((((PH_MASK) >> (k)) & 1) && lo <= (k) && (k) < hi)
#else
#define IN(k) ((((PH_MASK) >> (k)) & 1) != 0)
#endif
#define BOTH(k) (IN(k) && IN((k) + 1))
    const int G = F.G, cid = (int)blockIdx.x, cls = ((int)blockIdx.x >> 3) & 1;
#define pHN ((bf16*)(ws + WS_HN))
#define pUA ((bf16*)(ws + WS_UA))
#define pGL ((bf16*)(ws + WS_GL))
#define pOG ((bf16*)(ws + WS_OG))
#define pH2 ((float*)(ws + WS_H2))
#define pHB ((bf16*)(ws + WS_H2 + 64 * MiB))
#define pYP ((bf16*)(ws + WS_YP))
#define pHID ((bf16*)(ws + WS_HID))
#define pTOKL ((int*)(ws + WS_TOKL))
#define pPW ((float*)(ws + WS_PW))
#define pSS ((float*)(ws + WS_SS))
#define pRSTD ((float*)(ws + WS_RSTD))
#define PH() unsigned char* ws; { int l_; asm volatile("v_mbcnt_lo_u32_b32 %0, -1, 0\n\tv_mbcnt_hi_u32_b32 %0, -1, %0" : "=v"(l_)); F.lane = l_; F.wave = wave0; F.tid = wave0 * 64 + l_; \
    unsigned wl_ = __builtin_amdgcn_readfirstlane((unsigned)(uintptr_t)args.ws), wh_ = __builtin_amdgcn_readfirstlane((unsigned)((uintptr_t)args.ws >> 32)); asm volatile("" : "+s"(wl_), "+s"(wh_)); ws = (unsigned char*)(((uintptr_t)wh_ << 32) | wl_); F.ws = ws; }
    if (IN(0)) { PH(); p0_prologue(F, args, ws); if (BOTH(0)) GRID_BAR(); }
    if (IN(1)) { PH(); SchedDense S; S.init(pHN, D, ws + WS_WS5IN, D, M / 256, DS / 256, G, cid); EpiU E{pUA};
        if (cls == 0) { moe_conv(F, args, ws, 0, 0, 3); __syncthreads(); } pg8::gemm_phase<EpiU, SchedDense, true>(F.lds + RING_OFF, F.tid, D, D, D, S, E); if (cls == 1) { __syncthreads(); moe_conv(F, args, ws, 0, 0, 3); } if (BOTH(1)) GRID_BAR(); }
    if (IN(2)) { PH(); SchedS5<1> S; S.init(pUA, ws + WS_PT, 256, 512, G, cid); EpiScan E{pUA, (const float*)(ws + WS_AL)};
        pg8::gemm_phase<EpiScan, SchedS5<1>, false>(F.lds + RING_OFF, F.tid, 512, KP, 512, S, E);
        if (G > 2 * NG && cid >= 2 * NG) conv_range<2>(F, args, ws, 0, CONV_TOTAL_FOX, (cid - 2 * NG) * NWAVES + F.wave, (G - 2 * NG) * NWAVES);
        if (BOTH(2)) GRID_BAR(); }
    if (IN(3)) { PH(); SchedS5<2> S; S.init(pUA, ws + WS_TT, 512, KP, G, cid); EpiY E{pUA, args.in[9], pGL};
        if (G <= 2 * NG && cls == 0) { conv_run<2>(F, args, ws, 0, 1); __syncthreads(); } pg8::gemm_phase<EpiY, SchedS5<2>, true>(F.lds + RING_OFF, F.tid, KP, KP, KP, S, E); if (G <= 2 * NG && cls == 1) { __syncthreads(); conv_run<2>(F, args, ws, 0, 1); } if (BOTH(3)) GRID_BAR(); }
    if (IN(4)) { PH(); SchedDense S; S.init(pGL, DS, ws + WS_WGLU, DS, M / 256, DS / 256, G, cid); EpiGlu E{pGL, args.in[12], pOG};
        if (cls == 0) { moe_conv(F, args, ws, 0, 1, 3); __syncthreads(); } pg8::gemm_phase<EpiGlu, SchedDense, true>(F.lds + RING_OFF, F.tid, DS, DS, DS, S, E); if (cls == 1) { __syncthreads(); moe_conv(F, args, ws, 0, 1, 3); } if (BOTH(4)) GRID_BAR(); }
    if (IN(5)) { PH(); SchedDense S; S.init(pOG, DS, ws + WS_WS5OUT, DS, M / 256, D / 256, G, cid); EpiResB E{args.in[0], pHB, pSS};
        if (cls == 0) { moe_conv(F, args, ws, 0, 2, 3); __syncthreads(); } pg8::gemm_phase<EpiResB, SchedDense, true>(F.lds + RING_OFF, F.tid, DS, DS, DS, S, E); if (cls == 1) { __syncthreads(); moe_conv(F, args, ws, 0, 2, 3); } if (BOTH(5)) GRID_BAR(); }

    {
        constexpr int pR = 6;
        unsigned* const cnt = (unsigned*)(F.ctl + CW_CNT) + 0;
        if (IN(pR)) { PH(); RowArgs A{}; A.Hin = pHB; A.gain = args.in[14]; A.HN = pHN; A.Wsk = (const bf16*)(ws + WS_WR) + (size_t)0 * (256 * 1024); A.b0 = args.in[16]; A.b1 = args.in[18];
            A.cnt = cnt; A.tokl = pTOKL; A.pw = pPW; A.SS = pSS; A.RSTD = pRSTD; A.tokw = (float*)(ws + WS_TOKW); A.tokr = (float*)(ws + WS_TOKR);
            row_phase<1>(F, A); if (BOTH(pR)) GRID_BAR(); }
        if (IN(pR + 1)) { PH(); const MoeTab tab = moe_tables(F, cnt);
            const int nwg_ = tab.T * 4, R_ = (nwg_ + G - 1) / G, Gp = (nwg_ + R_ - 1) / R_, nfree = G - Gp;
            constexpr int IPW = 64;
            const int npre_ = nfree * NWAVES * IPW < CONV_TOTAL_MOE ? nfree * NWAVES * IPW : CONV_TOTAL_MOE;
            if (cid == 0 && F.tid == 0) __hip_atomic_store(F.ctl + CW_NPRE, (unsigned)npre_, RLX_AGENT);
            if (cid < Gp) {
            SchedMoeGU S; S.T.init(tab.T, 4, Gp, cid); S.tab = tab; S.HN = (const char*)pHB; S.W = (const char*)(ws + WS_WGU) + (size_t)0 * NE * 1024 * D * 2; S.tokl = pTOKL; S.tid = F.tid;
            EpiGU E{pHID, tab, (const float*)(ws + WS_TOKR)};
            pg8::gemm_phase<EpiGU, SchedMoeGU, true>(F.lds + RING_OFF, F.tid, D, D, D, S, E);
            } else { conv_range<1>(F, args, ws, 0, npre_, (cid - Gp) * NWAVES + F.wave, nfree * NWAVES); }
            if (BOTH(pR + 1)) GRID_BAR(); }
        if (IN(pR + 2)) { PH(); const MoeTab tab = moe_tables(F, cnt);
            SchedMoeDN S; S.T.init(tab.T, 8, G, cid); S.T.split = 1;   S.tab = tab; S.HID = (const char*)pHID; S.W = (const char*)(ws + WS_WDN) + (size_t)0 * NE * D * DE * 2;
            EpiDN E{tab, pTOKL, (const float*)(ws + WS_TOKW), pYP};
            pg8::gemm_phase<EpiDN, SchedMoeDN, true>(F.lds + RING_OFF, F.tid, DE, DE, DE, S, E); if (BOTH(pR + 2)) GRID_BAR(); }
        }
    {
            if (IN(9)) { PH(); RowArgs A{}; A.Hin = pHB; A.YP = pYP; A.gain = args.in[22]; A.HN = pHN; A.Wsk = (const bf16*)(ws + WS_WF); A.b0 = args.in[24]; A.LF = (float*)(ws + WS_LF);
                row_phase<2>(F, A); if (BOTH(9)) GRID_BAR(); }
            if (IN(10)) { { PH(); cumsum_phase(F, (const float*)(ws + WS_LF), (float*)(ws + WS_CUMB)); }
#pragma unroll 1
                for (int seg = 0; seg < 2; ++seg) { PH();
                    const int split_ = 2 * (int)((blockIdx.x >> 3) & 3);
                    SchedDense S; S.init(pHN, D, ws + WS_WFOXIN, D, M / 256, 4 * D / 256, G, cid); EpiQKVG E{(bf16*)(ws + WS_Q), (size_t)(WS_K - WS_Q) / 2};
                    S.i_begin = seg ? split_ : 0; S.i_end = seg ? (1 << 30) : split_;
                    pg8::gemm_phase<EpiQKVG, SchedDense, true>(F.lds + RING_OFF, F.tid, D, D, D, S, E);
                    if (seg == 0) { asm volatile("s_waitcnt vmcnt(0)" ::: "memory"); __syncthreads();
                        const int npre_ = (int)__hip_atomic_load(F.ctl + CW_NPRE, RLX_AGENT), gw_ = F.vcu * NWAVES + F.wave;
                        conv_range<1>(F, args, ws, npre_, npre_ + (CONV_TOTAL_MOE - npre_) / 2, gw_, G * NWAVES); __syncthreads(); } }
                if (BOTH(10)) GRID_BAR(); }
            if (IN(11)) { PH(); static_assert(WS_V - WS_K == fox::VK_DELTA, "V = K + 64 MiB");
                const fox::Tens T{(const bf16*)(ws + WS_Q), (const bf16*)(ws + WS_K), (bf16*)(ws + WS_Q), (const bf16*)(ws + WS_SG), (const float*)(ws + WS_CUMB)};
                const int npre_ = (int)__hip_atomic_load(F.ctl + CW_NPRE, RLX_AGENT), gw_ = F.vcu * NWAVES + F.wave, mid_ = npre_ + (CONV_TOTAL_MOE - npre_) / 2;
                if (cls == 0) { conv_range<1>(F, args, ws, mid_, CONV_TOTAL_MOE, gw_, G * NWAVES); __syncthreads(); }
                fox::fox_phase((char*)lds + RING_OFF, T, G, cid, F.tid);
                if (cls == 1) { asm volatile("s_waitcnt vmcnt(0)" ::: "memory"); __syncthreads(); conv_range<1>(F, args, ws, mid_, CONV_TOTAL_MOE, gw_, G * NWAVES); }
                if (BOTH(11)) GRID_BAR(); }
            if (IN(12)) { PH(); SchedDense S; S.init(ws + WS_Q, D, ws + WS_WFOXOUT, D, M / 256, D / 256, G, cid); EpiResYPB E{pHB, pYP, pSS};
                pg8::gemm_phase<EpiResYPB, SchedDense, true>(F.lds + RING_OFF, F.tid, D, D, D, S, E); if (BOTH(12)) GRID_BAR(); }
            }
    {
        constexpr int pR = 13;
        unsigned* const cnt = (unsigned*)(F.ctl + CW_CNT) + 64;
        if (IN(pR)) { PH(); RowArgs A{}; A.Hin = pHB; A.gain = args.in[26]; A.HN = pHN; A.Wsk = (const bf16*)(ws + WS_WR) + (size_t)1 * (256 * 1024); A.b0 = args.in[28]; A.b1 = args.in[30];
            A.cnt = cnt; A.tokl = pTOKL; A.pw = pPW; A.SS = pSS; A.RSTD = pRSTD; A.tokw = (float*)(ws + WS_TOKW); A.tokr = (float*)(ws + WS_TOKR);
            row_phase<1>(F, A); if (BOTH(pR)) GRID_BAR(); }
        if (IN(pR + 1)) { PH(); const MoeTab tab = moe_tables(F, cnt);
            SchedMoeGU S; S.T.init(tab.T, 4, G, cid); S.T.split = 1;   S.tab = tab; S.HN = (const char*)pHB; S.W = (const char*)(ws + WS_WGU) + (size_t)1 * NE * 1024 * D * 2; S.tokl = pTOKL; S.tid = F.tid;
            EpiGU E{pHID, tab, (const float*)(ws + WS_TOKR)};
            pg8::gemm_phase<EpiGU, SchedMoeGU, true>(F.lds + RING_OFF, F.tid, D, D, D, S, E); if (BOTH(pR + 1)) GRID_BAR(); }
        if (IN(pR + 2)) { PH(); const MoeTab tab = moe_tables(F, cnt);
            SchedMoeDN S; S.T.init(tab.T, 8, G, cid); S.T.split = 1;   S.tab = tab; S.HID = (const char*)pHID; S.W = (const char*)(ws + WS_WDN) + (size_t)1 * NE * D * DE * 2;
            EpiDN E{tab, pTOKL, (const float*)(ws + WS_TOKW), pYP};
            pg8::gemm_phase<EpiDN, SchedMoeDN, true>(F.lds + RING_OFF, F.tid, DE, DE, DE, S, E); if (BOTH(pR + 2)) GRID_BAR(); }
        }
    if (IN(16)) { PH(); RowArgs A{}; A.Hin = pHB; A.YP = pYP; A.gain = args.in[34]; A.out = args.out; row_phase<3>(F, A); }
#undef IN
#undef BOTH
#undef GRID_BAR
#undef PH
#undef pHN
#undef pUA
#undef pGL
#undef pOG
#undef pH2
#undef pHB
#undef pYP
#undef pHID
#undef pTOKL
#undef pPW
#undef pSS
#undef pRSTD
}

extern "C" void kernel_launch(void* const* d_in, const int* in_sizes, int n_in, void* d_out, int out_size, void* d_ws, size_t ws_size, hipStream_t stream) {
    static int grid = 0;
    if (grid == 0) {
        if (n_in != 35 || in_sizes[0] != M * D || out_size != M * D || ws_size < WS_END) { fprintf(stderr, "kernel_launch: shape/workspace mismatch (n_in %d in0 %d out %d ws %zu need %zu)\n", n_in, n_in > 0 ? in_sizes[0] : -1, out_size, ws_size, (size_t)WS_END); grid = -1; return; }
        int dev = 0, cus = 0, per_cu = 0;
        if (hipGetDevice(&dev) != hipSuccess || hipDeviceGetAttribute(&cus, hipDeviceAttributeMultiprocessorCount, dev) != hipSuccess) { grid = -1; return; }
        if (hipFuncSetAttribute((const void*)hybrid_fwd, hipFuncAttributeMaxDynamicSharedMemorySize, LDS_BYTES) != hipSuccess) { fprintf(stderr, "kernel_launch: hipFuncSetAttribute failed\n"); grid = -1; return; }
        if (hipOccupancyMaxActiveBlocksPerMultiprocessor(&per_cu, (const void*)hybrid_fwd, NWAVES * 64, LDS_BYTES) != hipSuccess || per_cu < 1)
            fprintf(stderr, "kernel_launch: occupancy query reports %d workgroups per CU\n", per_cu);
        (void)hipGetLastError();
        grid = cus;
    }
    if (grid < 0) return;
    if (hipMemsetAsync((char*)d_ws + WS_CTL, 0, CTL_ZERO_BYTES, stream) != hipSuccess) return;
    Args a{};
    for (int i = 0; i < 35; ++i) a.in[i] = (const float*)d_in[i];
    a.out = (float*)d_out; a.ws = (unsigned char*)d_ws;
#if MK_PER_PHASE
    for (int p = 0; p < NPHASE; ++p) { a.ph_lo = p; a.ph_hi = p + 1; hipLaunchKernelGGL(hybrid_fwd, dim3(grid), dim3(NWAVES * 64), LDS_BYTES, stream, a); }
#else
    a.ph_lo = 0; a.ph_hi = NPHASE;
    hipLaunchKernelGGL(hybrid_fwd, dim3(grid), dim3(NWAVES * 64), LDS_BYTES, stream, a);
#endif
    const hipError_t le = hipPeekAtLastError();
    if (le != hipSuccess) fprintf(stderr, "kernel_launch: launch failed: %s\n", hipGetErrorName(le));
}
```

```cpp
#include <hip/hip_runtime.h>
#include <cstdio>
#include <cstdint>

namespace pg8 {
#define PG8_LAS __attribute__((address_space(3)))
typedef unsigned short bf16_t;
typedef short bf16x8 __attribute__((ext_vector_type(8)));
typedef float f32x4 __attribute__((ext_vector_type(4)));
typedef float f32x2 __attribute__((ext_vector_type(2)));
typedef unsigned u32x4 __attribute__((ext_vector_type(4)));
constexpr int BM = 256, BK = 64, HALF = 128, HTB = HALF * BK * 2  , STAGE_BYTES = 8 * HTB, NXCD = 8, WGM = 8;

__host__ __device__ __forceinline__ int lds_byte(int r, int c) { const int st = (r >> 4) * 2 + (c >> 5), rr = r & 15, cc = c & 31, ob = rr * 64 + cc * 2; return st * 1024 + (ob ^ (((ob >> 9) & 1) << 5)); }
__host__ __device__ __forceinline__ void stage_rc(int b, int& R, int& C) { const int st = b / 1024, sb = b % 1024, swz = sb ^ (((sb >> 9) & 1) << 5); R = (st >> 1) * 16 + swz / 64; C = (st & 1) * 32 + (swz % 64) / 2; }
__host__ __device__ __forceinline__ int perm32(int rho) { const int n = rho >> 4, i = rho & 15; return 8 * (i >> 2) + 4 * n + (i & 3); }

struct Unit { int pm, pn, half; };
struct UPtr { const char* A; const char* B; };

struct TileOrder {
    int nM, nN, nwg, G, c;
    __device__ __forceinline__ void init(int nM_, int nN_, int G_, int c_) { nM = nM_; nN = nN_; nwg = nM * nN; G = G_; c = c_; split = 0; }
    int split;
    __device__ __forceinline__ bool next(int i, Unit& u) const {
        if (split) { const int full = (nwg / G) * G, rem = nwg - full;
            if (rem > 0 && 2 * rem <= G && i == nwg / G) { if (c >= 2 * rem) return false; Unit t; const bool ok = next_lin((long)full + (c >> 1), t); u = t; u.half = c & 1; return ok; } }
        return next_lin((long)i * G + c, u);
    }
    __device__ __forceinline__ bool next_lin(const long L, Unit& u) const {
        if (L >= nwg) return false;
        int wgid = (int)L; { const int q = nwg / NXCD, r = nwg % NXCD, xcd = wgid % NXCD, off = wgid / NXCD; wgid = (xcd < r ? xcd * (q + 1) : r * (q + 1) + (xcd - r) * q) + off; }
        const int nig = WGM * nN, gid = wgid / nig, fm = gid * WGM, gsz = (nM - fm) < WGM ? (nM - fm) : WGM;
        u.pm = fm + ((wgid % nig) % gsz); u.pn = (wgid % nig) / gsz; u.half = -1; return true;
    }
};

__device__ __forceinline__ unsigned cvt_pk_bf16(float lo, float hi) { unsigned r; asm volatile("v_cvt_pk_bf16_f32 %0, %1, %2" : "=v"(r) : "v"(lo), "v"(hi)); return r; }
__device__ __forceinline__ float bf_lo(unsigned w) { return __uint_as_float(w << 16); }
__device__ __forceinline__ float bf_hi(unsigned w) { return __uint_as_float(w & 0xffff0000u); }

template <class Epi, class Sched, bool ALIGN_EPI>
__device__ __forceinline__ void gemm_phase(PG8_LAS unsigned char* lds, const int tid, const int K, const int lda, const int ldb, const Sched& S, const Epi& E) {
    const int wid = __builtin_amdgcn_readfirstlane(tid >> 6), lane = tid & 63, wr = wid >> 2, wc = wid & 3, fr = lane & 15, fq = lane >> 4;
    const int nt = K / BK;
    unsigned voffB[2], offC[2][2], offN[2][2];
    const unsigned hstepA = (unsigned)HALF * (unsigned)lda * 2u;
    const size_t hstepB = (size_t)HALF * ldb * 2;
#pragma unroll
    for (int i = 0; i < 2; ++i) { int R, C; stage_rc(tid * 16 + i * 8192, R, C); const int Rb = Epi::PERM ? ((R & ~31) + perm32(R & 31)) : R;
        offC[0][i] = (unsigned)(R * lda + C) * 2u; offC[1][i] = offC[0][i] + hstepA; voffB[i] = (unsigned)(Rb * ldb + C) * 2u; }
    const size_t kstep = (size_t)(BK * 2);
    const unsigned ldsw = (unsigned)wid * 1024u;
    const int aoff = lds_byte(wr * 64 + fr, fq * 8), boff = lds_byte(wc * 32 + fr, fq * 8);
#define PG8_SA(b, h) (((b) * 2 + (h)) * HTB)
#define PG8_SB(b, h) ((4 + (b) * 2 + (h)) * HTB)
#define PG8_STAGEB(bufoff, gbase) do { _Pragma("unroll") for (int _i = 0; _i < 2; ++_i) \
        __builtin_amdgcn_global_load_lds((const unsigned*)((const char*)(gbase) + voffB[_i]), (PG8_LAS unsigned*)(lds + (bufoff) + ldsw + _i * 8192), 16, 0, 0); } while (0)
#define PG8_STAGEA(bufoff, gbase, O, h) do { _Pragma("unroll") for (int _i = 0; _i < 2; ++_i) \
        __builtin_amdgcn_global_load_lds((const unsigned*)((const char*)(gbase) + (Sched::GATHER ? (size_t)0 : (size_t)(h) * hstepA) + (O)[Sched::GATHER ? (h) : 0][_i]), (PG8_LAS unsigned*)(lds + (bufoff) + ldsw + _i * 8192), 16, 0, 0); } while (0)
#define PG8_LDA(dst, b, h) do { _Pragma("unroll") for (int m = 0; m < 4; ++m) _Pragma("unroll") for (int k = 0; k < 2; ++k) dst[m][k] = *(const PG8_LAS bf16x8*)(lds + PG8_SA(b, h) + aoff + m * 2048 + k * 1024); } while (0)
#define PG8_LDB(dst, b, h) do { _Pragma("unroll") for (int n = 0; n < 2; ++n) _Pragma("unroll") for (int k = 0; k < 2; ++k) dst[n][k] = *(const PG8_LAS bf16x8*)(lds + PG8_SB(b, h) + boff + n * 2048 + k * 1024); } while (0)
#define PG8_MMA(ai, bj, At, Bt) do { __builtin_amdgcn_s_setprio(1); _Pragma("unroll") for (int m = 0; m < 4; ++m) _Pragma("unroll") for (int n = 0; n < 2; ++n) _Pragma("unroll") for (int k = 0; k < 2; ++k) \
        acc[ai][bj][m][n] = __builtin_amdgcn_mfma_f32_16x16x32_bf16(Bt[n][k], At[m][k], acc[ai][bj][m][n], 0, 0, 0); __builtin_amdgcn_s_setprio(0); } while (0)
#define PG8_WAIT_V(n) asm volatile("s_waitcnt vmcnt(" #n ")" ::: "memory")
#define PG8_WAIT_L(n) asm volatile("s_waitcnt lgkmcnt(" #n ")" ::: "memory")
#define PG8_BAR __builtin_amdgcn_s_barrier()
#define PG8_SCHED __builtin_amdgcn_sched_barrier(0)
    Unit cur, nxt; int ui = 0;
    if (!S.next(0, cur)) return;
    f32x4 acc[2][2][4][2];
#pragma unroll
    for (int a = 0; a < 2; ++a)
#pragma unroll
        for (int b = 0; b < 2; ++b)
#pragma unroll
            for (int m = 0; m < 4; ++m)
#pragma unroll
                for (int n = 0; n < 2; ++n) acc[a][b][m][n] = (f32x4){0.f, 0.f, 0.f, 0.f};
    bf16x8 At[4][2], B0[2][2], B1[2][2];
    UPtr cp = S.ptrs(cur);
    const char* cA = cp.A; const char* cB = cp.B;
    if constexpr (Sched::GATHER) { S.gather(cur, offC); }
    bool act0 = true, act1 = true;
    if constexpr (Sched::ROWSKIP) { const int v = S.valid(cur); act0 = wr * 64 < v && cur.half != 1; act1 = HALF + wr * 64 < v && cur.half != 0; }
#pragma unroll
    for (int h = 0; h < 2; ++h)
#pragma unroll
        for (int i = 0; i < 2; ++i) offN[h][i] = offC[h][i];
    PG8_STAGEB(PG8_SB(0, 0), cB); PG8_STAGEB(PG8_SB(0, 1), cB + hstepB); PG8_STAGEA(PG8_SA(0, 0), cA, offC, 0); PG8_STAGEA(PG8_SA(0, 1), cA, offC, 1);
    if (wr == 1) PG8_BAR;
    PG8_WAIT_V(2); PG8_BAR;
    PG8_STAGEB(PG8_SB(1, 0), cB + kstep); PG8_STAGEA(PG8_SA(1, 0), cA + kstep, offC, 0); PG8_STAGEB(PG8_SB(1, 1), cB + hstepB + kstep);
    PG8_WAIT_V(6); PG8_BAR;
    for (;;) {
        const bool has_next = S.next(ui + 1, nxt);
        const char* nA = cA; const char* nB = cB;
        if (has_next) { const UPtr np = S.ptrs(nxt); nA = np.A; nB = np.B; if constexpr (Sched::GATHER) { S.gather(nxt, offN); } }
        for (int t = 0; t < nt; t += 2) {
            const bool last = (t == nt - 2);
            const char* a1 = cA + (size_t)(t + 1) * kstep;
            const char* a2 = last ? nA : cA + (size_t)(t + 2) * kstep; const char* b2 = last ? nB : cB + (size_t)(t + 2) * kstep;
            const char* a3 = a2 + kstep; const char* b3 = b2 + kstep;
            unsigned o2[2][2];
#pragma unroll
            for (int h = 0; h < 2; ++h)
#pragma unroll
                for (int i = 0; i < 2; ++i) o2[h][i] = (Sched::GATHER && last) ? offN[h][i] : offC[h][i];
            PG8_LDB(B0, 0, 0); PG8_LDB(B1, 0, 1); PG8_SCHED; if (act0) PG8_LDA(At, 0, 0); PG8_STAGEA(PG8_SA(1, 1), a1, offC, 1);
            PG8_WAIT_V(8); PG8_WAIT_L(0); PG8_BAR; if (act0) { PG8_MMA(0, 0, At, B0); PG8_MMA(0, 1, At, B1); } PG8_BAR; PG8_SCHED;
            if (act1) PG8_LDA(At, 0, 1); PG8_STAGEB(PG8_SB(0, 0), b2); PG8_STAGEB(PG8_SB(0, 1), b2 + hstepB); PG8_STAGEA(PG8_SA(0, 0), a2, o2, 0);
            PG8_WAIT_V(8); PG8_WAIT_L(0); PG8_BAR; if (act1) { PG8_MMA(1, 0, At, B0); PG8_MMA(1, 1, At, B1); } PG8_BAR; PG8_SCHED;
            PG8_LDB(B0, 1, 0); PG8_LDB(B1, 1, 1); PG8_SCHED; if (act0) PG8_LDA(At, 1, 0); PG8_STAGEA(PG8_SA(0, 1), a2, o2, 1);
            PG8_WAIT_V(8); PG8_WAIT_L(0); PG8_BAR; if (act0) { PG8_MMA(0, 0, At, B0); PG8_MMA(0, 1, At, B1); } PG8_BAR; PG8_SCHED;
            if (act1) PG8_LDA(At, 1, 1); PG8_STAGEB(PG8_SB(1, 0), b3); PG8_STAGEB(PG8_SB(1, 1), b3 + hstepB); PG8_STAGEA(PG8_SA(1, 0), a3, o2, 0);
            PG8_WAIT_V(8); PG8_WAIT_L(0); PG8_BAR; if (act1) { PG8_MMA(1, 0, At, B0); PG8_MMA(1, 1, At, B1); } PG8_BAR; PG8_SCHED;
        }
        if constexpr (ALIGN_EPI) { if (wr == 0) PG8_BAR; }
        if constexpr (!Epi::AFTER_DRAIN) { E(acc, cur, wr, wc, fr, fq); }
        if (!has_next) break;
#pragma unroll
        for (int a = 0; a < 2; ++a)
#pragma unroll
            for (int b = 0; b < 2; ++b)
#pragma unroll
                for (int m = 0; m < 4; ++m)
#pragma unroll
                    for (int n = 0; n < 2; ++n) acc[a][b][m][n] = (f32x4){0.f, 0.f, 0.f, 0.f};
        cur = nxt; cA = nA; cB = nB; ++ui;
        if constexpr (Sched::ROWSKIP) { const int v = S.valid(cur); act0 = wr * 64 < v && cur.half != 1; act1 = HALF + wr * 64 < v && cur.half != 0; }
        if constexpr (Sched::GATHER) {
#pragma unroll
            for (int h = 0; h < 2; ++h)
#pragma unroll
                for (int i = 0; i < 2; ++i) offC[h][i] = offN[h][i];
        }
        if constexpr (ALIGN_EPI) { if (wr == 1) PG8_BAR; }
    }
    PG8_WAIT_V(0);
    if constexpr (!ALIGN_EPI) { if (wr == 0) PG8_BAR; }
    PG8_BAR;
    if constexpr (Epi::AFTER_DRAIN) { E.fused(acc, cur, wr, wc, fr, fq, lds, wid, lane); }
#undef PG8_SA
#undef PG8_SB
#undef PG8_STAGEA
#undef PG8_STAGEB
#undef PG8_LDA
#undef PG8_LDB
#undef PG8_MMA
#undef PG8_WAIT_V
#undef PG8_WAIT_L
#undef PG8_BAR
#undef PG8_SCHED
}
}

constexpr int NWAVES = 8;
constexpr int NB = 8, SEQ = 2048, D = 2048, M = NB * SEQ;
constexpr int DS = 1024, NG = 64, GC = 16, NST = 64;
constexpr int LCH = 32, NCH = SEQ / LCH;
constexpr int KP = LCH * GC + 2 * NST;
constexpr int NH = 16, HD = 128;
constexpr int NE = 64, DE = 512, NEG = 8, EPG = 8;
constexpr int FOXN = 4 * D + NH;
constexpr float RMS_EPS = 1e-6f;
constexpr int RT_ROWS = 96;
constexpr int MAXMT = 192;

constexpr size_t MiB = 1u << 20;
constexpr size_t WS_CTL = 0, CTL_ZERO_BYTES = 1 * MiB;
constexpr size_t WS_WS5IN  = 1 * MiB;
constexpr size_t WS_WGLU   = WS_WS5IN + 4 * MiB;
constexpr size_t WS_WS5OUT = WS_WGLU + 2 * MiB;
constexpr size_t WS_WFOXIN = WS_WS5OUT + 4 * MiB;
constexpr size_t WS_WFOXOUT = WS_WFOXIN + 32 * MiB;
constexpr size_t WS_WR     = WS_WFOXOUT + 8 * MiB;
constexpr size_t WS_WF     = WS_WR + 1 * MiB;
constexpr size_t WS_AL     = WS_WF + 512 * 1024;
constexpr size_t WS_LF     = WS_AL + 512 * 1024;
constexpr size_t WS_CUMB   = WS_LF + 1 * MiB;
constexpr size_t WS_PW     = WS_CUMB + 1 * MiB;
constexpr size_t WS_TOKL   = WS_PW + 1 * MiB;
constexpr size_t WS_SS     = 60 * MiB;
constexpr size_t WS_RSTD   = 62 * MiB;
constexpr size_t WS_WGU    = 64 * MiB;
constexpr size_t WS_WDN    = WS_WGU + 512 * MiB;
constexpr size_t WS_HN     = WS_WDN + 256 * MiB;
constexpr size_t WS_H2     = WS_HN + 64 * MiB;
constexpr size_t WS_Q      = WS_H2 + 128 * MiB;
constexpr size_t WS_K      = WS_Q + 64 * MiB, WS_V = WS_K + 64 * MiB, WS_SG = WS_V + 64 * MiB;
constexpr size_t WS_R1     = WS_SG + 64 * MiB;
constexpr size_t WS_TT     = WS_R1;
constexpr size_t WS_PT     = WS_TT + 40 * MiB;
constexpr size_t WS_UA     = WS_PT + 16 * MiB;
constexpr size_t WS_GL     = WS_UA + 40 * MiB;
constexpr size_t WS_OG     = WS_GL + 32 * MiB;
constexpr size_t WS_YP     = WS_R1;
constexpr size_t WS_HID    = WS_YP + 128 * MiB;
constexpr size_t WS_TOKW   = WS_R1 + 176 * MiB;
constexpr size_t WS_TOKR   = WS_TOKW + 4 * MiB;
constexpr size_t WS_END    = WS_TOKR + 4 * MiB;
static_assert(WS_TOKL + 4 * MiB <= WS_WGU && WS_OG + 32 * MiB <= WS_END && WS_HID + 48 * MiB <= WS_END, "d_ws map");
constexpr int CW_TMO = 0, CW_CODE = 1, CW_NPRE = 8;
constexpr int CW_BAR = 4096;
constexpr int CW_CNT = 16384;

constexpr int RING_OFF = 0, RING_BYTES = 131072;
constexpr int LDSCTL_OFF = 151552, MISC_OFF = LDSCTL_OFF + 320;
constexpr int MOE_OFF = LDSCTL_OFF + 512;
constexpr int LDS_BYTES = 155648;
static_assert(MOE_OFF + (64 * 3 + 4 + 2 * MAXMT) * 4 <= LDS_BYTES, "LDS map");

#define GAS __attribute__((address_space(1)))
#define LAS __attribute__((address_space(3)))
typedef unsigned short bf16;
typedef unsigned v4u __attribute__((ext_vector_type(4)));
typedef unsigned v2u __attribute__((ext_vector_type(2)));
typedef float f32x4 __attribute__((ext_vector_type(4)));
typedef float f32x16 __attribute__((ext_vector_type(16)));
typedef short bf16x8 __attribute__((ext_vector_type(8)));
typedef GAS unsigned gu32;
#define RLX_AGENT __ATOMIC_RELAXED, __HIP_MEMORY_SCOPE_AGENT
#define LDS_WAIT() asm volatile("s_waitcnt lgkmcnt(0)" ::: "memory")
#define VM_WAIT() asm volatile("s_waitcnt vmcnt(0)" ::: "memory")
__device__ __forceinline__ unsigned f2bf(float f) { unsigned u = __builtin_bit_cast(unsigned, f); return (u + 0x7fffu + ((u >> 16) & 1u)) >> 16; }
__device__ __forceinline__ unsigned pk2(float lo, float hi) { return pg8::cvt_pk_bf16(lo, hi); }

#define XB_TMO      128
#define XB_XCNT(j)  (256  + 64 * (j))
#define XB_XSUB(j)  (1280 + 64 * (j))
#define XB_XGEN(j)  (2304 + 64 * (j))
#define XB_TOP      3328
#define XB_TOPGEN   3392
#define XCD_BAR_WORDS 3456
#define XB_SPIN_CAP (1u << 18)

__device__ __forceinline__ unsigned xb_ld(unsigned* p)              { return __hip_atomic_load(p, __ATOMIC_RELAXED, __HIP_MEMORY_SCOPE_AGENT); }
__device__ __forceinline__ unsigned xb_add(unsigned* p, unsigned v) { return __hip_atomic_fetch_add(p, v, __ATOMIC_RELAXED, __HIP_MEMORY_SCOPE_AGENT); }
__device__ __forceinline__ unsigned xb_xcc_id() { return (unsigned)__builtin_amdgcn_s_getreg((3 << 11) | 20) & 0xFu; }
#define XB_SPIN(cond, bar) do { unsigned _sp = 0; while (cond) { __builtin_amdgcn_s_sleep(1); \
    if ((++_sp & 255u) == 0u) { if (xb_ld(&(bar)[XB_TMO])) break; if (_sp > XB_SPIN_CAP) { atomicAdd(&(bar)[XB_TMO], 1u); break; } } } } while (0)

struct XcdBarrier {
    unsigned* bar; unsigned x;
    volatile LAS unsigned* st;
};
__device__ __forceinline__ XcdBarrier xcd_barrier_post(unsigned* bar, volatile LAS unsigned* st) {
    XcdBarrier b; b.bar = bar; b.x = xb_xcc_id(); b.st = st;
    if (threadIdx.x == 0) (void)xb_add(&bar[XB_XCNT(b.x)], 1u);
    return b;
}
__device__ __forceinline__ void xcd_barrier_complete(unsigned* bar, unsigned x, unsigned& nloc, unsigned& nx) {
    const unsigned G = gridDim.x * gridDim.y * gridDim.z;
    unsigned sum, cnt, mine, sp = 0u;
    for (;;) {
        sum = 0u; cnt = 0u; mine = 0u;
#pragma unroll
        for (unsigned j = 0; j < 16; ++j) { const unsigned c = xb_ld(&bar[XB_XCNT(j)]); sum += c; cnt += (c > 0u) ? 1u : 0u; mine = (j == x) ? c : mine; }
        if (sum == G) break;
        __builtin_amdgcn_s_sleep(1);
        if ((++sp & 255u) == 0u) { if (xb_ld(&bar[XB_TMO])) break; if (sp > XB_SPIN_CAP) { atomicAdd(&bar[XB_TMO], 1u); break; } }
    }
    nloc = mine > 0u ? mine : 1u; nx = cnt > 0u ? cnt : 1u;
}
__device__ __forceinline__ void xcd_barrier(const XcdBarrier& b, const int tid) {
    asm volatile("s_waitcnt vmcnt(0)" ::: "memory");
    __syncthreads();
    if (tid == 0) {
        unsigned* bar = b.bar;
        const unsigned bx = xb_xcc_id();
        __builtin_amdgcn_s_waitcnt(0);
        unsigned nloc = b.st[0], nx = b.st[1];
        if (nloc == 0u) { xcd_barrier_complete(bar, bx, nloc, nx); b.st[0] = nloc; b.st[1] = nx; }
        const unsigned old = xb_add(&bar[XB_XSUB(bx)], 1u);
        const unsigned gen = old / nloc;
        if (old + 1u == (gen + 1u) * nloc) {
            __builtin_amdgcn_fence(__ATOMIC_RELEASE, "agent");
            asm volatile("s_waitcnt vmcnt(0)" ::: "memory");
            const unsigned og = xb_add(&bar[XB_TOP], 1u);
            const unsigned tg = og / nx;
            if (og + 1u == (tg + 1u) * nx) { xb_add(&bar[XB_TOPGEN], 1u); xb_add(&bar[XB_XGEN(bx)], 1u); __builtin_amdgcn_fence(__ATOMIC_ACQUIRE, "agent"); }
            else { __builtin_amdgcn_fence(__ATOMIC_ACQUIRE, "agent"); XB_SPIN(xb_ld(&bar[XB_TOPGEN]) == tg, bar); xb_add(&bar[XB_XGEN(bx)], 1u); }
            asm volatile("s_waitcnt vmcnt(0)" ::: "memory");
        } else {
            __builtin_amdgcn_fence(__ATOMIC_ACQUIRE, "agent");
            XB_SPIN(xb_ld(&bar[XB_XGEN(bx)]) == gen, bar);
            asm volatile("s_waitcnt vmcnt(0)" ::: "memory");
        }
    }
    __syncthreads();
}

struct Frame {
    LAS unsigned char* lds;
    volatile LAS unsigned* MISC;
    gu32* ctl;
    int tid, lane, wave;
    int vcu, G;
    unsigned char* ws;
};
__device__ __forceinline__ float wave_sum(float v) {
#pragma unroll
    for (int o = 1; o < 64; o <<= 1) v += __shfl_xor(v, o);
    return v;
}
__device__ __forceinline__ float sigmoidf_(float x) { return __builtin_amdgcn_rcpf(1.f + __builtin_amdgcn_exp2f(-1.4426950408889634f * x)); }
__device__ __forceinline__ float gelu_tanh_(float x) {
    const float u = x * (1.f + 0.044715f * x * x);
    return x * __builtin_amdgcn_rcpf(1.f + __builtin_amdgcn_exp2f(-2.302208198f * u));
}

struct Args { const float* in[35]; float* out; unsigned char* ws; int ph_lo, ph_hi; };

__device__ __forceinline__ void p0_transpose_item(const float* W, int K, int N, int k0, int n0, bf16* dst0, LAS float* scr, int lane) {
    const int cn = n0 + (lane & 31); const bool ok = cn < N;
    float ld[32];
    const GAS float* Wp = (const GAS float*)W + (size_t)(k0 + (lane >> 5)) * N + cn;
#pragma unroll
    for (int i = 0; i < 32; ++i) ld[i] = ok ? Wp[(size_t)(2 * i) * N] : 0.f;
#pragma unroll
    for (int i = 0; i < 32; ++i) scr[(2 * i + (lane >> 5)) * 33 + (lane & 31)] = ld[i];
    LDS_WAIT(); asm volatile("" ::: "memory");
    const int c = lane & 7;
#pragma unroll
    for (int j = 0; j < 4; ++j) { const int n = (lane >> 3) + 8 * j; const LAS float* s = scr + (8 * c) * 33 + n;
        v4u o; o.x = pk2(s[0 * 33], s[1 * 33]); o.y = pk2(s[2 * 33], s[3 * 33]); o.z = pk2(s[4 * 33], s[5 * 33]); o.w = pk2(s[6 * 33], s[7 * 33]);
        *(GAS v4u*)(dst0 + (size_t)n * K + k0 + 8 * c) = o; }
    LDS_WAIT(); asm volatile("" ::: "memory");
}
__device__ __forceinline__ void p0_router_item(const float* wg, const float* we, const float* gain, bf16* WR, int kb, int ng, int lane) {
    const int k = kb * 64 + lane; const float g = gain[k];
    const GAS f32x4* src = ng == 0 ? (const GAS f32x4*)(wg + (size_t)k * 8) : (const GAS f32x4*)(we + (size_t)k * 64 + (ng - 1) * 8);
    const f32x4 v0 = src[0], v1 = src[1];
    GAS bf16* dst = (GAS bf16*)WR + (size_t)(ng == 0 ? 0 : 8 + (ng - 1) * 8) * D + k;
    dst[0 * D] = (bf16)f2bf(g * v0.x); dst[1 * D] = (bf16)f2bf(g * v0.y); dst[2 * D] = (bf16)f2bf(g * v0.z); dst[3 * D] = (bf16)f2bf(g * v0.w);
    dst[4 * D] = (bf16)f2bf(g * v1.x); dst[5 * D] = (bf16)f2bf(g * v1.y); dst[6 * D] = (bf16)f2bf(g * v1.z); dst[7 * D] = (bf16)f2bf(g * v1.w);
    if (ng == 8) for (int n = 72; n < RT_ROWS; ++n) WR[(size_t)n * D + k] = (bf16)0;
}
struct S5P { const float *lre, *lim, *bre, *bim, *cre, *cim, *lstep; };
__device__ __forceinline__ void s5_cis(double th, float& c, float& s, float& sh) {
    const double k = __builtin_rint(th * 0.15915494309189535);
    const float r = (float)__builtin_fma(-k, 6.283185307179586, th);
    c = cosf(r); s = sinf(r); sh = sinf(0.5f * r);
}
__device__ __forceinline__ void s5_pow(const S5P& P, int g, int n, int m, float& pr, float& pi) {
    const float lr = P.lre[g * 64 + n], li = P.lim[g * 64 + n], step = expf(P.lstep[g]);
    float c, s, sh; s5_cis((double)m * ((double)li * (double)step), c, s, sh);
    const float mag = expf((float)m * (lr * step));
    pr = mag * c; pi = mag * s;
}
__device__ __forceinline__ void s5_zoh(const S5P& P, int g, int n, float& fr, float& fi) {
    const float lr = P.lre[g * 64 + n], li = P.lim[g * 64 + n], step = expf(P.lstep[g]);
    float c, s, sh; s5_cis((double)li * (double)step, c, s, sh);
    const float em1 = expm1f(lr * step), mag = em1 + 1.f;
    const float nr = em1 * c - 2.f * sh * sh, ni = mag * s;
    const float den = lr * lr + li * li;
    fr = (nr * lr + ni * li) / den; fi = (ni * lr - nr * li) / den;
}
__device__ __forceinline__ void s5_item_kernel(const S5P& P, bf16* TT, int g, int m, int lane) {
    float pr, pi, fr, fi; s5_pow(P, g, lane, m, pr, pi); s5_zoh(P, g, lane, fr, fi);
    const int co = lane >> 2, ci0 = (lane & 3) * 4;
    const float wr = pr * fr - pi * fi, wi = pr * fi + pi * fr;
    float a0 = 0.f, a1 = 0.f, a2 = 0.f, a3 = 0.f;
    const GAS float* crp = (const GAS float*)P.cre + (size_t)(g * 16 + co) * 64; const GAS float* cmp_ = (const GAS float*)P.cim + (size_t)(g * 16 + co) * 64;
    const GAS f32x4* brp = (const GAS f32x4*)(P.bre + (size_t)(g * 64) * 16 + ci0); const GAS f32x4* bip = (const GAS f32x4*)(P.bim + (size_t)(g * 64) * 16 + ci0);
#pragma unroll 8
    for (int n = 0; n < 64; ++n) {
        const float wrn = __shfl(wr, n), win = __shfl(wi, n);
        const f32x4 br = brp[4 * n], bi = bip[4 * n];
        const float cr = crp[n], cm = cmp_[n];
        const float dr = cr * wrn - cm * win, di = cr * win + cm * wrn;
        a0 += dr * br.x - di * bi.x;
        a1 += dr * br.y - di * bi.y;
        a2 += dr * br.z - di * bi.z;
        a3 += dr * br.w - di * bi.w;
    }
    v2u w; w.x = pk2(a0, a1); w.y = pk2(a2, a3); const v2u z = {0u, 0u};
    bf16* Tg = TT + (size_t)g * 512 * KP;
    for (int j = 0; j + m < LCH; ++j) {
        *(GAS v2u*)(Tg + (size_t)((j + m) * 16 + co) * KP + j * 16 + ci0) = w;
        if (m >= 1) *(GAS v2u*)(Tg + (size_t)(j * 16 + co) * KP + (j + m) * 16 + ci0) = z;
    }
}
__device__ __forceinline__ void s5_item_state(const S5P& P, bf16* TT, int g, int i, int lane) {
    float pr, pi; s5_pow(P, g, lane, i + 1, pr, pi);
    bf16* Tg = TT + (size_t)g * 512 * KP;
#pragma unroll
    for (int co = 0; co < 16; ++co) {
        const float cr = P.cre[(size_t)(g * 16 + co) * 64 + lane], cm = P.cim[(size_t)(g * 16 + co) * 64 + lane];
        const float car = cr * pr - cm * pi, cai = cr * pi + cm * pr;
        *(GAS unsigned*)(Tg + (size_t)(i * 16 + co) * KP + 512 + 2 * lane) = pk2(car, -cai);
    }
}
__device__ __forceinline__ void s5_item_p(const S5P& P, bf16* PT, float* AL, int g, int j, int lane) {
    const int n = lane;
    float qr, qi, fr, fi; s5_pow(P, g, n, LCH - 1 - j, qr, qi); s5_zoh(P, g, n, fr, fi);
    bf16* Pg = PT + (size_t)g * 256 * 512;
#pragma unroll
    for (int h = 0; h < 2; ++h) {
        float re[8], im[8];
#pragma unroll
        for (int q = 0; q < 2; ++q) { const f32x4 br = *(const f32x4*)(P.bre + (size_t)(g * 64 + n) * 16 + h * 8 + q * 4), bi = *(const f32x4*)(P.bim + (size_t)(g * 64 + n) * 16 + h * 8 + q * 4);
#pragma unroll
            for (int e = 0; e < 4; ++e) { const float bbr = fr * br[e] - fi * bi[e], bbi = fr * bi[e] + fi * br[e]; re[q * 4 + e] = qr * bbr - qi * bbi; im[q * 4 + e] = qr * bbi + qi * bbr; } }
        v4u wr_, wi_; wr_.x = pk2(re[0], re[1]); wr_.y = pk2(re[2], re[3]); wr_.z = pk2(re[4], re[5]); wr_.w = pk2(re[6], re[7]);
        wi_.x = pk2(im[0], im[1]); wi_.y = pk2(im[2], im[3]); wi_.z = pk2(im[4], im[5]); wi_.w = pk2(im[6], im[7]);
        const v4u z = {0u, 0u, 0u, 0u};
        *(GAS v4u*)(Pg + (size_t)(2 * n) * 512 + j * 16 + h * 8) = wr_;
        *(GAS v4u*)(Pg + (size_t)(2 * n + 1) * 512 + j * 16 + h * 8) = wi_;
        *(GAS v4u*)(Pg + (size_t)(128 + 2 * n) * 512 + j * 16 + h * 8) = z;
        *(GAS v4u*)(Pg + (size_t)(129 + 2 * n) * 512 + j * 16 + h * 8) = z;
    }
    if (j == 0) { float ar, ai; s5_pow(P, g, n, LCH, ar, ai); AL[(g * 64 + n) * 2] = ar; AL[(g * 64 + n) * 2 + 1] = ai; }
}
__device__ __forceinline__ void rms_row_to_bf16(const float* xrow, const float* gain, bf16* orow, int lane) {
    const GAS f32x4* xr = (const GAS f32x4*)xrow + lane; const GAS f32x4* gr = (const GAS f32x4*)gain + lane;
    f32x4 v[8]; float s = 0.f;
#pragma unroll
    for (int j = 0; j < 8; ++j) { v[j] = xr[64 * j]; s += (v[j].x * v[j].x + v[j].y * v[j].y) + (v[j].z * v[j].z + v[j].w * v[j].w); }
    const float rstd = 1.f / sqrtf(wave_sum(s) * (1.f / D) + RMS_EPS);
    GAS v2u* o8 = (GAS v2u*)orow + lane;
#pragma unroll
    for (int j = 0; j < 8; ++j) { const f32x4 g = gr[64 * j]; v2u w; w.x = pk2(v[j].x * rstd * g.x, v[j].y * rstd * g.y); w.y = pk2(v[j].z * rstd * g.z, v[j].w * rstd * g.w); o8[64 * j] = w; }
}

__device__ __forceinline__ void p0_prologue(Frame& F, const Args& a, unsigned char* ws) {
    LAS float* scr = (LAS float*)(F.lds + RING_OFF + F.wave * 16384);
    const int gw = F.vcu * NWAVES + F.wave, NGW = F.G * NWAVES;
    const S5P P{a.in[3], a.in[4], a.in[5], a.in[6], a.in[7], a.in[8], a.in[10]};
    bf16* TT = (bf16*)(ws + WS_TT); bf16* PT = (bf16*)(ws + WS_PT); float* AL = (float*)(ws + WS_AL);
    for (int it = gw; it < 3 * NG * LCH; it += NGW) {
        const int kind = it / (NG * LCH), r = it % (NG * LCH), g = r / LCH, m = r % LCH;
        if (kind == 0) s5_item_kernel(P, TT, g, m, F.lane);
        else if (kind == 1) s5_item_state(P, TT, g, m, F.lane);
        else s5_item_p(P, PT, AL, g, m, F.lane);
    }
    for (int it = gw; it < 2 * 32 * 9; it += NGW) { const int l = it / 288, r = it % 288, kb = r / 9, ng = r % 9;
        p0_router_item(a.in[l ? 27 : 15], a.in[l ? 29 : 17], a.in[l ? 26 : 14], (bf16*)(ws + WS_WR) + (size_t)l * (256 * 1024), kb, ng, F.lane); }
    constexpr int I_S5IN = 32 * 32, I_GLU = 16 * 32, I_S5OUT = 16 * 64, I_FOXIN = 32 * 257, I_FOXOUT = 32 * 64;
    constexpr int NITEMS = I_S5IN + I_GLU + I_S5OUT;
    for (int it = gw; it < NITEMS; it += NGW) {
        int r = it;
        if (r < I_S5IN) { const int kb = r / 32, nb = r % 32; p0_transpose_item(a.in[2], D, DS, kb * 64, nb * 32, (bf16*)(ws + WS_WS5IN) + (size_t)(nb * 32) * D, scr, F.lane); continue; } r -= I_S5IN;
        if (r < I_GLU) { const int kb = r / 32, nb = r % 32; p0_transpose_item(a.in[11], DS, DS, kb * 64, nb * 32, (bf16*)(ws + WS_WGLU) + (size_t)(nb * 32) * DS, scr, F.lane); continue; } r -= I_GLU;
        { const int kb = r / 64, nb = r % 64; p0_transpose_item(a.in[13], DS, D, kb * 64, nb * 32, (bf16*)(ws + WS_WS5OUT) + (size_t)(nb * 32) * DS, scr, F.lane); }
    }
    for (int m = gw; m < M; m += NGW) rms_row_to_bf16(a.in[0] + (size_t)m * D, a.in[1], (bf16*)(ws + WS_HN) + (size_t)m * D, F.lane);
}

struct ConvItem { const GAS float* Wp; bf16* dst0; const float* gain; int N, K, k0; bool ok, hasg; };
__device__ __forceinline__ ConvItem moe_conv_item(const Args& a, unsigned char* ws, const int l, int r, const int lane) {
    constexpr int I_EXP = 512;
    ConvItem it; it.gain = a.in[l ? 26 : 14];
    const int kind = r / (64 * I_EXP); it.hasg = kind < 2; r -= kind * (64 * I_EXP);
    const int e = r / I_EXP; r -= e * I_EXP;
    if (kind < 2) {
        const int kb = r / 16, nb = r % 16, n0 = nb * 32;
        it.N = DE; it.K = D; it.k0 = kb * 64;
        it.Wp = (const GAS float*)(a.in[(l ? 31 : 19) + kind] + (size_t)e * D * DE) + (size_t)(it.k0 + (lane >> 3)) * DE + n0 + 4 * (lane & 7);
        it.dst0 = (bf16*)(ws + WS_WGU) + ((size_t)l * NE * 1024 + (size_t)e * 1024 + (n0 >> 7) * 256 + kind * 128 + (n0 & 127)) * D;
    } else {
        const int kb = r / 64, nb = r % 64, n0 = nb * 32;
        it.N = D; it.K = DE; it.k0 = kb * 64;
        it.Wp = (const GAS float*)(a.in[l ? 33 : 21] + (size_t)e * DE * D) + (size_t)(it.k0 + (lane >> 3)) * D + n0 + 4 * (lane & 7);
        it.dst0 = (bf16*)(ws + WS_WDN) + ((size_t)l * NE * D + (size_t)e * D + n0) * DE;
    }
    it.ok = true; return it;
}
__device__ __forceinline__ ConvItem fox_conv_item(const Args& a, unsigned char* ws, int r, const int lane) {
    constexpr int I_FOXIN = 32 * 257;
    ConvItem it; it.K = D; it.gain = a.in[14]; it.hasg = false;
    if (r < I_FOXIN) { const int kb = r / 257, nb = r % 257, n0 = nb * 32, cn = n0 + 4 * (lane & 7);
        it.N = FOXN; it.k0 = kb * 64; it.ok = cn < FOXN;
        it.Wp = (const GAS float*)a.in[23] + (size_t)(it.k0 + (lane >> 3)) * FOXN + (it.ok ? cn : 0);
        it.dst0 = nb < 256 ? (bf16*)(ws + WS_WFOXIN) + (size_t)n0 * D : (bf16*)(ws + WS_WF);
    } else { r -= I_FOXIN; const int kb = r / 64, nb = r % 64, n0 = nb * 32;
        it.N = D; it.k0 = kb * 64; it.ok = true;
        it.Wp = (const GAS float*)a.in[25] + (size_t)(it.k0 + (lane >> 3)) * D + n0 + 4 * (lane & 7);
        it.dst0 = (bf16*)(ws + WS_WFOXOUT) + (size_t)n0 * D; }
    return it;
}
template <int KIND>
__device__ __forceinline__ void conv_range(Frame& F, const Args& a, unsigned char* ws, const int r0, const int r_end, const int worker, const int stride) {
    LAS unsigned char* scrb = F.lds + RING_OFF + F.wave * 16384;
    const int lane = F.lane;
    int r = r0 + worker;
    if (r >= r_end) return;
    const int wk = lane >> 3, l7 = lane & 7, wn = 4 * l7, c = l7;
    __builtin_amdgcn_s_waitcnt(0x0F70);
    if constexpr (KIND < 2) {
        const GAS f32x4* gsrc = (const GAS f32x4*)a.in[KIND ? 26 : 14];
#pragma unroll
        for (int i = 0; i < 8; ++i) *(LAS f32x4*)(scrb + 8192 + (i * 64 + lane) * 16) = gsrc[i * 64 + lane];
        LDS_WAIT(); asm volatile("" ::: "memory");
    }
    ConvItem dummy; dummy.Wp = (const GAS float*)a.in[14] + wn; dummy.dst0 = nullptr; dummy.gain = a.in[14]; dummy.N = 0; dummy.K = 0; dummy.k0 = 0; dummy.ok = true; dummy.hasg = false;
#define CONV_ITEM(r) ((r) < r_end ? (KIND < 2 ? moe_conv_item(a, ws, KIND, (r), lane) : fox_conv_item(a, ws, (r), lane)) : dummy)
#define CONV_LOAD(dst, it) { _Pragma("unroll") for (int i = 0; i < 8; ++i) dst[i] = __builtin_nontemporal_load((const GAS f32x4*)(it.Wp + (size_t)(8 * i) * it.N)); }
    const unsigned wq = (unsigned)(l7 ^ wk), wb = (unsigned)wk * 128u;
    unsigned X[8];
#pragma unroll
    for (int m = 0; m < 8; ++m) X[m] = (unsigned)c * 1024u + (unsigned)(wk & 3) * 4u + ((((unsigned)(wk >> 2) ^ (unsigned)c ^ (unsigned)m)) << 4);
#define CONV_PROC(ld, cur) { \
        _Pragma("unroll") for (int i = 0; i < 8; ++i) { const f32x4 v = cur.ok ? ld[i] : f32x4{0.f, 0.f, 0.f, 0.f}; *(LAS f32x4*)(scrb + wb + i * 1024 + ((wq ^ (unsigned)i) << 4)) = v; } \
        LDS_WAIT(); asm volatile("" ::: "memory"); \
        f32x4 g0 = {1.f, 1.f, 1.f, 1.f}, g1 = g0; \
        if constexpr (KIND < 2) { const f32x4 q0 = *(const LAS f32x4*)(scrb + 8192 + (cur.k0 + 8 * c) * 4), q1 = *(const LAS f32x4*)(scrb + 8192 + (cur.k0 + 8 * c) * 4 + 16); g0 = cur.hasg ? q0 : g0; g1 = cur.hasg ? q1 : g1; } \
        float spa[4][8]; \
        _Pragma("unroll") for (int jj = 0; jj < 4; ++jj) _Pragma("unroll") for (int t = 0; t < 8; ++t) spa[jj][t] = *(const LAS float*)(scrb + X[t ^ (2 * jj)] + t * 128);     \
        _Pragma("unroll") for (int jj = 0; jj < 4; ++jj) { const int n = (lane >> 3) + 8 * jj; const float* sp = spa[jj]; \
            v4u o; o.x = pk2(sp[0] * g0.x, sp[1] * g0.y); o.y = pk2(sp[2] * g0.z, sp[3] * g0.w); o.z = pk2(sp[4] * g1.x, sp[5] * g1.y); o.w = pk2(sp[6] * g1.z, sp[7] * g1.w); \
            __builtin_nontemporal_store(o, (GAS v4u*)(cur.dst0 + (size_t)n * cur.K + cur.k0 + 8 * c)); } \
        LDS_WAIT(); asm volatile("" ::: "memory"); }
    ConvItem iA = CONV_ITEM(r), iB = CONV_ITEM(r + stride), iC = CONV_ITEM(r + 2 * stride), iD = CONV_ITEM(r + 3 * stride), iE;
    f32x4 A[8], B[8], C[8], Dd[8], Ee[8];
    CONV_LOAD(A, iA)
    __builtin_amdgcn_sched_barrier(0);
    CONV_LOAD(B, iB)
    __builtin_amdgcn_sched_barrier(0);
    CONV_LOAD(C, iC)
    __builtin_amdgcn_sched_barrier(0);
    CONV_LOAD(Dd, iD)
    __builtin_amdgcn_sched_barrier(0);
    for (; r < r_end; r += 5 * stride) {
        iE = CONV_ITEM(r + 4 * stride); CONV_LOAD(Ee, iE)
        CONV_PROC(A, iA)
        iA = CONV_ITEM(r + 5 * stride); CONV_LOAD(A, iA)
        if (r + stride < r_end) CONV_PROC(B, iB)
        iB = CONV_ITEM(r + 6 * stride); CONV_LOAD(B, iB)
        if (r + 2 * stride < r_end) CONV_PROC(C, iC)
        iC = CONV_ITEM(r + 7 * stride); CONV_LOAD(C, iC)
        if (r + 3 * stride < r_end) CONV_PROC(Dd, iD)
        iD = CONV_ITEM(r + 8 * stride); CONV_LOAD(Dd, iD)
        if (r + 4 * stride < r_end) CONV_PROC(Ee, iE)
    }
#undef CONV_PROC
#undef CONV_LOAD
#undef CONV_ITEM
}
constexpr int CONV_TOTAL_MOE = 3 * 64 * 512, CONV_TOTAL_FOX = 32 * 257 + 32 * 64;
template <int KIND>
__device__ __forceinline__ void conv_run(Frame& F, const Args& a, unsigned char* ws, const int slot, const int nslots) {
    const int gw = F.vcu * NWAVES + F.wave, NGW = F.G * NWAVES;
    constexpr int TOTAL = KIND < 2 ? CONV_TOTAL_MOE : CONV_TOTAL_FOX;
    const int nj = (TOTAL + NGW - 1) / NGW, j0 = (nj * slot) / nslots, j1 = (nj * (slot + 1)) / nslots;
    const int re = j1 * NGW < TOTAL ? j1 * NGW : TOTAL;
    conv_range<KIND>(F, a, ws, j0 * NGW, re, gw, NGW);
}
__device__ __forceinline__ void moe_conv(Frame& F, const Args& a, unsigned char* ws, const int l, const int slot, const int nslots) {
    if (l == 0) conv_run<0>(F, a, ws, slot, nslots); else conv_run<1>(F, a, ws, slot, nslots);
}

using pg8::Unit; using pg8::UPtr; using pg8::TileOrder; using pg8::cvt_pk_bf16; using pg8::bf_lo; using pg8::bf_hi;
typedef pg8::f32x4 (AccT)[2][2][4][2];

struct SchedDense {
    static constexpr bool GATHER = false, ROWSKIP = false;
    TileOrder T; const char* A; const char* B; size_t astep, bstep;
    int i_begin, i_end;
    __device__ __forceinline__ void init(const void* A_, int lda, const void* B_, int ldb, int nM, int nN, int G, int c) { T.init(nM, nN, G, c); A = (const char*)A_; B = (const char*)B_; astep = (size_t)256 * lda * 2; bstep = (size_t)256 * ldb * 2; i_begin = 0; i_end = 1 << 30; }
    __device__ __forceinline__ bool next(int i, Unit& u) const { return (i + i_begin < i_end) && T.next(i + i_begin, u); }
    __device__ __forceinline__ UPtr ptrs(const Unit& u) const { UPtr p; p.A = A + (size_t)u.pm * astep; p.B = B + (size_t)u.pn * bstep; return p; }
};
template <int NPN> struct SchedS5 {
    static constexpr bool GATHER = false, ROWSKIP = false;
    int G, c; const char* A; const char* B; size_t bgrp, btile;
    __device__ __forceinline__ void init(const void* A_, const void* B_, int brows_per_group, int ldb, int G_, int c_) { G = G_; c = c_; A = (const char*)A_; B = (const char*)B_; bgrp = (size_t)brows_per_group * ldb * 2; btile = (size_t)256 * ldb * 2; }
    __device__ __forceinline__ bool next(int i, Unit& u) const { const int L = i * G + c; if (L >= NG * 2 * NPN) return false; u.pm = L / NPN; u.pn = L % NPN; u.half = -1; return true; }
    __device__ __forceinline__ UPtr ptrs(const Unit& u) const { UPtr p; p.A = A + (size_t)u.pm * 256 * KP * 2; p.B = B + (size_t)(u.pm >> 1) * bgrp + (size_t)u.pn * btile; return p; }
};
struct MoeTab { const LAS int* cnt; const LAS int* mt_e; const LAS int* mt_row0; int T; };
struct SchedMoeGU {
    static constexpr bool GATHER = true, ROWSKIP = true;
    __device__ __forceinline__ int valid(const Unit& u) const { return tab.cnt[tab.mt_e[u.pm]] - tab.mt_row0[u.pm]; }
    TileOrder T; MoeTab tab; const char* HN; const char* W; const int* tokl; int tid;
    __device__ __forceinline__ bool next(int i, Unit& u) const { return T.next(i, u); }
    __device__ __forceinline__ UPtr ptrs(const Unit& u) const { UPtr p; p.A = HN; p.B = W + ((size_t)tab.mt_e[u.pm] * 1024 + (size_t)u.pn * 256) * D * 2; return p; }
    __device__ __forceinline__ void gather(const Unit& u, unsigned (&off)[2][2]) const {
        const int e = tab.mt_e[u.pm], row0 = tab.mt_row0[u.pm], cnt = tab.cnt[e];
        const GAS int* tl = (const GAS int*)tokl + (size_t)e * M;
        int pr[2][2];
#pragma unroll
        for (int i = 0; i < 2; ++i) { int R, C; pg8::stage_rc(tid * 16 + i * 8192, R, C);
#pragma unroll
            for (int h = 0; h < 2; ++h) { const int idx = row0 + h * 128 + R; pr[h][i] = tl[idx < cnt ? idx : cnt - 1]; } }
#pragma unroll
        for (int i = 0; i < 2; ++i) { int R, C; pg8::stage_rc(tid * 16 + i * 8192, R, C);
#pragma unroll
            for (int h = 0; h < 2; ++h) { const int idx = row0 + h * 128 + R; const int pair = idx < cnt ? pr[h][i] : 0;
                off[h][i] = (unsigned)(pair >> 1) * (unsigned)(D * 2) + (unsigned)C * 2u; } }
    }
};
struct SchedMoeDN {
    static constexpr bool GATHER = false, ROWSKIP = true;
    __device__ __forceinline__ int valid(const Unit& u) const { return tab.cnt[tab.mt_e[u.pm]] - tab.mt_row0[u.pm]; }
    TileOrder T; MoeTab tab; const char* HID; const char* W;
    __device__ __forceinline__ bool next(int i, Unit& u) const { return T.next(i, u); }
    __device__ __forceinline__ UPtr ptrs(const Unit& u) const { UPtr p; p.A = HID + (size_t)u.pm * 256 * DE * 2; p.B = W + ((size_t)tab.mt_e[u.pm] * D + (size_t)u.pn * 256) * DE * 2; return p; }
};

struct EpiU {
    static constexpr bool PERM = true, AFTER_DRAIN = false;
    bf16* UA;
    __device__ __forceinline__ void operator()(const AccT& acc, const Unit& u, int wr, int wc, int fr, int fq) const {
#pragma unroll
        for (int ai = 0; ai < 2; ++ai)
#pragma unroll
            for (int m = 0; m < 4; ++m) { const int t = u.pm * 256 + ai * 128 + wr * 64 + m * 16 + fr;
                const int b = t >> 11, s = t & 2047, ch = s >> 5, j = s & 31;
#pragma unroll
                for (int bj = 0; bj < 2; ++bj) { const int c0 = u.pn * 256 + bj * 128 + wc * 32 + 8 * fq, g = c0 >> 4, hf = (c0 >> 3) & 1;
                    const pg8::f32x4 v0 = acc[ai][bj][m][0], v1 = acc[ai][bj][m][1];
                    v4u w; w.x = cvt_pk_bf16(v0[0], v0[1]); w.y = cvt_pk_bf16(v0[2], v0[3]); w.z = cvt_pk_bf16(v1[0], v1[1]); w.w = cvt_pk_bf16(v1[2], v1[3]);
                    *(GAS v4u*)(UA + ((size_t)(g * 512 + b * 64 + ch) * KP + j * 16 + hf * 8)) = w; } }
    }
};
struct EpiScan {
    static constexpr bool PERM = false, AFTER_DRAIN = true;
    bf16* UA; const float* AL;
    __device__ __forceinline__ void fused(const AccT& acc, const Unit& u, int wr, int wc, int fr, int fq, LAS unsigned char* lds, int wid, int lane) const {
        LAS float* X = (LAS float*)lds;
#pragma unroll
        for (int ai = 0; ai < 2; ++ai)
#pragma unroll
            for (int m = 0; m < 4; ++m) { const int r = ai * 128 + wr * 64 + m * 16 + fr;
#pragma unroll
                for (int n = 0; n < 2; ++n) *(LAS pg8::f32x4*)(X + r * 128 + wc * 32 + n * 16 + 4 * fq) = acc[ai][0][m][n]; }
        LDS_WAIT(); __syncthreads();
        const int tid = wid * 64 + lane;
        if (tid < 256) { const int bl = tid >> 6, n = tid & 63, g = u.pm >> 1;
            const float ar = AL[(g * 64 + n) * 2], ai_ = AL[(g * 64 + n) * 2 + 1];
            float sr = 0.f, si = 0.f;
            bf16* dst = UA + (size_t)(u.pm * 256 + bl * 64) * KP + 512 + 2 * n;
            const LAS float* xs = X + (bl * 64) * 128 + 2 * n;
            for (int c = 0; c < 64; ++c) {
                *(GAS unsigned*)(dst + (size_t)c * KP) = pk2(sr, si);
                const float xr = xs[c * 128], xi = xs[c * 128 + 1];
                const float nr = ar * sr - ai_ * si + xr, ni = ar * si + ai_ * sr + xi; sr = nr; si = ni; }
        }
        __syncthreads();
    }
};
struct EpiY {
    static constexpr bool PERM = true, AFTER_DRAIN = false;
    const bf16* UA; const float* dsk; bf16* GL;
    __device__ __forceinline__ void operator()(const AccT& acc, const Unit& u, int wr, int wc, int fr, int fq) const {
        const int g = u.pm >> 1, n00 = u.pn * 256 + wc * 32 + 8 * fq;
        const GAS bf16* ug = (const GAS bf16*)UA + ((size_t)(g * 512 + (u.pm & 1) * 256 + wr * 64 + fr) * KP + n00);
        v4u uv[4][2]; f32x4 dd[2][2];
#define EY_LOAD(b) { const GAS bf16* p_ = ug + (size_t)(((b) >> 2) * 128 + ((b) & 3) * 16) * KP; uv[(b) & 3][0] = *(const GAS v4u*)p_; uv[(b) & 3][1] = *(const GAS v4u*)(p_ + 128); }
        EY_LOAD(0) EY_LOAD(1) EY_LOAD(2) EY_LOAD(3)
#pragma unroll
        for (int bj = 0; bj < 2; ++bj) { const int hf = ((n00 + bj * 128) >> 3) & 1; dd[bj][0] = *(const GAS f32x4*)(dsk + g * 16 + hf * 8); dd[bj][1] = *(const GAS f32x4*)(dsk + g * 16 + hf * 8 + 4); }
        __builtin_amdgcn_s_waitcnt(0x0F70);
#pragma unroll
        for (int b = 0; b < 8; ++b) { const int ai = b >> 2, m = b & 3;
            const int rl = ai * 128 + wr * 64 + m * 16 + fr, row = (u.pm & 1) * 256 + rl, bb = row >> 6, ch = row & 63;
#pragma unroll
            for (int bj = 0; bj < 2; ++bj) { const int n0 = n00 + bj * 128, i = n0 >> 4, hf = (n0 >> 3) & 1;
                const v4u uu = uv[m][bj]; const f32x4 d0 = dd[bj][0], d1 = dd[bj][1];
                const pg8::f32x4 v0 = acc[ai][bj][m][0], v1 = acc[ai][bj][m][1];
                float y[8];
                y[0] = v0[0] + d0.x * bf_lo(uu.x); y[1] = v0[1] + d0.y * bf_hi(uu.x); y[2] = v0[2] + d0.z * bf_lo(uu.y); y[3] = v0[3] + d0.w * bf_hi(uu.y);
                y[4] = v1[0] + d1.x * bf_lo(uu.z); y[5] = v1[1] + d1.y * bf_hi(uu.z); y[6] = v1[2] + d1.z * bf_lo(uu.w); y[7] = v1[3] + d1.w * bf_hi(uu.w);
#pragma unroll
                for (int e = 0; e < 8; ++e) y[e] = gelu_tanh_(y[e]);
                v4u w; w.x = cvt_pk_bf16(y[0], y[1]); w.y = cvt_pk_bf16(y[2], y[3]); w.z = cvt_pk_bf16(y[4], y[5]); w.w = cvt_pk_bf16(y[6], y[7]);
                const size_t tok = (size_t)bb * SEQ + ch * LCH + i;
                *(GAS v4u*)(GL + tok * DS + g * 16 + hf * 8) = w; }
            if (b + 4 < 8) EY_LOAD(b + 4) }
#undef EY_LOAD
    }
};
struct EpiGlu {
    static constexpr bool PERM = true, AFTER_DRAIN = false;
    const bf16* GL; const float* bias; bf16* OG;
    __device__ __forceinline__ void operator()(const AccT& acc, const Unit& u, int wr, int wc, int fr, int fq) const {
        const int c00 = u.pn * 256 + wc * 32 + 8 * fq;
        const GAS bf16* gp = (const GAS bf16*)GL + ((size_t)u.pm * 256 + wr * 64 + fr) * DS + c00;
        v4u gv[4][2]; f32x4 bb[2][2];
#define EG_LOAD(b) { const GAS bf16* p_ = gp + (size_t)(((b) >> 2) * 128 + ((b) & 3) * 16) * DS; gv[(b) & 3][0] = *(const GAS v4u*)p_; gv[(b) & 3][1] = *(const GAS v4u*)(p_ + 128); }
        EG_LOAD(0) EG_LOAD(1) EG_LOAD(2) EG_LOAD(3)
#pragma unroll
        for (int bj = 0; bj < 2; ++bj) { bb[bj][0] = *(const GAS f32x4*)(bias + c00 + bj * 128); bb[bj][1] = *(const GAS f32x4*)(bias + c00 + bj * 128 + 4); }
        __builtin_amdgcn_s_waitcnt(0x0F70);
#pragma unroll
        for (int b = 0; b < 8; ++b) { const int ai = b >> 2, m = b & 3; const size_t row = (size_t)u.pm * 256 + ai * 128 + wr * 64 + m * 16 + fr;
#pragma unroll
            for (int bj = 0; bj < 2; ++bj) { const int c0 = c00 + bj * 128; const v4u gg = gv[m][bj]; const f32x4 b0 = bb[bj][0], b1 = bb[bj][1];
                const pg8::f32x4 v0 = acc[ai][bj][m][0], v1 = acc[ai][bj][m][1];
                float o[8];
                o[0] = bf_lo(gg.x) * sigmoidf_(v0[0] + b0.x); o[1] = bf_hi(gg.x) * sigmoidf_(v0[1] + b0.y); o[2] = bf_lo(gg.y) * sigmoidf_(v0[2] + b0.z); o[3] = bf_hi(gg.y) * sigmoidf_(v0[3] + b0.w);
                o[4] = bf_lo(gg.z) * sigmoidf_(v1[0] + b1.x); o[5] = bf_hi(gg.z) * sigmoidf_(v1[1] + b1.y); o[6] = bf_lo(gg.w) * sigmoidf_(v1[2] + b1.z); o[7] = bf_hi(gg.w) * sigmoidf_(v1[3] + b1.w);
                v4u w; w.x = cvt_pk_bf16(o[0], o[1]); w.y = cvt_pk_bf16(o[2], o[3]); w.z = cvt_pk_bf16(o[4], o[5]); w.w = cvt_pk_bf16(o[6], o[7]);
                *(GAS v4u*)(OG + row * DS + c0) = w; }
            if (b + 4 < 8) EG_LOAD(b + 4) }
#undef EG_LOAD
    }
};
struct EpiRes {
    static constexpr bool PERM = false, AFTER_DRAIN = false;
    const float* base; float* out;
    __device__ __forceinline__ void operator()(const AccT& acc, const Unit& u, int wr, int wc, int fr, int fq) const {
#pragma unroll
        for (int ai = 0; ai < 2; ++ai)
#pragma unroll
            for (int m = 0; m < 4; ++m) { const size_t off = ((size_t)u.pm * 256 + ai * 128 + wr * 64 + m * 16 + fr) * D + u.pn * 256 + wc * 32 + 4 * fq;
#pragma unroll
                for (int bj = 0; bj < 2; ++bj)
#pragma unroll
                    for (int n = 0; n < 2; ++n) { const f32x4 bs = *(const GAS f32x4*)(base + off + bj * 128 + n * 16); const pg8::f32x4 a = acc[ai][bj][m][n];
                        f32x4 o; o.x = bs.x + a[0]; o.y = bs.y + a[1]; o.z = bs.z + a[2]; o.w = bs.w + a[3];
                        *(GAS f32x4*)(out + off + bj * 128 + n * 16) = o; }
                asm volatile("" ::: "memory"); }
    }
};
struct EpiResYP {
    static constexpr bool PERM = false, AFTER_DRAIN = false;
    float* out; const bf16* YP;
    __device__ __forceinline__ void operator()(const AccT& acc, const Unit& u, int wr, int wc, int fr, int fq) const {
#pragma unroll
        for (int ai = 0; ai < 2; ++ai)
#pragma unroll
            for (int m = 0; m < 4; ++m) { const size_t row = (size_t)u.pm * 256 + ai * 128 + wr * 64 + m * 16 + fr; const int col = u.pn * 256 + wc * 32 + 4 * fq;
#pragma unroll
                for (int bj = 0; bj < 2; ++bj)
#pragma unroll
                    for (int n = 0; n < 2; ++n) { const int c = col + bj * 128 + n * 16;
                        const f32x4 bs = *(const GAS f32x4*)(out + row * D + c); const v2u y0 = *(const GAS v2u*)(YP + (2 * row) * D + c), y1 = *(const GAS v2u*)(YP + (2 * row + 1) * D + c);
                        const pg8::f32x4 a = acc[ai][bj][m][n];
                        f32x4 o; o.x = bs.x + bf_lo(y0.x) + bf_lo(y1.x) + a[0]; o.y = bs.y + bf_hi(y0.x) + bf_hi(y1.x) + a[1]; o.z = bs.z + bf_lo(y0.y) + bf_lo(y1.y) + a[2]; o.w = bs.w + bf_hi(y0.y) + bf_hi(y1.y) + a[3];
                        *(GAS f32x4*)(out + row * D + c) = o; }
                asm volatile("" ::: "memory"); }
    }
};
__device__ __forceinline__ float sumsq8(const v4u w) { float s = 0.f; s += bf_lo(w.x) * bf_lo(w.x) + bf_hi(w.x) * bf_hi(w.x); s += bf_lo(w.y) * bf_lo(w.y) + bf_hi(w.y) * bf_hi(w.y);
    s += bf_lo(w.z) * bf_lo(w.z) + bf_hi(w.z) * bf_hi(w.z); s += bf_lo(w.w) * bf_lo(w.w) + bf_hi(w.w) * bf_hi(w.w); return s; }
struct EpiResB {
    static constexpr bool PERM = true, AFTER_DRAIN = false;
    const float* x; bf16* HB; float* SS;
    __device__ __forceinline__ void operator()(const AccT& acc, const Unit& u, int wr, int wc, int fr, int fq) const {
        const int c00 = u.pn * 256 + wc * 32 + 8 * fq;
        const GAS float* xg = (const GAS float*)x + ((size_t)u.pm * 256 + wr * 64 + fr) * D + c00;
        f32x4 xv[4][2][2];
#define RB_LOAD(b) { const GAS float* p_ = xg + (size_t)(((b) >> 2) * 128 + ((b) & 3) * 16) * D; _Pragma("unroll") for (int bj = 0; bj < 2; ++bj) { xv[(b) & 3][bj][0] = *(const GAS f32x4*)(p_ + bj * 128); xv[(b) & 3][bj][1] = *(const GAS f32x4*)(p_ + bj * 128 + 4); } }
        RB_LOAD(0) RB_LOAD(1) RB_LOAD(2) RB_LOAD(3)
        __builtin_amdgcn_s_waitcnt(0x0F70);
#pragma unroll
        for (int b = 0; b < 8; ++b) { const int ai = b >> 2, m = b & 3; const size_t row = (size_t)u.pm * 256 + ai * 128 + wr * 64 + m * 16 + fr; float ssq = 0.f;
#pragma unroll
            for (int bj = 0; bj < 2; ++bj) { const int c = c00 + bj * 128; const f32x4 x0 = xv[m][bj][0], x1 = xv[m][bj][1];
                const pg8::f32x4 v0 = acc[ai][bj][m][0], v1 = acc[ai][bj][m][1];
                v4u w; w.x = cvt_pk_bf16(x0.x + v0[0], x0.y + v0[1]); w.y = cvt_pk_bf16(x0.z + v0[2], x0.w + v0[3]); w.z = cvt_pk_bf16(x1.x + v1[0], x1.y + v1[1]); w.w = cvt_pk_bf16(x1.z + v1[2], x1.w + v1[3]);
                *(GAS v4u*)(HB + row * D + c) = w; ssq += sumsq8(w); }
            ssq += __shfl_xor(ssq, 16); ssq += __shfl_xor(ssq, 32);
            if (fq == 0) SS[row * 32 + u.pn * 4 + wc] = ssq;
            if (b + 4 < 8) RB_LOAD(b + 4) }
#undef RB_LOAD
    }
};
struct EpiResYPB {
    static constexpr bool PERM = true, AFTER_DRAIN = false;
    bf16* HB; const bf16* YP; float* SS;
    __device__ __forceinline__ void operator()(const AccT& acc, const Unit& u, int wr, int wc, int fr, int fq) const {
        const int c00 = u.pn * 256 + wc * 32 + 8 * fq;
        const size_t r00 = (size_t)u.pm * 256 + wr * 64 + fr;
        const GAS bf16* hg = (const GAS bf16*)HB + r00 * D + c00; const GAS bf16* yg = (const GAS bf16*)YP + (2 * r00) * D + c00;
        v4u hv[4][2], y0v[4][2], y1v[4][2];
#define RY_LOAD(b) { const size_t ro_ = (size_t)(((b) >> 2) * 128 + ((b) & 3) * 16); _Pragma("unroll") for (int bj = 0; bj < 2; ++bj) { \
            hv[(b) & 3][bj] = *(const GAS v4u*)(hg + ro_ * D + bj * 128); y0v[(b) & 3][bj] = *(const GAS v4u*)(yg + (2 * ro_) * D + bj * 128); y1v[(b) & 3][bj] = *(const GAS v4u*)(yg + (2 * ro_ + 1) * D + bj * 128); } }
        RY_LOAD(0) RY_LOAD(1) RY_LOAD(2) RY_LOAD(3)
        __builtin_amdgcn_s_waitcnt(0x0F70);
#pragma unroll
        for (int b = 0; b < 8; ++b) { const int ai = b >> 2, m = b & 3; const size_t row = (size_t)u.pm * 256 + ai * 128 + wr * 64 + m * 16 + fr; float ssq = 0.f;
#pragma unroll
            for (int bj = 0; bj < 2; ++bj) { const int c = c00 + bj * 128; const v4u hb = hv[m][bj], y0 = y0v[m][bj], y1 = y1v[m][bj];
                const pg8::f32x4 v0 = acc[ai][bj][m][0], v1 = acc[ai][bj][m][1];
                v4u w;
                w.x = cvt_pk_bf16(bf_lo(hb.x) + bf_lo(y0.x) + bf_lo(y1.x) + v0[0], bf_hi(hb.x) + bf_hi(y0.x) + bf_hi(y1.x) + v0[1]);
                w.y = cvt_pk_bf16(bf_lo(hb.y) + bf_lo(y0.y) + bf_lo(y1.y) + v0[2], bf_hi(hb.y) + bf_hi(y0.y) + bf_hi(y1.y) + v0[3]);
                w.z = cvt_pk_bf16(bf_lo(hb.z) + bf_lo(y0.z) + bf_lo(y1.z) + v1[0], bf_hi(hb.z) + bf_hi(y0.z) + bf_hi(y1.z) + v1[1]);
                w.w = cvt_pk_bf16(bf_lo(hb.w) + bf_lo(y0.w) + bf_lo(y1.w) + v1[2], bf_hi(hb.w) + bf_hi(y0.w) + bf_hi(y1.w) + v1[3]);
                *(GAS v4u*)(HB + row * D + c) = w; ssq += sumsq8(w); }
            ssq += __shfl_xor(ssq, 16); ssq += __shfl_xor(ssq, 32);
            if (fq == 0) SS[row * 32 + u.pn * 4 + wc] = ssq;
            if (b + 4 < 8) RY_LOAD(b + 4) }
#undef RY_LOAD
    }
};
struct EpiGU {
    static constexpr bool PERM = true, AFTER_DRAIN = false;
    bf16* HID; MoeTab tab; const float* tokr;
    __device__ __forceinline__ void operator()(const AccT& acc, const Unit& u, int wr, int wc, int fr, int fq) const {
        const int e_ = tab.mt_e[u.pm], row0_ = tab.mt_row0[u.pm], cnt_ = tab.cnt[e_];
        const GAS float* tr = (const GAS float*)tokr + (size_t)e_ * M;
        float rsv[8];
#pragma unroll
        for (int b = 0; b < 8; ++b) { const int idx_ = row0_ + (b >> 2) * 128 + wr * 64 + (b & 3) * 16 + fr; rsv[b] = tr[idx_ < cnt_ ? idx_ : cnt_ - 1]; }
        __builtin_amdgcn_s_waitcnt(0x0F70);
#pragma unroll
        for (int ai = 0; ai < 2; ++ai) { if (u.half >= 0 && u.half != ai) continue;
#pragma unroll
            for (int m = 0; m < 4; ++m) { const size_t row = (size_t)u.pm * 256 + ai * 128 + wr * 64 + m * 16 + fr;
                const int idx_ = row0_ + ai * 128 + wr * 64 + m * 16 + fr; const float rs = idx_ < cnt_ ? rsv[ai * 4 + m] : 0.f;
                float h[8];
#pragma unroll
                for (int n = 0; n < 2; ++n)
#pragma unroll
                    for (int e = 0; e < 4; ++e) { const float gt = acc[ai][0][m][n][e] * rs, up = acc[ai][1][m][n][e] * rs; h[n * 4 + e] = gt * sigmoidf_(gt) * up; }
                v4u w; w.x = cvt_pk_bf16(h[0], h[1]); w.y = cvt_pk_bf16(h[2], h[3]); w.z = cvt_pk_bf16(h[4], h[5]); w.w = cvt_pk_bf16(h[6], h[7]);
                *(GAS v4u*)(HID + row * DE + u.pn * 128 + wc * 32 + 8 * fq) = w; } }
    }
};
struct EpiDN {
    static constexpr bool PERM = true, AFTER_DRAIN = false;
    MoeTab tab; const int* tokl; const float* tokw; bf16* YP;
    __device__ __forceinline__ void operator()(const AccT& acc, const Unit& u, int wr, int wc, int fr, int fq) const {
        const int e = tab.mt_e[u.pm], row0 = tab.mt_row0[u.pm], cnt = tab.cnt[e];
        const GAS int* tl = (const GAS int*)tokl + (size_t)e * M; const GAS float* tw = (const GAS float*)tokw + (size_t)e * M;
        int pr[8]; float wg[8];
#pragma unroll
        for (int b = 0; b < 8; ++b) { const int idx = row0 + (b >> 2) * 128 + wr * 64 + (b & 3) * 16 + fr, ic = idx < cnt ? idx : cnt - 1; pr[b] = tl[ic]; wg[b] = tw[ic]; }
        __builtin_amdgcn_s_waitcnt(0x0F70);
#pragma unroll
        for (int ai = 0; ai < 2; ++ai) { if (u.half >= 0 && u.half != ai) continue;
#pragma unroll
            for (int m = 0; m < 4; ++m) { const int idx = row0 + ai * 128 + wr * 64 + m * 16 + fr;
                if (idx < cnt) { const int pair = pr[ai * 4 + m]; const float wgt = wg[ai * 4 + m];
#pragma unroll
                    for (int bj = 0; bj < 2; ++bj) { const pg8::f32x4 v0 = acc[ai][bj][m][0], v1 = acc[ai][bj][m][1];
                        v4u w; w.x = cvt_pk_bf16(v0[0] * wgt, v0[1] * wgt); w.y = cvt_pk_bf16(v0[2] * wgt, v0[3] * wgt); w.z = cvt_pk_bf16(v1[0] * wgt, v1[1] * wgt); w.w = cvt_pk_bf16(v1[2] * wgt, v1[3] * wgt);
                        *(GAS v4u*)(YP + (size_t)pair * D + u.pn * 256 + bj * 128 + wc * 32 + 8 * fq) = w; } } } }
    }
};
struct EpiQKVG {
    static constexpr bool PERM = true, AFTER_DRAIN = false;
    bf16* Q; size_t tstride;
    __device__ __forceinline__ void operator()(const AccT& acc, const Unit& u, int wr, int wc, int fr, int fq) const {
        const int t = u.pn >> 3; bf16* base = Q + (size_t)t * tstride; const int col0 = (u.pn & 7) * 256 + wc * 32 + 8 * fq;
#pragma unroll
        for (int ai = 0; ai < 2; ++ai)
#pragma unroll
            for (int m = 0; m < 4; ++m) { bf16* rowp = base + ((size_t)u.pm * 256 + ai * 128 + wr * 64 + m * 16 + fr) * D + col0;
#pragma unroll
                for (int bj = 0; bj < 2; ++bj) { pg8::f32x4 v0 = acc[ai][bj][m][0], v1 = acc[ai][bj][m][1];
                    if (t == 3) {
#pragma unroll
                        for (int e = 0; e < 4; ++e) { v0[e] = sigmoidf_(v0[e]); v1[e] = sigmoidf_(v1[e]); } }
                    v4u w; w.x = cvt_pk_bf16(v0[0], v0[1]); w.y = cvt_pk_bf16(v0[2], v0[3]); w.z = cvt_pk_bf16(v1[0], v1[1]); w.w = cvt_pk_bf16(v1[2], v1[3]);
                    *(GAS v4u*)(rowp + bj * 128) = w; } }
    }
};

namespace fox {
constexpr int AD = 128, PITCH = 2048;
constexpr float SCALE = 0.08838834764831845f;
constexpr float THR = 24.f;
constexpr int NW = 8, QBLK = 32, KVBLK = 64, QB = NW * QBLK;
constexpr int SHM_V = KVBLK * AD * 2, SHM_K = KVBLK * AD * 2;
constexpr int WS_OFF = 2 * SHM_V + 2 * SHM_K;
constexpr int BIAS_OFF = WS_OFF + NW * 64 * 4;
constexpr int ATT_LDS_BYTES = BIAS_OFF + 2 * SEQ * 4;
constexpr int GATE_OFF = 86016;
static_assert(GATE_OFF >= ATT_LDS_BYTES && GATE_OFF % 16 == 0, "gate tiles above the K/V/bias region");
typedef short s16x4 __attribute__((ext_vector_type(4)));

#define KSWZ(row, colB) ((row) * 256 + ((colB) ^ (((row) & 7) << 4)))
#define SBAR() __builtin_amdgcn_sched_barrier(0)
__device__ __forceinline__ int v_st(int k, int c) { const int kk = (k & ~0xC) | ((k & 4) << 1) | ((k & 8) >> 1); return ((kk >> 3) * 4 + (c >> 5)) * 512 + ((kk & 7) * 32 + (c & 31)) * 2; }
__device__ __forceinline__ int v_rd_base(int lane) { return ((lane & 3) << 3) | (((lane >> 2) & 3) << 6) | (((lane >> 4) & 1) << 5) | (((lane >> 5) & 1) << 8); }
constexpr int v_rd_off(int d0, int ks, int half) { return d0 * 512 + ks * 4096 + half * 2048; }
__device__ __forceinline__ int crow(int r, int hi) { return (r & 3) + 8 * (r >> 2) + 4 * hi; }
__device__ __forceinline__ unsigned cvtpk(float lo, float hi) { unsigned r; asm volatile("v_cvt_pk_bf16_f32 %0, %1, %2" : "=v"(r) : "v"(lo), "v"(hi)); return r; }
__device__ __forceinline__ bf16x8 ld8(const GAS char* ubase, unsigned voff) { return *(const GAS bf16x8*)(ubase + voff); }
constexpr size_t VK_DELTA = (size_t)64 << 20;
__device__ __forceinline__ void mask_tile(f32x16& p0, f32x16& p1, int dq) {
    const float NEG = -__builtin_inff();
#pragma unroll
    for (int r = 0; r < 16; ++r) {
        const int c = (r & 3) + 8 * (r >> 2);
        if (dq - c < 0) p0[r] = NEG;
        if (dq - c - 32 < 0) p1[r] = NEG;
    }
}
__device__ __forceinline__ void partialSM(f32x16& p0, f32x16& p1, float& m_reg, float& mn, float& alpha) {
    float pmax = p0[0]; for (int r = 1; r < 16; ++r) pmax = fmaxf(pmax, p0[r]); for (int r = 0; r < 16; ++r) pmax = fmaxf(pmax, p1[r]);
    { auto rr = __builtin_amdgcn_permlane32_swap(__float_as_uint(pmax), __float_as_uint(pmax), false, false);
      pmax = fmaxf(__uint_as_float(rr[0]), __uint_as_float(rr[1])); }
    constexpr float C2 = 1.4426950408889634f * SCALE;
    if (__builtin_expect(__all((pmax - m_reg) * SCALE <= THR), 1)) { mn = m_reg; alpha = 1.f; }
    else { mn = fmaxf(m_reg, pmax); alpha = __builtin_amdgcn_exp2f((m_reg - mn) * C2); m_reg = mn; }
    const float mnL = -mn * C2;
    for (int r = 0; r < 16; ++r) p0[r] = fmaf(p0[r], C2, mnL); for (int r = 0; r < 16; ++r) p1[r] = fmaf(p1[r], C2, mnL);
    for (int r = 0; r < 16; ++r) p0[r] = __builtin_amdgcn_exp2f(p0[r]);
}
__device__ __forceinline__ void finishSM(f32x16& p0, f32x16& p1, float alpha, float& l_reg, bf16x8& pa0, bf16x8& pa1, bf16x8& pa2, bf16x8& pa3) {
    for (int r = 0; r < 16; ++r) p1[r] = __builtin_amdgcn_exp2f(p1[r]);
    float ps = 0; for (int r = 0; r < 16; ++r) ps += p0[r]; for (int r = 0; r < 16; ++r) ps += p1[r];
    { auto rr = __builtin_amdgcn_permlane32_swap(__float_as_uint(ps), __float_as_uint(ps), false, false);
      ps = __uint_as_float(rr[0]) + __uint_as_float(rr[1]); }
    l_reg = l_reg * alpha + ps;
#define PK4(P, B_, OUT) do { unsigned a0 = cvtpk(P[B_+0], P[B_+1]), a1 = cvtpk(P[B_+2], P[B_+3]);                          \
        unsigned b0 = cvtpk(P[B_+4], P[B_+5]), b1 = cvtpk(P[B_+6], P[B_+7]);                                             \
        auto r0 = __builtin_amdgcn_permlane32_swap(a0, b0, false, false); auto r1 = __builtin_amdgcn_permlane32_swap(a1, b1, false, false); \
        v4u w = {r0[0], r1[0], r0[1], r1[1]}; OUT = *reinterpret_cast<bf16x8*>(&w); } while (0)
    PK4(p0, 0, pa0); PK4(p0, 8, pa1); PK4(p1, 0, pa2); PK4(p1, 8, pa3);
#undef PK4
}
template <int KB>
__device__ __forceinline__ void qkt(f32x16& p0, f32x16& p1, const char* K_lds, int r32, int hi, const bf16x8* qr, const float* bias_t  ) {
#pragma unroll
    for (int g = 0; g < 4; ++g) { const f32x4 b0 = *(const f32x4*)(bias_t + 8 * g), b1 = *(const f32x4*)(bias_t + 32 + 8 * g);
        p0[4 * g] = b0.x; p0[4 * g + 1] = b0.y; p0[4 * g + 2] = b0.z; p0[4 * g + 3] = b0.w;
        p1[4 * g] = b1.x; p1[4 * g + 1] = b1.y; p1[4 * g + 2] = b1.z; p1[4 * g + 3] = b1.w; }
    const char* kb[4];
#pragma unroll
    for (int dd = 0; dd < 4; ++dd) kb[dd] = K_lds + KB * SHM_K + KSWZ(r32, (dd * 16 + hi * 8) * 2);
#pragma unroll
    for (int d0 = 0; d0 < 8; ++d0) { const char* a = kb[d0 & 3] + (d0 >> 2) * 128;
        bf16x8 b0 = *reinterpret_cast<const bf16x8*>(a);
        bf16x8 b1 = *reinterpret_cast<const bf16x8*>(a + 32 * 256);
        p0 = __builtin_amdgcn_mfma_f32_32x32x16_bf16(b0, qr[d0], p0, 0, 0, 0);
        p1 = __builtin_amdgcn_mfma_f32_32x32x16_bf16(b1, qr[d0], p1, 0, 0, 0); }
}
template <int VB>
__device__ __forceinline__ void pv_tile(f32x16* o, int vb0, bf16x8 pa0, bf16x8 pa1, bf16x8 pa2, bf16x8 pa3) {
#define TRRD(dst, off) asm volatile("ds_read_b64_tr_b16 %0, %1 offset:%2" : "=&v"(dst) : "v"(vb0), "i"(off) : "memory")
#define PV_D0(d0) do { s16x4 l0, l1, l2, l3, h0, h1, h2, h3; constexpr int b_ = VB * SHM_V + v_rd_off(d0, 0, 0); \
        TRRD(l0, b_); TRRD(h0, b_ + 2048); TRRD(l1, b_ + 4096); TRRD(h1, b_ + 6144); TRRD(l2, b_ + 8192); TRRD(h2, b_ + 10240); TRRD(l3, b_ + 12288); TRRD(h3, b_ + 14336); \
        asm volatile("s_waitcnt lgkmcnt(0)" ::: "memory"); SBAR();   \
        o[d0] = __builtin_amdgcn_mfma_f32_32x32x16_bf16(pa0, (bf16x8){l0[0], l0[1], l0[2], l0[3], h0[0], h0[1], h0[2], h0[3]}, o[d0], 0, 0, 0);   \
        o[d0] = __builtin_amdgcn_mfma_f32_32x32x16_bf16(pa1, (bf16x8){l1[0], l1[1], l1[2], l1[3], h1[0], h1[1], h1[2], h1[3]}, o[d0], 0, 0, 0);   \
        o[d0] = __builtin_amdgcn_mfma_f32_32x32x16_bf16(pa2, (bf16x8){l2[0], l2[1], l2[2], l2[3], h2[0], h2[1], h2[2], h2[3]}, o[d0], 0, 0, 0);   \
        o[d0] = __builtin_amdgcn_mfma_f32_32x32x16_bf16(pa3, (bf16x8){l3[0], l3[1], l3[2], l3[3], h3[0], h3[1], h3[2], h3[3]}, o[d0], 0, 0, 0); } while (0)
    PV_D0(0); PV_D0(1); PV_D0(2); PV_D0(3);
#undef PV_D0
#undef TRRD
}

struct BlockRef { const GAS char* Q; const GAS char* K; GAS char* O; const GAS char* SG; const GAS char* CB; int P0; int par; };
struct Seam { bf16x8 qr[8]; bf16x8 st_v0, st_v1, st_k0, st_k1; };
#define KVP(Kp, k0) ((Kp) + (size_t)(k0) * (PITCH * 2))
#define VMW() asm volatile("s_waitcnt vmcnt(0)" ::: "memory")
#define VMWN(n) asm volatile("s_waitcnt vmcnt(%0)" :: "i"(n) : "memory")
#define SLOAD_H(Kp, k0) do { S.st_v0 = ld8(KVP(Kp, k0) + VK_DELTA, kvo0); S.st_v1 = ld8(KVP(Kp, k0) + VK_DELTA, kvo1);              \
                         S.st_k0 = ld8(KVP(Kp, k0), kvo0); S.st_k1 = ld8(KVP(Kp, k0), kvo1); } while (0)
#define SWRITE_HK(bf) do { *(bf16x8*)(K_lds + (bf) * SHM_K + kws) = S.st_k0; *(bf16x8*)(K_lds + (bf) * SHM_K + kws + 32 * 256) = S.st_k1; } while (0)
#define SWRITE_HV(bf) do { *(bf16x8*)(V_lds + (bf) * SHM_V + vst0) = S.st_v0; *(bf16x8*)(V_lds + (bf) * SHM_V + vst1) = S.st_v1; } while (0)
#define SWRITE_H(bf) do { SWRITE_HV(bf); SWRITE_HK(bf); } while (0)
#define QLOAD(blk) do { const GAS char* qb_ = (blk).Q + (size_t)wid * (QBLK * PITCH * 2); _Pragma("unroll") for (int d0 = 0; d0 < 8; ++d0) S.qr[d0] = ld8(qb_ + d0 * 32, qvo); } while (0)
#define GATE_DMA(blk) do { const GAS char* gs_ = (blk).SG + (size_t)wid * (QBLK * PITCH * 2); _Pragma("unroll") for (int i_ = 0; i_ < 8; ++i_) \
        __builtin_amdgcn_global_load_lds((const GAS unsigned*)(gs_ + (size_t)i_ * (4 * PITCH * 2) + gvo), (LAS unsigned*)(lds + GATE_OFF + wid * 8192 + i_ * 1024), 16, 0, 0); } while (0)
#define BIAS_DMA(blk) __builtin_amdgcn_global_load_lds((const GAS unsigned*)((blk).CB + wid * 1024 + bvo), (LAS unsigned*)(lds + BIAS_OFF + (blk).par * (SEQ * 4) + wid * 1024), 16, 0, 0)
__device__ __forceinline__ void fox_prime(const BlockRef& cur, char* lds, Seam& S, const int tid) {
    const int wid = __builtin_amdgcn_readfirstlane(tid >> 6), lane = tid & 63, r32 = lane & 31, hi = lane >> 5;
    const int sr = tid >> 4, sc = (tid & 15) * 8, kws = KSWZ(sr, sc * 2); char* K_lds = lds + 2 * SHM_V;
    unsigned kvo0 = (unsigned)(sr * PITCH + sc) * 2u, kvo1 = kvo0 + 32u * PITCH * 2u, qvo = (unsigned)(r32 * PITCH + hi * 8) * 2u, bvo = (unsigned)(lane * 16), gvo = (unsigned)((lane >> 4) * (PITCH * 2) + (lane & 15) * 16);
    asm volatile("" : "+v"(kvo0), "+v"(kvo1), "+v"(qvo), "+v"(bvo), "+v"(gvo));
    BIAS_DMA(cur); GATE_DMA(cur);
    QLOAD(cur);
    SLOAD_H(cur.K, 0); VMW(); SWRITE_HK(0);
    __syncthreads();
}
__device__ __forceinline__ void fox_block(const BlockRef& cur, const BlockRef& nxt, char* lds, Seam& S, const int tid) {
    const int wid = __builtin_amdgcn_readfirstlane(tid >> 6), lane = tid & 63, r32 = lane & 31, hi = lane >> 5;
    const int NT = (cur.P0 + QB - 1) / KVBLK + 1;
    const int qlo = cur.P0 + wid * QBLK, qm = qlo + r32 - 4 * hi;
    char* V_lds = lds; char* K_lds = lds + 2 * SHM_V;
    float* ws = (float*)(lds + WS_OFF) + wid * 64; float* li_l = ws, * al_l = ws + 32;
    const float* bias_l = (const float*)(lds + BIAS_OFF + cur.par * (SEQ * 4)) + 4 * hi;
    float m_reg = -1e30f, l_reg = 0; f32x16 o[4] = {};
    const int sr = tid >> 4, sc = (tid & 15) * 8, vst0 = v_st(sr, sc), vst1 = v_st(32 + sr, sc), kws = KSWZ(sr, sc * 2);
    const int vb0 = (int)(uintptr_t)V_lds + v_rd_base(lane);
    const GAS char* Kh = cur.K;
    unsigned kvo0 = (unsigned)(sr * PITCH + sc) * 2u, kvo1 = kvo0 + 32u * PITCH * 2u, qvo = (unsigned)(r32 * PITCH + hi * 8) * 2u, bvo = (unsigned)(lane * 16), gvo = (unsigned)((lane >> 4) * (PITCH * 2) + (lane & 15) * 16);
    asm volatile("" : "+v"(kvo0), "+v"(kvo1), "+v"(qvo), "+v"(bvo), "+v"(gvo));
#define RESC(a) do { if (__any((a) < 1.f)) { if (hi == 0) al_l[r32] = (a); asm volatile("s_waitcnt lgkmcnt(0)" ::: "memory");              \
                     for (int d_ = 0; d_ < 4; ++d_) for (int r = 0; r < 16; ++r) o[d_][r] *= al_l[crow(r, hi)]; } } while (0)
#define KBASE(t) ((t) * KVBLK)
#define MASKT(P0_, P1_, t) do { const int kb_ = KBASE(t); if (kb_ + KVBLK - 1 > qlo) mask_tile(P0_, P1_, qm - kb_); } while (0)
    constexpr int NQL = 8;
#define SEAM_K0() do { VMWN(NQL); SWRITE_HK(0); SBAR(); } while (0)
    f32x16 pA0, pA1, pB0, pB1; float mnA, mnB, alA, alB; bf16x8 pa0, pa1, pa2, pa3;
    SWRITE_HV(0); SBAR();
    if (NT > 1) { SLOAD_H(Kh, KBASE(1)); }
    SBAR(); qkt<0>(pA0, pA1, K_lds, r32, hi, S.qr, bias_l + KBASE(0));
    MASKT(pA0, pA1, 0); partialSM(pA0, pA1, m_reg, mnA, alA);
    if (NT > 1) { VMW(); SWRITE_H(1); }
    __syncthreads();
#define HALF_STEP(PX0, PX1, mnX, alX, PY0, PY1, alY, t, KB, VB, SB) do {                                                      \
        SBAR(); qkt<KB>(PX0, PX1, K_lds, r32, hi, S.qr, bias_l + KBASE(t));                                                   \
        finishSM(PY0, PY1, alY, l_reg, pa0, pa1, pa2, pa3); SBAR();                                                           \
        if ((t) + 1 < NT) { SLOAD_H(Kh, KBASE((t) + 1)); SBAR(); }                                                        \
        pv_tile<VB>(o, vb0, pa0, pa1, pa2, pa3); MASKT(PX0, PX1, (t)); partialSM(PX0, PX1, m_reg, mnX, alX);                  \
        __syncthreads();                                                                                                      \
        if ((t) + 1 < NT) { VMW(); SWRITE_H(SB); }                                                                            \
        RESC(alX); __syncthreads(); } while (0)
    for (int t = 1; t + 1 < NT; t += 2) {
        HALF_STEP(pB0, pB1, mnB, alB, pA0, pA1, alA, t, 1, 0, 0);
        HALF_STEP(pA0, pA1, mnA, alA, pB0, pB1, alB, t + 1, 0, 1, 1);
    }
    const bool even = (NT & 1) == 0;
    if (even) { SBAR(); qkt<1>(pB0, pB1, K_lds, r32, hi, S.qr, bias_l + KBASE(NT - 1)); SBAR(); }
    BIAS_DMA(nxt);
    SLOAD_H(nxt.K, 0); SBAR();
    QLOAD(nxt);
    SBAR();
    finishSM(pA0, pA1, alA, l_reg, pa0, pa1, pa2, pa3); SBAR();
    pv_tile<0>(o, vb0, pa0, pa1, pa2, pa3);
    if (even) { MASKT(pB0, pB1, NT - 1); partialSM(pB0, pB1, m_reg, mnB, alB); __syncthreads(); RESC(alB);
        finishSM(pB0, pB1, alB, l_reg, pa0, pa1, pa2, pa3); SBAR(); pv_tile<1>(o, vb0, pa0, pa1, pa2, pa3); }
    SBAR(); SEAM_K0();
    if (hi == 0) li_l[r32] = l_reg; asm volatile("s_waitcnt lgkmcnt(0)" ::: "memory");
    float rli[16];
#pragma unroll
    for (int r = 0; r < 16; ++r) rli[r] = __builtin_amdgcn_rcpf(li_l[crow(r, hi)]);
    const char* gate_l = lds + GATE_OFF + wid * 8192 + (4 * hi) * 256 + r32 * 2;
    GAS char* Ow = cur.O + (size_t)wid * (QBLK * PITCH * 2); unsigned ovo = (unsigned)(4 * hi * PITCH + r32) * 2u; asm volatile("" : "+v"(ovo));
#pragma unroll
    for (int r = 0; r < 16; ++r) { GAS char* Or = Ow + (size_t)((r & 3) + 8 * (r >> 2)) * (PITCH * 2);
#pragma unroll
        for (int d0 = 0; d0 < 4; ++d0) { const float v = o[d0][r] * rli[r];
            const float vn = __shfl_xor(v, 1);
            if ((r32 & 1) == 0) { const unsigned gg = *(const unsigned*)(gate_l + ((r & 3) + 8 * (r >> 2)) * 256 + d0 * 64);
                *(GAS unsigned*)(Or + d0 * 64 + ovo) = cvtpk(v * pg8::bf_lo(gg), vn * pg8::bf_hi(gg)); } } }
    asm volatile("s_waitcnt lgkmcnt(0)" ::: "memory"); SBAR();
    GATE_DMA(nxt);
    __syncthreads();
#undef RESC
#undef KBASE
#undef MASKT
#undef SEAM_K0
#undef HALF_STEP
}
#undef KVP
#undef QLOAD
#undef VMW
#undef VMWN
#undef SLOAD_H
#undef SWRITE_HK
#undef SWRITE_HV
#undef SWRITE_H
#undef BIAS_DMA
#undef GATE_DMA

struct Tens { const bf16* Q; const bf16* K; bf16* O; const bf16* SG; const float* CB; };
__device__ __forceinline__ BlockRef fox_ref(const Tens& T, int L, int pass, int seq_no) {
    const int xcd = L & 7, k = L >> 3, bh = (k >> 2) * 8 + xcd, x = k & 3, qb = pass ? 7 - x : x, b = bh >> 4, h = bh & 15;
    BlockRef r; const size_t hoff = (size_t)b * SEQ * PITCH + h * AD, qoff = hoff + (size_t)qb * QB * PITCH;
    r.Q = (const GAS char*)(T.Q + qoff); r.O = (GAS char*)(T.O + qoff); r.SG = (const GAS char*)(T.SG + qoff); r.K = (const GAS char*)(T.K + hoff); r.CB = (const GAS char*)(T.CB + (size_t)bh * SEQ); r.P0 = qb * QB; r.par = seq_no & 1;
    return r;
}
__device__ __forceinline__ void fox_phase(char* lds, const Tens& T, int G, int c, const int tid) {
    constexpr int total = NB * NH * 4;
    int L = c; if (L >= total) return;
    int pass = 0, seq = 0;
    BlockRef cur = fox_ref(T, L, 0, 0);
    Seam S;
    fox_prime(cur, lds, S, tid);
    for (;;) {
        const bool more_pass = pass == 0, more_item = L + G < total, last = !more_pass && !more_item;
        int passn = pass + 1, Ln = L;
        if (!more_pass) { passn = 0; Ln = more_item ? L + G : L; }
        const BlockRef nxt = fox_ref(T, Ln, passn, seq + 1);
        fox_block(cur, nxt, lds, S, tid);
        if (last) break;
        cur = nxt; pass = passn; L = Ln; ++seq;
    }
}
}

__device__ __forceinline__ float log_sigmoid_(float x) { return x >= 0.f ? -log1pf(expf(-x)) : x - log1pf(expf(x)); }
struct RowArgs {
    const bf16* Hin; const bf16* YP; float* Hout; const float* gain; bf16* HN; float* out;
    const bf16* Wsk; const float* b0; const float* b1;
    unsigned* cnt; int* tokl; float* pw; float* LF; float* tokw; float* tokr;
    const float* SS; float* RSTD;
};
template <int MODE>
__device__ __forceinline__ void row_phase(Frame& F, const RowArgs& A) {
    constexpr int NCT = (MODE == 1) ? 3 : 1, LGP = NCT * 32, RU = (MODE == 1) ? 4 : 2;
    LAS float* PB = (LAS float*)(F.lds + RING_OFF);
    LAS float* LG = PB + 64 * LGP;
    for (int blk = blockIdx.x; blk < M / 64; blk += F.G) {
        const int r0 = blk * 64;
        if constexpr (MODE >= 2)
        for (int k0 = 0; k0 < 8; k0 += RU) {
            f32x4 v[RU][8];
#pragma unroll
            for (int u = 0; u < RU; ++u) { const GAS v2u* xr = (const GAS v2u*)(A.Hin + (size_t)(r0 + F.wave * 8 + k0 + u) * D) + F.lane;
#pragma unroll
                for (int j = 0; j < 8; ++j) { const v2u hb = xr[64 * j]; v[u][j].x = bf_lo(hb.x); v[u][j].y = bf_hi(hb.x); v[u][j].z = bf_lo(hb.y); v[u][j].w = bf_hi(hb.y); } }
            if constexpr (MODE >= 2) {
                v2u ya[RU][8], yb[RU][8];
#pragma unroll
                for (int u = 0; u < RU; ++u) { const int row = r0 + F.wave * 8 + k0 + u;
                    const GAS v2u* y0 = (const GAS v2u*)(A.YP + (size_t)(2 * row) * D) + F.lane; const GAS v2u* y1 = (const GAS v2u*)(A.YP + (size_t)(2 * row + 1) * D) + F.lane;
#pragma unroll
                    for (int j = 0; j < 8; ++j) { ya[u][j] = y0[64 * j]; yb[u][j] = y1[64 * j]; } }
#pragma unroll
                for (int u = 0; u < RU; ++u)
#pragma unroll
                    for (int j = 0; j < 8; ++j) { const v2u a = ya[u][j], b = yb[u][j];
                        v[u][j].x += bf_lo(a.x) + bf_lo(b.x); v[u][j].y += bf_hi(a.x) + bf_hi(b.x); v[u][j].z += bf_lo(a.y) + bf_lo(b.y); v[u][j].w += bf_hi(a.y) + bf_hi(b.y); }
            }
#pragma unroll
            for (int u = 0; u < RU; ++u) {
                const int row = r0 + F.wave * 8 + k0 + u;
                float s = 0.f;
#pragma unroll
                for (int j = 0; j < 8; ++j) s += (v[u][j].x * v[u][j].x + v[u][j].y * v[u][j].y) + (v[u][j].z * v[u][j].z + v[u][j].w * v[u][j].w);
                const float rstd = 1.f / sqrtf(wave_sum(s) * (1.f / D) + RMS_EPS);
                const GAS f32x4* gr = (const GAS f32x4*)A.gain + F.lane;
                if constexpr (MODE == 3) { GAS f32x4* o = (GAS f32x4*)(A.out + (size_t)row * D) + F.lane;
#pragma unroll
                    for (int j = 0; j < 8; ++j) { const f32x4 g = gr[64 * j]; f32x4 w; w.x = v[u][j].x * rstd * g.x; w.y = v[u][j].y * rstd * g.y; w.z = v[u][j].z * rstd * g.z; w.w = v[u][j].w * rstd * g.w; __builtin_nontemporal_store(w, o + 64 * j); } }
                else { GAS v2u* o8 = (GAS v2u*)(A.HN + (size_t)row * D) + F.lane;
#pragma unroll
                    for (int j = 0; j < 8; ++j) { const f32x4 g = gr[64 * j]; v2u w; w.x = pk2(v[u][j].x * rstd * g.x, v[u][j].y * rstd * g.y); w.y = pk2(v[u][j].z * rstd * g.z, v[u][j].w * rstd * g.w); o8[64 * j] = w; } }
            }
        }
        if constexpr (MODE == 1 || MODE == 2) {
            LAS float* RS_l = PB + 4 * 64 * LGP;
            if constexpr (MODE == 1) { if (F.tid < 64) { const GAS f32x4* ss = (const GAS f32x4*)(A.SS + (size_t)(r0 + F.tid) * 32); float t = 0.f;
#pragma unroll
                    for (int j = 0; j < 8; ++j) { const f32x4 q = ss[j]; t += (q.x + q.y) + (q.z + q.w); }
                    const float rs = 1.f / sqrtf(t * (1.f / D) + RMS_EPS); RS_l[F.tid] = rs; A.RSTD[r0 + F.tid] = rs; } }
            VM_WAIT(); __syncthreads();
            const int r32 = F.lane & 31, hi = F.lane >> 5;
            f32x16 acc[2][NCT];
#pragma unroll
            for (int rt = 0; rt < 2; ++rt)
#pragma unroll
                for (int ct = 0; ct < NCT; ++ct) acc[rt][ct] = (f32x16){};
            {
                const bf16* ap = (MODE == 1 ? A.Hin : A.HN) + (size_t)(r0 + r32) * D + F.wave * 256 + 8 * hi;
                const bf16* bp = A.Wsk + (size_t)r32 * D + F.wave * 256 + 8 * hi;
                constexpr int QB = (MODE == 1) ? 4 : 8;
#pragma unroll 1
                for (int kb = 0; kb < 16 / QB; ++kb) {
                    bf16x8 af[2][QB], bfr[NCT][QB];
#pragma unroll
                    for (int q = 0; q < QB; ++q) {
#pragma unroll
                        for (int rt = 0; rt < 2; ++rt) af[rt][q] = *(const GAS bf16x8*)(ap + (size_t)rt * 32 * D + (kb * QB + q) * 16);
#pragma unroll
                        for (int ct = 0; ct < NCT; ++ct) bfr[ct][q] = *(const GAS bf16x8*)(bp + (size_t)ct * 32 * D + (kb * QB + q) * 16); }
#pragma unroll
                    for (int q = 0; q < QB; ++q)
#pragma unroll
                        for (int rt = 0; rt < 2; ++rt)
#pragma unroll
                            for (int ct = 0; ct < NCT; ++ct) acc[rt][ct] = __builtin_amdgcn_mfma_f32_32x32x16_bf16(af[rt][q], bfr[ct][q], acc[rt][ct], 0, 0, 0);
                }
            }
#define RP_STORE(buf) do { _Pragma("unroll") for (int rt = 0; rt < 2; ++rt) _Pragma("unroll") for (int ct = 0; ct < NCT; ++ct) _Pragma("unroll") for (int r = 0; r < 16; ++r) \
                (buf)[(rt * 32 + (r & 3) + 8 * (r >> 2) + 4 * hi) * LGP + ct * 32 + r32] = acc[rt][ct][r]; } while (0)
#define RP_ADD(buf) do { _Pragma("unroll") for (int rt = 0; rt < 2; ++rt) _Pragma("unroll") for (int ct = 0; ct < NCT; ++ct) _Pragma("unroll") for (int r = 0; r < 16; ++r) \
                acc[rt][ct][r] += (buf)[(rt * 32 + (r & 3) + 8 * (r >> 2) + 4 * hi) * LGP + ct * 32 + r32]; } while (0)
            if (F.wave >= 4) RP_STORE(PB + (F.wave - 4) * 64 * LGP);
            LDS_WAIT(); __syncthreads();
            if (F.wave < 4) RP_ADD(PB + F.wave * 64 * LGP);
            LDS_WAIT(); __syncthreads();
            if (F.wave == 2 || F.wave == 3) RP_STORE(PB + (F.wave - 2) * 64 * LGP);
            LDS_WAIT(); __syncthreads();
            if (F.wave < 2) RP_ADD(PB + F.wave * 64 * LGP);
            LDS_WAIT(); __syncthreads();
            if (F.wave == 1) RP_STORE(PB);
            LDS_WAIT(); __syncthreads();
            if (F.wave == 0) { RP_ADD(PB); RP_STORE(LG); }
            LDS_WAIT(); __syncthreads();
#undef RP_STORE
#undef RP_ADD
            if constexpr (MODE == 1) {
                if (F.tid < 64) {
                    const int tok = r0 + F.tid; const LAS float* lg = LG + F.tid * LGP;
                    float gl[8]; const float rs = RS_l[F.tid];
#pragma unroll
                    for (int i = 0; i < 8; ++i) gl[i] = lg[i] * rs + A.b0[i];
                    int gs = 0; float gm = gl[0];
#pragma unroll
                    for (int i = 1; i < 8; ++i) if (gl[i] > gm) { gm = gl[i]; gs = i; }
                    float den = 0.f;
#pragma unroll
                    for (int i = 0; i < 8; ++i) den += expf(gl[i] - gm);
                    const float pg = 1.f / den;
                    float el[8];
#pragma unroll
                    for (int i = 0; i < 8; ++i) el[i] = lg[8 + gs * 8 + i] * rs + A.b1[gs * 8 + i];
                    int i0 = 0; float t0 = el[0];
#pragma unroll
                    for (int i = 1; i < 8; ++i) if (el[i] > t0) { t0 = el[i]; i0 = i; }
                    int i1 = 0; float t1 = -__builtin_inff();
#pragma unroll
                    for (int i = 0; i < 8; ++i) if (i != i0 && el[i] > t1) { t1 = el[i]; i1 = i; }
                    const float w0 = pg / (1.f + expf(t1 - t0)), w1 = pg - w0;
                    const int e0 = gs * 8 + i0, e1 = gs * 8 + i1;
                    const unsigned p0 = __hip_atomic_fetch_add(A.cnt + e0, 1u, RLX_AGENT), p1 = __hip_atomic_fetch_add(A.cnt + e1, 1u, RLX_AGENT);
                    A.tokl[(size_t)e0 * M + p0] = 2 * tok; A.tokl[(size_t)e1 * M + p1] = 2 * tok + 1;
                    A.tokw[(size_t)e0 * M + p0] = w0; A.tokw[(size_t)e1 * M + p1] = w1; A.tokr[(size_t)e0 * M + p0] = rs; A.tokr[(size_t)e1 * M + p1] = rs;
                    A.pw[2 * tok] = w0; A.pw[2 * tok + 1] = w1;
                }
            } else {
#pragma unroll
                for (int q = 0; q < 2; ++q) { const int idx = F.tid + q * 512, tl = idx >> 4, h = idx & 15;
                    A.LF[(size_t)(r0 + tl) * 16 + h] = log_sigmoid_(LG[tl * LGP + h] + A.b0[h]); }
            }
            __syncthreads();
        }
    }
}
__device__ __forceinline__ void cumsum_phase(Frame& F, const float* LF, float* CUMB) {
    LAS float* wt = (LAS float*)(F.lds + RING_OFF);
    for (int bh = blockIdx.x; bh < NB * NH; bh += F.G) {
        const int b = bh >> 4, h = bh & 15, s0 = 4 * F.tid;
        float c0 = LF[(size_t)(b * SEQ + s0) * 16 + h], c1 = c0 + LF[(size_t)(b * SEQ + s0 + 1) * 16 + h], c2 = c1 + LF[(size_t)(b * SEQ + s0 + 2) * 16 + h], c3 = c2 + LF[(size_t)(b * SEQ + s0 + 3) * 16 + h];
        float incl = c3;
#pragma unroll
        for (int o = 1; o < 64; o <<= 1) { const float t = __shfl_up(incl, o); if (F.lane >= o) incl += t; }
        if (F.lane == 63) wt[F.wave] = incl;
        LDS_WAIT(); __syncthreads();
        float off = incl - c3;
        for (int w = 0; w < F.wave; ++w) off += wt[w];
        const float sc = -1.f / fox::SCALE;
        f32x4 o4; o4.x = (off + c0) * sc; o4.y = (off + c1) * sc; o4.z = (off + c2) * sc; o4.w = (off + c3) * sc;
        *(GAS f32x4*)(CUMB + (size_t)bh * SEQ + s0) = o4;
        __syncthreads();
    }
}
__device__ __forceinline__ MoeTab moe_tables(Frame& F, const unsigned* cnt) {
    LAS int* base = (LAS int*)(F.lds + MOE_OFF);
    LAS int* cnt_l = base; LAS int* tstart = base + 64; LAS int* ntile = base + 128; LAS int* Tw = base + 192; LAS int* mt_e = base + 196; LAS int* mt_row0 = base + 196 + MAXMT;
    __syncthreads();
    if (F.tid < 64) {
        const int c = (int)__hip_atomic_load(cnt + F.tid, RLX_AGENT); const int nt = (c + 255) >> 8;
        int incl = nt;
#pragma unroll
        for (int o = 1; o < 64; o <<= 1) { const int t = __shfl_up(incl, o); if (F.lane >= o) incl += t; }
        cnt_l[F.tid] = c; tstart[F.tid] = incl - nt; ntile[F.tid] = nt; if (F.tid == 63) Tw[0] = incl;
    }
    LDS_WAIT(); __syncthreads();
    const int T = Tw[0];
    for (int mt = F.tid; mt < T; mt += NWAVES * 64) { int e = 0;
        for (int k = 0; k < 64; ++k) e += (tstart[k] + ntile[k] <= mt) ? 1 : 0;
        e = e > 63 ? 63 : e; mt_e[mt] = e; mt_row0[mt] = (mt - tstart[e]) * 256; }
    LDS_WAIT(); __syncthreads();
    MoeTab t; t.cnt = cnt_l; t.mt_e = mt_e; t.mt_row0 = mt_row0; t.T = T; return t;
}

#ifndef MK_PER_PHASE
#define MK_PER_PHASE 0
#endif
constexpr int NPHASE = 17;
__global__ void __launch_bounds__(NWAVES * 64, 2) hybrid_fwd(Args args) {
    extern __shared__ __attribute__((aligned(16))) unsigned char lds[];
    Frame F;
    F.lds = (LAS unsigned char*)lds;
    F.MISC = (volatile LAS unsigned*)(F.lds + MISC_OFF);
    F.tid = threadIdx.x; F.lane = F.tid & 63; F.wave = __builtin_amdgcn_readfirstlane(F.tid >> 6);
    const int wave0 = F.wave;
    F.G = gridDim.x; { const int bx = blockIdx.x; F.vcu = (F.G % 8 == 0) ? (bx % 8) * (F.G / 8) + bx / 8 : bx; }
    F.ws = args.ws;
    F.ctl = (gu32*)(args.ws + WS_CTL);
    for (int u = F.tid; u < (LDS_BYTES - LDSCTL_OFF) / 4; u += NWAVES * 64) ((LAS unsigned*)(F.lds + LDSCTL_OFF))[u] = 0u;
    __syncthreads();
    XcdBarrier bar; bar.bar = (unsigned*)(F.ctl + CW_BAR); bar.x = 0; bar.st = nullptr;
    if (!MK_PER_PHASE) bar = xcd_barrier_post((unsigned*)(F.ctl + CW_BAR), F.MISC + 8);
#define GRID_BAR() do { if (MK_PER_PHASE) { if (F.tid == 0) __hip_atomic_store(F.ctl + CW_TMO, 0xBADBA0u, RLX_AGENT); } else { XcdBarrier bb_ = bar; asm volatile("" : "+s"(bb_.bar)); xcd_barrier(bb_, F.tid); } } while (0)
    const int lo = args.ph_lo, hi = args.ph_hi; (void)lo; (void)hi;
#ifndef PH_MASK
#define PH_MASK 0x1ffff
#endif
#if MK_PER_PHASE
#define IN(k) ((((PH_MASK) >> (k)) & 1) && lo <= (k) && (k) < hi)
#else
#define IN(k) ((((PH_MASK) >> (k)) & 1) != 0)
#endif
#define BOTH(k) (IN(k) && IN((k) + 1))
    const int G = F.G, cid = (int)blockIdx.x, cls = ((int)blockIdx.x >> 3) & 1;
#define pHN ((bf16*)(ws + WS_HN))
#define pUA ((bf16*)(ws + WS_UA))
#define pGL ((bf16*)(ws + WS_GL))
#define pOG ((bf16*)(ws + WS_OG))
#define pH2 ((float*)(ws + WS_H2))
#define pHB ((bf16*)(ws + WS_H2 + 64 * MiB))
#define pYP ((bf16*)(ws + WS_YP))
#define pHID ((bf16*)(ws + WS_HID))
#define pTOKL ((int*)(ws + WS_TOKL))
#define pPW ((float*)(ws + WS_PW))
#define pSS ((float*)(ws + WS_SS))
#define pRSTD ((float*)(ws + WS_RSTD))
#define PH() unsigned char* ws; { int l_; asm volatile("v_mbcnt_lo_u32_b32 %0, -1, 0\n\tv_mbcnt_hi_u32_b32 %0, -1, %0" : "=v"(l_)); F.lane = l_; F.wave = wave0; F.tid = wave0 * 64 + l_; \
    unsigned wl_ = __builtin_amdgcn_readfirstlane((unsigned)(uintptr_t)args.ws), wh_ = __builtin_amdgcn_readfirstlane((unsigned)((uintptr_t)args.ws >> 32)); asm volatile("" : "+s"(wl_), "+s"(wh_)); ws = (unsigned char*)(((uintptr_t)wh_ << 32) | wl_); F.ws = ws; }
    if (IN(0)) { PH(); p0_prologue(F, args, ws); if (BOTH(0)) GRID_BAR(); }
    if (IN(1)) { PH(); SchedDense S; S.init(pHN, D, ws + WS_WS5IN, D, M / 256, DS / 256, G, cid); EpiU E{pUA};
        if (cls == 0) { moe_conv(F, args, ws, 0, 0, 3); __syncthreads(); } pg8::gemm_phase<EpiU, SchedDense, true>(F.lds + RING_OFF, F.tid, D, D, D, S, E); if (cls == 1) { __syncthreads(); moe_conv(F, args, ws, 0, 0, 3); } if (BOTH(1)) GRID_BAR(); }
    if (IN(2)) { PH(); SchedS5<1> S; S.init(pUA, ws + WS_PT, 256, 512, G, cid); EpiScan E{pUA, (const float*)(ws + WS_AL)};
        pg8::gemm_phase<EpiScan, SchedS5<1>, false>(F.lds + RING_OFF, F.tid, 512, KP, 512, S, E);
        if (G > 2 * NG && cid >= 2 * NG) conv_range<2>(F, args, ws, 0, CONV_TOTAL_FOX, (cid - 2 * NG) * NWAVES + F.wave, (G - 2 * NG) * NWAVES);
        if (BOTH(2)) GRID_BAR(); }
    if (IN(3)) { PH(); SchedS5<2> S; S.init(pUA, ws + WS_TT, 512, KP, G, cid); EpiY E{pUA, args.in[9], pGL};
        if (G <= 2 * NG && cls == 0) { conv_run<2>(F, args, ws, 0, 1); __syncthreads(); } pg8::gemm_phase<EpiY, SchedS5<2>, true>(F.lds + RING_OFF, F.tid, KP, KP, KP, S, E); if (G <= 2 * NG && cls == 1) { __syncthreads(); conv_run<2>(F, args, ws, 0, 1); } if (BOTH(3)) GRID_BAR(); }
    if (IN(4)) { PH(); SchedDense S; S.init(pGL, DS, ws + WS_WGLU, DS, M / 256, DS / 256, G, cid); EpiGlu E{pGL, args.in[12], pOG};
        if (cls == 0) { moe_conv(F, args, ws, 0, 1, 3); __syncthreads(); } pg8::gemm_phase<EpiGlu, SchedDense, true>(F.lds + RING_OFF, F.tid, DS, DS, DS, S, E); if (cls == 1) { __syncthreads(); moe_conv(F, args, ws, 0, 1, 3); } if (BOTH(4)) GRID_BAR(); }
    if (IN(5)) { PH(); SchedDense S; S.init(pOG, DS, ws + WS_WS5OUT, DS, M / 256, D / 256, G, cid); EpiResB E{args.in[0], pHB, pSS};
        if (cls == 0) { moe_conv(F, args, ws, 0, 2, 3); __syncthreads(); } pg8::gemm_phase<EpiResB, SchedDense, true>(F.lds + RING_OFF, F.tid, DS, DS, DS, S, E); if (cls == 1) { __syncthreads(); moe_conv(F, args, ws, 0, 2, 3); } if (BOTH(5)) GRID_BAR(); }

    {
        constexpr int pR = 6;
        unsigned* const cnt = (unsigned*)(F.ctl + CW_CNT) + 0;
        if (IN(pR)) { PH(); RowArgs A{}; A.Hin = pHB; A.gain = args.in[14]; A.HN = pHN; A.Wsk = (const bf16*)(ws + WS_WR) + (size_t)0 * (256 * 1024); A.b0 = args.in[16]; A.b1 = args.in[18];
            A.cnt = cnt; A.tokl = pTOKL; A.pw = pPW; A.SS = pSS; A.RSTD = pRSTD; A.tokw = (float*)(ws + WS_TOKW); A.tokr = (float*)(ws + WS_TOKR);
            row_phase<1>(F, A); if (BOTH(pR)) GRID_BAR(); }
        if (IN(pR + 1)) { PH(); const MoeTab tab = moe_tables(F, cnt);
            const int nwg_ = tab.T * 4, R_ = (nwg_ + G - 1) / G, Gp = (nwg_ + R_ - 1) / R_, nfree = G - Gp;
            constexpr int IPW = 64;
            const int npre_ = nfree * NWAVES * IPW < CONV_TOTAL_MOE ? nfree * NWAVES * IPW : CONV_TOTAL_MOE;
            if (cid == 0 && F.tid == 0) __hip_atomic_store(F.ctl + CW_NPRE, (unsigned)npre_, RLX_AGENT);
            if (cid < Gp) {
            SchedMoeGU S; S.T.init(tab.T, 4, Gp, cid); S.tab = tab; S.HN = (const char*)pHB; S.W = (const char*)(ws + WS_WGU) + (size_t)0 * NE * 1024 * D * 2; S.tokl = pTOKL; S.tid = F.tid;
            EpiGU E{pHID, tab, (const float*)(ws + WS_TOKR)};
            pg8::gemm_phase<EpiGU, SchedMoeGU, true>(F.lds + RING_OFF, F.tid, D, D, D, S, E);
            } else { conv_range<1>(F, args, ws, 0, npre_, (cid - Gp) * NWAVES + F.wave, nfree * NWAVES); }
            if (BOTH(pR + 1)) GRID_BAR(); }
        if (IN(pR + 2)) { PH(); const MoeTab tab = moe_tables(F, cnt);
            SchedMoeDN S; S.T.init(tab.T, 8, G, cid); S.T.split = 1;   S.tab = tab; S.HID = (const char*)pHID; S.W = (const char*)(ws + WS_WDN) + (size_t)0 * NE * D * DE * 2;
            EpiDN E{tab, pTOKL, (const float*)(ws + WS_TOKW), pYP};
            pg8::gemm_phase<EpiDN, SchedMoeDN, true>(F.lds + RING_OFF, F.tid, DE, DE, DE, S, E); if (BOTH(pR + 2)) GRID_BAR(); }
        }
    {
            if (IN(9)) { PH(); RowArgs A{}; A.Hin = pHB; A.YP = pYP; A.gain = args.in[22]; A.HN = pHN; A.Wsk = (const bf16*)(ws + WS_WF); A.b0 = args.in[24]; A.LF = (float*)(ws + WS_LF);
                row_phase<2>(F, A); if (BOTH(9)) GRID_BAR(); }
            if (IN(10)) { { PH(); cumsum_phase(F, (const float*)(ws + WS_LF), (float*)(ws + WS_CUMB)); }
#pragma unroll 1
                for (int seg = 0; seg < 2; ++seg) { PH();
                    const int split_ = 2 * (int)((blockIdx.x >> 3) & 3);
                    SchedDense S; S.init(pHN, D, ws + WS_WFOXIN, D, M / 256, 4 * D / 256, G, cid); EpiQKVG E{(bf16*)(ws + WS_Q), (size_t)(WS_K - WS_Q) / 2};
                    S.i_begin = seg ? split_ : 0; S.i_end = seg ? (1 << 30) : split_;
                    pg8::gemm_phase<EpiQKVG, SchedDense, true>(F.lds + RING_OFF, F.tid, D, D, D, S, E);
                    if (seg == 0) { asm volatile("s_waitcnt vmcnt(0)" ::: "memory"); __syncthreads();
                        const int npre_ = (int)__hip_atomic_load(F.ctl + CW_NPRE, RLX_AGENT), gw_ = F.vcu * NWAVES + F.wave;
                        conv_range<1>(F, args, ws, npre_, npre_ + (CONV_TOTAL_MOE - npre_) / 2, gw_, G * NWAVES); __syncthreads(); } }
                if (BOTH(10)) GRID_BAR(); }
            if (IN(11)) { PH(); static_assert(WS_V - WS_K == fox::VK_DELTA, "V = K + 64 MiB");
                const fox::Tens T{(const bf16*)(ws + WS_Q), (const bf16*)(ws + WS_K), (bf16*)(ws + WS_Q), (const bf16*)(ws + WS_SG), (const float*)(ws + WS_CUMB)};
                const int npre_ = (int)__hip_atomic_load(F.ctl + CW_NPRE, RLX_AGENT), gw_ = F.vcu * NWAVES + F.wave, mid_ = npre_ + (CONV_TOTAL_MOE - npre_) / 2;
                if (cls == 0) { conv_range<1>(F, args, ws, mid_, CONV_TOTAL_MOE, gw_, G * NWAVES); __syncthreads(); }
                fox::fox_phase((char*)lds + RING_OFF, T, G, cid, F.tid);
                if (cls == 1) { asm volatile("s_waitcnt vmcnt(0)" ::: "memory"); __syncthreads(); conv_range<1>(F, args, ws, mid_, CONV_TOTAL_MOE, gw_, G * NWAVES); }
                if (BOTH(11)) GRID_BAR(); }
            if (IN(12)) { PH(); SchedDense S; S.init(ws + WS_Q, D, ws + WS_WFOXOUT, D, M / 256, D / 256, G, cid); EpiResYPB E{pHB, pYP, pSS};
                pg8::gemm_phase<EpiResYPB, SchedDense, true>(F.lds + RING_OFF, F.tid, D, D, D, S, E); if (BOTH(12)) GRID_BAR(); }
            }
    {
        constexpr int pR = 13;
        unsigned* const cnt = (unsigned*)(F.ctl + CW_CNT) + 64;
        if (IN(pR)) { PH(); RowArgs A{}; A.Hin = pHB; A.gain = args.in[26]; A.HN = pHN; A.Wsk = (const bf16*)(ws + WS_WR) + (size_t)1 * (256 * 1024); A.b0 = args.in[28]; A.b1 = args.in[30];
            A.cnt = cnt; A.tokl = pTOKL; A.pw = pPW; A.SS = pSS; A.RSTD = pRSTD; A.tokw = (float*)(ws + WS_TOKW); A.tokr = (float*)(ws + WS_TOKR);
            row_phase<1>(F, A); if (BOTH(pR)) GRID_BAR(); }
        if (IN(pR + 1)) { PH(); const MoeTab tab = moe_tables(F, cnt);
            SchedMoeGU S; S.T.init(tab.T, 4, G, cid); S.T.split = 1;   S.tab = tab; S.HN = (const char*)pHB; S.W = (const char*)(ws + WS_WGU) + (size_t)1 * NE * 1024 * D * 2; S.tokl = pTOKL; S.tid = F.tid;
            EpiGU E{pHID, tab, (const float*)(ws + WS_TOKR)};
            pg8::gemm_phase<EpiGU, SchedMoeGU, true>(F.lds + RING_OFF, F.tid, D, D, D, S, E); if (BOTH(pR + 1)) GRID_BAR(); }
        if (IN(pR + 2)) { PH(); const MoeTab tab = moe_tables(F, cnt);
            SchedMoeDN S; S.T.init(tab.T, 8, G, cid); S.T.split = 1;   S.tab = tab; S.HID = (const char*)pHID; S.W = (const char*)(ws + WS_WDN) + (size_t)1 * NE * D * DE * 2;
            EpiDN E{tab, pTOKL, (const float*)(ws + WS_TOKW), pYP};
            pg8::gemm_phase<EpiDN, SchedMoeDN, true>(F.lds + RING_OFF, F.tid, DE, DE, DE, S, E); if (BOTH(pR + 2)) GRID_BAR(); }
        }
    if (IN(16)) { PH(); RowArgs A{}; A.Hin = pHB; A.YP = pYP; A.gain = args.in[34]; A.out = args.out; row_phase<3>(F, A); }
#undef IN
#undef BOTH
#undef GRID_BAR
#undef PH
#undef pHN
#undef pUA
#undef pGL
#undef pOG
#undef pH2
#undef pHB
#undef pYP
#undef pHID
#undef pTOKL
#undef pPW
#undef pSS
#undef pRSTD
}

extern "C" void kernel_launch(void* const* d_in, const int* in_sizes, int n_in, void* d_out, int out_size, void* d_ws, size_t ws_size, hipStream_t stream) {
    static int grid = 0;
    if (grid == 0) {
        if (n_in != 35 || in_sizes[0] != M * D || out_size != M * D || ws_size < WS_END) { fprintf(stderr, "kernel_launch: shape/workspace mismatch (n_in %d in0 %d out %d ws %zu need %zu)\n", n_in, n_in > 0 ? in_sizes[0] : -1, out_size, ws_size, (size_t)WS_END); grid = -1; return; }
        int dev = 0, cus = 0, per_cu = 0;
        if (hipGetDevice(&dev) != hipSuccess || hipDeviceGetAttribute(&cus, hipDeviceAttributeMultiprocessorCount, dev) != hipSuccess) { grid = -1; return; }
        if (hipFuncSetAttribute((const void*)hybrid_fwd, hipFuncAttributeMaxDynamicSharedMemorySize, LDS_BYTES) != hipSuccess) { fprintf(stderr, "kernel_launch: hipFuncSetAttribute failed\n"); grid = -1; return; }
        if (hipOccupancyMaxActiveBlocksPerMultiprocessor(&per_cu, (const void*)hybrid_fwd, NWAVES * 64, LDS_BYTES) != hipSuccess || per_cu < 1)
            fprintf(stderr, "kernel_launch: occupancy query reports %d workgroups per CU\n", per_cu);
        (void)hipGetLastError();
        grid = cus;
    }
    if (grid < 0) return;
    if (hipMemsetAsync((char*)d_ws + WS_CTL, 0, CTL_ZERO_BYTES, stream) != hipSuccess) return;
    Args a{};
    for (int i = 0; i < 35; ++i) a.in[i] = (const float*)d_in[i];
    a.out = (float*)d_out; a.ws = (unsigned char*)d_ws;
#if MK_PER_PHASE
    for (int p = 0; p < NPHASE; ++p) { a.ph_lo = p; a.ph_hi = p + 1; hipLaunchKernelGGL(hybrid_fwd, dim3(grid), dim3(NWAVES * 64), LDS_BYTES, stream, a); }
#else
    a.ph_lo = 0; a.ph_hi = NPHASE;
    hipLaunchKernelGGL(hybrid_fwd, dim3(grid), dim3(NWAVES * 64), LDS_BYTES, stream, a);
#endif
    const hipError_t le = hipPeekAtLastError();
    if (le != hipSuccess) fprintf(stderr, "kernel_launch: launch failed: %s\n", hipGetErrorName(le));
}
```
